# Optimizing an MI355X kernel written in HIP

```python
import jax
import jax.numpy as jnp
from jax import lax
import numpy as np

D_MODEL = 2048
BATCH = 2
SEQ = 4096
DEPTH = 2

Q_BLOCK = 128
LN_EPS = 1e-5
RMS_EPS = 1e-6
ALPHA = (2 * DEPTH) ** 0.25
BETA = (8 * DEPTH) ** -0.25

MLA_HEADS = 8
MLA_Q_LORA = 512
MLA_KV_LORA = 256
MLA_NOPE = 128
MLA_ROPE = 64
MLA_V = 128
ROPE_THETA = 10000.0

FOX_HEADS = 8
FOX_HEAD_DIM = 128

SWA_Q_HEADS = 16
SWA_KV_HEADS = 2
SWA_HEAD_DIM = 64
SWA_WINDOW = 128

MOBA_HEADS = 8
MOBA_HEAD_DIM = 128
MOBA_BLOCK = 256
MOBA_TOPK = 3
MOBA_Q_CHUNK = 64

N_EXPERTS = 32
N_GROUPS = 8
EXPERTS_PER_GROUP = N_EXPERTS // N_GROUPS
MOE_TOPK = 2
EXPERT_FF = 512

EVEN_IN_SIZES = (MLA_Q_LORA, MLA_KV_LORA, MLA_ROPE, FOX_HEADS * FOX_HEAD_DIM, FOX_HEADS * FOX_HEAD_DIM, FOX_HEADS * FOX_HEAD_DIM, FOX_HEADS)
EVEN_IN = sum(EVEN_IN_SIZES)
EVEN_MIX = MLA_HEADS * MLA_V + FOX_HEADS * FOX_HEAD_DIM
ODD_IN_SIZES = (SWA_Q_HEADS * SWA_HEAD_DIM, SWA_KV_HEADS * SWA_HEAD_DIM, SWA_KV_HEADS * SWA_HEAD_DIM, MOBA_HEADS * MOBA_HEAD_DIM, MOBA_HEADS * MOBA_HEAD_DIM, MOBA_HEADS * MOBA_HEAD_DIM)
ODD_IN = sum(ODD_IN_SIZES)
ODD_MIX = SWA_Q_HEADS * SWA_HEAD_DIM + MOBA_HEADS * MOBA_HEAD_DIM

kernel_name = "hybrid_mla_fox_swa_moba_moe_deepnorm"


def _split(t, sizes):
    offsets = [int(o) for o in np.cumsum(sizes)[:-1]]
    return jnp.split(t, offsets, axis=-1)


def layer_norm(x, g, b):
    xf = x.astype(jnp.float32)
    mu = jnp.mean(xf, axis=-1, keepdims=True)
    var = jnp.mean(jnp.square(xf - mu), axis=-1, keepdims=True)
    y = (xf - mu) * lax.rsqrt(var + LN_EPS) * g.astype(jnp.float32) + b.astype(jnp.float32)
    return y.astype(x.dtype)


def rms_norm(x, g):
    xf = x.astype(jnp.float32)
    y = xf * lax.rsqrt(jnp.mean(jnp.square(xf), axis=-1, keepdims=True) + RMS_EPS) * g.astype(jnp.float32)
    return y.astype(x.dtype)


def alibi_slopes(n):
    return jnp.asarray(2.0 ** (-8.0 * np.arange(1, n + 1) / n), dtype=jnp.float32)


def rope(t, pos):
    half = t.shape[-1] // 2
    inv_freq = ROPE_THETA ** (-jnp.arange(half, dtype=jnp.float32) / half)
    ang = pos.astype(jnp.float32)[:, None] * inv_freq[None, :]
    cos, sin = jnp.cos(ang), jnp.sin(ang)
    t1 = t[..., :half].astype(jnp.float32)
    t2 = t[..., half:].astype(jnp.float32)
    return jnp.concatenate([t1 * cos - t2 * sin, t1 * sin + t2 * cos], axis=-1).astype(t.dtype)


def to_heads(t, n_heads, head_dim):
    b, s, _ = t.shape
    return t.reshape(b, s, n_heads, head_dim).transpose(0, 2, 1, 3)


def from_heads(t):
    b, h, s, d = t.shape
    return t.transpose(0, 2, 1, 3).reshape(b, s, h * d)


def blocked_causal_attention(q, k, v, scale, q_bias=None, k_bias=None):
    b, h, s, _ = q.shape
    kpos = jnp.arange(s)

    def one_block(i):
        start = i * Q_BLOCK
        qb = lax.dynamic_slice_in_dim(q, start, Q_BLOCK, axis=2)
        sc = jnp.einsum("bhqd,bhkd->bhqk", qb, k, preferred_element_type=jnp.float32) * scale
        if q_bias is not None:
            qbb = lax.dynamic_slice_in_dim(q_bias, start, Q_BLOCK, axis=2)
            sc = sc + qbb[..., :, None] - k_bias[..., None, :]
        qpos = start + jnp.arange(Q_BLOCK)
        sc = jnp.where(kpos[None, :] <= qpos[:, None], sc, -jnp.inf)
        p = jax.nn.softmax(sc, axis=-1).astype(v.dtype)
        return jnp.einsum("bhqk,bhkd->bhqd", p, v)

    out = lax.map(one_block, jnp.arange(s // Q_BLOCK))
    return jnp.moveaxis(out, 0, 2).reshape(b, h, s, -1)


def mla_attention(c_q, c_kv, k_rope_raw, q_norm, w_q_up, kv_norm, w_kv_up, pos):
    b, s, _ = c_q.shape
    q = to_heads(rms_norm(c_q, q_norm) @ w_q_up, MLA_HEADS, MLA_NOPE + MLA_ROPE)
    q = jnp.concatenate([q[..., :MLA_NOPE], rope(q[..., MLA_NOPE:], pos)], axis=-1)
    kv = to_heads(rms_norm(c_kv, kv_norm) @ w_kv_up, MLA_HEADS, MLA_NOPE + MLA_V)
    k_pe = jnp.broadcast_to(rope(k_rope_raw, pos)[:, None], (b, MLA_HEADS, s, MLA_ROPE))
    k = jnp.concatenate([kv[..., :MLA_NOPE], k_pe], axis=-1)
    v = kv[..., MLA_NOPE:]
    out = blocked_causal_attention(q, k, v, (MLA_NOPE + MLA_ROPE) ** -0.5)
    return from_heads(out)


def fox_attention(q, k, v, f_logit, forget_bias):
    q = to_heads(q, FOX_HEADS, FOX_HEAD_DIM)
    k = to_heads(k, FOX_HEADS, FOX_HEAD_DIM)
    v = to_heads(v, FOX_HEADS, FOX_HEAD_DIM)
    log_f = jax.nn.log_sigmoid(f_logit.astype(jnp.float32) + forget_bias.astype(jnp.float32))
    cum = jnp.cumsum(log_f, axis=1).transpose(0, 2, 1)
    out = blocked_causal_attention(q, k, v, FOX_HEAD_DIM ** -0.5, cum, cum)
    return from_heads(out)


def swa_sink_attention(q, k, v, sinks):
    b, s, _ = q.shape
    w, g, dh = SWA_WINDOW, SWA_Q_HEADS // SWA_KV_HEADS, SWA_HEAD_DIM
    nb = s // w
    q = q.reshape(b, nb, w, SWA_KV_HEADS, g, dh)
    k = k.reshape(b, nb, w, SWA_KV_HEADS, dh)
    v = v.reshape(b, nb, w, SWA_KV_HEADS, dh)
    pad = ((0, 0), (1, 0), (0, 0), (0, 0), (0, 0))
    kb = jnp.concatenate([jnp.pad(k, pad)[:, :-1], k], axis=2)
    vb = jnp.concatenate([jnp.pad(v, pad)[:, :-1], v], axis=2)
    sc = jnp.einsum("bnqhgd,bnkhd->bhgnqk", q, kb, preferred_element_type=jnp.float32) * dh ** -0.5
    dist = (jnp.arange(w)[:, None] + w - jnp.arange(2 * w)[None, :])
    abs_k = (jnp.arange(nb) * w - w)[:, None] + jnp.arange(2 * w)[None, :]
    valid = (dist >= 0)[None] & (dist < w)[None] & (abs_k >= 0)[:, None, :]
    slopes = alibi_slopes(SWA_Q_HEADS).reshape(SWA_KV_HEADS, g)
    sc = sc - slopes[None, :, :, None, None, None] * dist.astype(jnp.float32)
    sc = jnp.where(valid, sc, -jnp.inf)
    sink = sinks.astype(jnp.float32).reshape(SWA_KV_HEADS, g)[None, :, :, None, None, None]
    m = jnp.maximum(jnp.max(sc, axis=-1, keepdims=True), sink)
    p = jnp.exp(sc - m)
    p = p / (jnp.sum(p, axis=-1, keepdims=True) + jnp.exp(sink - m))
    out = jnp.einsum("bhgnqk,bnkhd->bnqhgd", p.astype(v.dtype), vb)
    return out.reshape(b, s, SWA_Q_HEADS * dh)


def moba_attention(q, k, v):
    b, s, _ = q.shape
    h, dh, bs, qc_len = MOBA_HEADS, MOBA_HEAD_DIM, MOBA_BLOCK, MOBA_Q_CHUNK
    n_kb = -(-s // bs)
    top = min(MOBA_TOPK, n_kb)
    pad = n_kb * bs - s
    q = to_heads(q, h, dh)
    padw = ((0, 0), (0, 0), (0, pad), (0, 0))
    k = jnp.pad(to_heads(k, h, dh), padw)
    v = jnp.pad(to_heads(v, h, dh), padw)
    k_blk = k.reshape(b, h, n_kb, bs, dh)
    v_blk = v.reshape(b, h, n_kb, bs, dh)
    k_mean = jnp.mean(k_blk.astype(jnp.float32), axis=3)
    slopes = alibi_slopes(h)
    scale = dh ** -0.5
    bi = jnp.arange(b)[:, None, None, None]
    hi = jnp.arange(h)[None, :, None, None]

    def one_chunk(ci):
        start = ci * qc_len
        blk = start // bs
        qc = lax.dynamic_slice_in_dim(q, start, qc_len, axis=2)
        qpos = (start + jnp.arange(qc_len)).astype(jnp.float32)
        gate = jnp.einsum("bhqd,bhnd->bhqn", qc.astype(jnp.float32), k_mean)
        gate = jnp.where(jnp.arange(n_kb) < blk, gate, -jnp.inf)
        _, idx = lax.top_k(gate, top)
        sel_ok = idx < blk
        k_sel = k_blk[bi, hi, idx]
        v_sel = v_blk[bi, hi, idx]
        s_sel = jnp.einsum("bhqd,bhqnkd->bhqnk", qc, k_sel, preferred_element_type=jnp.float32) * scale
        kpos_sel = (idx[..., None] * bs + jnp.arange(bs)).astype(jnp.float32)
        s_sel = s_sel - slopes[None, :, None, None, None] * (qpos[None, None, :, None, None] - kpos_sel)
        s_sel = jnp.where(sel_ok[..., None], s_sel, -jnp.inf)
        k_own = lax.dynamic_slice_in_dim(k, blk * bs, bs, axis=2)
        v_own = lax.dynamic_slice_in_dim(v, blk * bs, bs, axis=2)
        dist_own = qpos[:, None] - (blk * bs + jnp.arange(bs)).astype(jnp.float32)[None, :]
        s_own = jnp.einsum("bhqd,bhkd->bhqk", qc, k_own, preferred_element_type=jnp.float32) * scale
        s_own = s_own - slopes[None, :, None, None] * dist_own
        s_own = jnp.where(dist_own >= 0, s_own, -jnp.inf)
        p = jax.nn.softmax(jnp.concatenate([s_sel.reshape(b, h, qc_len, top * bs), s_own], axis=-1), axis=-1).astype(v.dtype)
        p_sel = p[..., :top * bs].reshape(b, h, qc_len, top, bs)
        p_own = p[..., top * bs:]
        return jnp.einsum("bhqnk,bhqnkd->bhqd", p_sel, v_sel) + jnp.einsum("bhqk,bhkd->bhqd", p_own, v_own)

    out = lax.map(one_chunk, jnp.arange(s // qc_len))
    out = jnp.moveaxis(out, 0, 2).reshape(b, h, s, dh)
    return from_heads(out)


def even_mixer(x, w_in, q_norm, w_q_up, kv_norm, w_kv_up, forget_bias, w_out):
    pos = jnp.arange(x.shape[1])
    c_q, c_kv, k_r, fq, fk, fv, f_logit = _split(x @ w_in, EVEN_IN_SIZES)
    a = mla_attention(c_q, c_kv, k_r, q_norm, w_q_up, kv_norm, w_kv_up, pos)
    bo = fox_attention(fq, fk, fv, f_logit, forget_bias)
    return jnp.concatenate([a, bo], axis=-1) @ w_out


def odd_mixer(x, w_in, sinks, w_out):
    sq, sk, sv, mq, mk, mv = _split(x @ w_in, ODD_IN_SIZES)
    c = swa_sink_attention(sq, sk, sv, sinks)
    d = moba_attention(mq, mk, mv)
    return jnp.concatenate([c, d], axis=-1) @ w_out


def moe(x, w_router, router_bias, w_gate_up, w_down):
    b, s, d = x.shape
    xt = x.reshape(b * s, d)
    aff = jax.nn.sigmoid(jnp.dot(xt, w_router, preferred_element_type=jnp.float32))
    sel = aff + router_bias.astype(jnp.float32)
    grp = sel.reshape(-1, N_GROUPS, EXPERTS_PER_GROUP)
    grp_score = jnp.sum(lax.top_k(grp, MOE_TOPK)[0], axis=-1)
    best = jnp.argmax(grp_score, axis=-1)
    in_grp = (jnp.arange(N_GROUPS)[None, :] == best[:, None])[:, :, None]
    masked = jnp.where(in_grp, grp, -jnp.inf).reshape(-1, N_EXPERTS)
    _, e_idx = lax.top_k(masked, MOE_TOPK)
    wts = jnp.take_along_axis(aff, e_idx, axis=-1)
    wts = wts / jnp.sum(wts, axis=-1, keepdims=True)
    gates = jnp.sum(jax.nn.one_hot(e_idx, N_EXPERTS, dtype=jnp.float32) * wts[..., None], axis=1).astype(x.dtype)
    y = jnp.zeros_like(xt)
    for e in range(N_EXPERTS):
        gu = xt @ w_gate_up[e]
        hdn = jax.nn.silu(gu[:, :EXPERT_FF]) * gu[:, EXPERT_FF:]
        y = y + gates[:, e:e + 1] * (hdn @ w_down[e])
    return y.reshape(b, s, d)


def setup_inputs(seed: int = 0) -> dict:
    key = jax.random.key(seed)
    ks = jax.random.split(key, 20)
    n_even = (DEPTH + 1) // 2
    n_odd = DEPTH // 2

    def nrm(k, shape, scale):
        return jax.random.normal(k, shape, jnp.float32) * scale

    return {
        "x": nrm(ks[0], (BATCH, SEQ, D_MODEL), 1.0),
        "w_router": nrm(ks[1], (D_MODEL, N_EXPERTS), D_MODEL ** -0.5),
        "router_bias": nrm(ks[2], (N_EXPERTS,), 0.01),
        "even_w_in": nrm(ks[3], (n_even, D_MODEL, EVEN_IN), D_MODEL ** -0.5),
        "even_q_norm": 1.0 + nrm(ks[4], (n_even, MLA_Q_LORA), 0.02),
        "even_w_q_up": nrm(ks[5], (n_even, MLA_Q_LORA, MLA_HEADS * (MLA_NOPE + MLA_ROPE)), MLA_Q_LORA ** -0.5),
        "even_kv_norm": 1.0 + nrm(ks[6], (n_even, MLA_KV_LORA), 0.02),
        "even_w_kv_up": nrm(ks[7], (n_even, MLA_KV_LORA, MLA_HEADS * (MLA_NOPE + MLA_V)), MLA_KV_LORA ** -0.5),
        "even_forget_bias": nrm(ks[8], (n_even, FOX_HEADS), 0.1),
        "even_w_out": nrm(ks[9], (n_even, EVEN_MIX, D_MODEL), BETA * EVEN_MIX ** -0.5),
        "odd_w_in": nrm(ks[10], (n_odd, D_MODEL, ODD_IN), D_MODEL ** -0.5),
        "odd_sinks": nrm(ks[11], (n_odd, SWA_Q_HEADS), 0.1),
        "odd_w_out": nrm(ks[12], (n_odd, ODD_MIX, D_MODEL), BETA * ODD_MIX ** -0.5),
        "ln_mix_g": 1.0 + nrm(ks[13], (DEPTH, D_MODEL), 0.02),
        "ln_mix_b": nrm(ks[14], (DEPTH, D_MODEL), 0.02),
        "ln_ffn_g": 1.0 + nrm(ks[15], (DEPTH, D_MODEL), 0.02),
        "ln_ffn_b": nrm(ks[16], (DEPTH, D_MODEL), 0.02),
        "w_gate_up": nrm(ks[17], (DEPTH, N_EXPERTS, D_MODEL, 2 * EXPERT_FF), D_MODEL ** -0.5),
        "w_down": nrm(ks[18], (DEPTH, N_EXPERTS, EXPERT_FF, D_MODEL), BETA * EXPERT_FF ** -0.5),
    }


def reference(x, w_router, router_bias, even_w_in, even_q_norm, even_w_q_up, even_kv_norm, even_w_kv_up, even_forget_bias, even_w_out, odd_w_in, odd_sinks, odd_w_out, ln_mix_g, ln_mix_b, ln_ffn_g, ln_ffn_b, w_gate_up, w_down):
    h = x
    for layer in range(DEPTH):
        i = layer // 2
        if layer % 2 == 0:
            mix = even_mixer(h, even_w_in[i], even_q_norm[i], even_w_q_up[i], even_kv_norm[i], even_w_kv_up[i], even_forget_bias[i], even_w_out[i])
        else:
            mix = odd_mixer(h, odd_w_in[i], odd_sinks[i], odd_w_out[i])
        h = layer_norm(ALPHA * h + mix, ln_mix_g[layer], ln_mix_b[layer])
        h = layer_norm(ALPHA * h + moe(h, w_router, router_bias, w_gate_up[layer], w_down[layer]), ln_ffn_g[layer], ln_ffn_b[layer])
    return h
```

```cpp
#include <hip/hip_runtime.h>
#include <stdint.h>
#include <stdio.h>

#ifndef ONE_LAUNCH
#define ONE_LAUNCH 1
#endif

#define DEVI __device__ __forceinline__
#define LAS __attribute__((address_space(3)))
typedef unsigned short bf16;
typedef short bf16x8 __attribute__((ext_vector_type(8)));
typedef float f32x4 __attribute__((ext_vector_type(4)));
typedef unsigned u32x4 __attribute__((ext_vector_type(4)));

constexpr int S = 4096, NBATCH = 2, T = NBATCH * S, DM = 2048;
constexpr int LDP = 4352;
constexpr int EVEN_IN = 3912, ODD_IN = 4352;
constexpr float LN_EPS = 1e-5f, RMS_EPS = 1e-6f;
constexpr float ALPHA = 1.4142135623730951f;
constexpr int NEXP = 32, FF = 512;
constexpr int E_CQ = 0, E_CKV = 512, E_KR = 768, E_FQ = 832, E_FK = 1856, E_FV = 2880, E_FL = 3904;
constexpr int O_SQ = 0, O_SK = 1024, O_SV = 1152, O_MQ = 1280, O_MK = 2304, O_MV = 3328;

constexpr size_t MiB = 1u << 20;
constexpr size_t WS_CTL = 0, CTL_BYTES = 1 * MiB;
constexpr int CW_CNT = 1024;
constexpr int CW_BAR = 4096;
constexpr size_t WS_LIST = 2 * MiB;
constexpr size_t WS_EW = 4 * MiB;
constexpr size_t WS_FL = 5 * MiB;
constexpr size_t WS_LF = 5 * MiB + 512 * 1024;
constexpr size_t WS_CUM = 6 * MiB;
constexpr size_t WS_KM = 6 * MiB + 512 * 1024;
constexpr size_t WS_KPE = 7 * MiB;
constexpr size_t WS_XB = 16 * MiB;
constexpr size_t WS_HB = 48 * MiB;
constexpr size_t WS_HFA = 80 * MiB;
constexpr size_t WS_HFB = 144 * MiB;
constexpr size_t WS_PRE = 208 * MiB;
constexpr size_t WS_P = 272 * MiB;
constexpr size_t WS_CQN = 340 * MiB;
constexpr size_t WS_CKVN = 348 * MiB;
constexpr size_t WS_QM = 352 * MiB;
constexpr size_t WS_KVM = 376 * MiB;
constexpr size_t WS_AO = 408 * MiB;
constexpr size_t WS_HDN = 440 * MiB;
constexpr size_t WS_Y = 464 * MiB;
constexpr size_t WS_END = 600 * MiB;

constexpr int LDS_BYTES = 98304;
constexpr int NTHREADS = 512, NWAVES = 8;

DEVI unsigned f2bf(float f) { unsigned u = __float_as_uint(f); return (u + 0x7fffu + ((u >> 16) & 1u)) >> 16; }
DEVI float bf2f(unsigned b) { return __uint_as_float(b << 16); }
DEVI float bflo(unsigned w) { return __uint_as_float(w << 16); }
DEVI float bfhi(unsigned w) { return __uint_as_float(w & 0xffff0000u); }
DEVI unsigned pk2(float lo, float hi) { return f2bf(lo) | (f2bf(hi) << 16); }
DEVI float wave_sum(float v) {
#pragma unroll
    for (int o = 1; o < 64; o <<= 1) v += __shfl_xor(v, o);
    return v;
}
DEVI float wave_max(float v) {
#pragma unroll
    for (int o = 1; o < 64; o <<= 1) v = fmaxf(v, __shfl_xor(v, o));
    return v;
}
DEVI void rope_cs(int t, int i, float& c, float& s) {
    const float inv_freq = exp2f(-(float)i * (13.287712379549449f / 32.0f));
    double rev = (double)t * (double)inv_freq * 0.15915494309189535;
    rev -= floor(rev);
    const float a = (float)(rev * 6.283185307179586);
    c = __cosf(a); s = __sinf(a);
}

#define XB_TMO      128
#define XB_XCNT(j)  (256  + 64 * (j))
#define XB_XSUB(j)  (1280 + 64 * (j))
#define XB_XGEN(j)  (2304 + 64 * (j))
#define XB_TOP      3328
#define XB_TOPGEN   3392
#define XCD_BAR_WORDS 3456
#define XB_SPIN_CAP (1u << 18)
DEVI unsigned xb_ld(unsigned* p)              { return __hip_atomic_load(p, __ATOMIC_RELAXED, __HIP_MEMORY_SCOPE_AGENT); }
DEVI unsigned xb_add(unsigned* p, unsigned v) { return __hip_atomic_fetch_add(p, v, __ATOMIC_RELAXED, __HIP_MEMORY_SCOPE_AGENT); }
DEVI unsigned xb_xcc_id() { return (unsigned)__builtin_amdgcn_s_getreg((3 << 11) | 20) & 0xFu; }
#define XB_SPIN(cond, bar) do { unsigned _sp = 0; while (cond) { __builtin_amdgcn_s_sleep(1); \
    if ((++_sp & 255u) == 0u) { if (xb_ld(&(bar)[XB_TMO])) break; if (_sp > XB_SPIN_CAP) { atomicAdd(&(bar)[XB_TMO], 1u); break; } } } } while (0)
struct XcdBarrier { unsigned* bar; unsigned x; volatile LAS unsigned* st; };
DEVI XcdBarrier xcd_barrier_post(unsigned* bar, volatile LAS unsigned* st) {
    XcdBarrier b; b.bar = bar; b.x = xb_xcc_id(); b.st = st;
    if (threadIdx.x == 0) (void)xb_add(&bar[XB_XCNT(b.x)], 1u);
    return b;
}
DEVI void xcd_barrier_complete(unsigned* bar, unsigned x, unsigned& nloc, unsigned& nx) {
    const unsigned G = gridDim.x * gridDim.y * gridDim.z;
    unsigned sum, cnt, mine, sp = 0u;
    for (;;) {
        sum = 0u; cnt = 0u; mine = 0u;
#pragma unroll
        for (unsigned j = 0; j < 16; ++j) { const unsigned c = xb_ld(&bar[XB_XCNT(j)]); sum += c; cnt += (c > 0u) ? 1u : 0u; mine = (j == x) ? c : mine; }
        if (sum == G) break;
        __builtin_amdgcn_s_sleep(1);
        if ((++sp & 255u) == 0u) { if (xb_ld(&bar[XB_TMO])) break; if (sp > XB_SPIN_CAP) { atomicAdd(&bar[XB_TMO], 1u); break; } }
    }
    nloc = mine > 0u ? mine : 1u; nx = cnt > 0u ? cnt : 1u;
}
DEVI void xcd_barrier(const XcdBarrier& b) {
    asm volatile("s_waitcnt vmcnt(0)" ::: "memory");
    __syncthreads();
    if (threadIdx.x == 0) {
        unsigned* bar = b.bar;
        __builtin_amdgcn_s_waitcnt(0);
        unsigned nloc = b.st[0], nx = b.st[1];
        if (nloc == 0u) { xcd_barrier_complete(bar, b.x, nloc, nx); b.st[0] = nloc; b.st[1] = nx; }
        const unsigned old = xb_add(&bar[XB_XSUB(b.x)], 1u);
        const unsigned gen = old / nloc;
        if (old + 1u == (gen + 1u) * nloc) {
            __builtin_amdgcn_fence(__ATOMIC_RELEASE, "agent");
            asm volatile("s_waitcnt vmcnt(0)" ::: "memory");
            const unsigned og = xb_add(&bar[XB_TOP], 1u);
            const unsigned tg = og / nx;
            if (og + 1u == (tg + 1u) * nx) xb_add(&bar[XB_TOPGEN], 1u);
            else XB_SPIN(xb_ld(&bar[XB_TOPGEN]) == tg, bar);
            __builtin_amdgcn_fence(__ATOMIC_ACQUIRE, "agent");
            xb_add(&bar[XB_XGEN(b.x)], 1u);
            asm volatile("s_waitcnt vmcnt(0)" ::: "memory");
        } else {
            XB_SPIN(xb_ld(&bar[XB_XGEN(b.x)]) == gen, bar);
            __builtin_amdgcn_fence(__ATOMIC_ACQUIRE, "agent");
            asm volatile("s_waitcnt vmcnt(0)" ::: "memory");
        }
    }
    __syncthreads();
}

template <class RowMap, class ColMap, class Epi>
DEVI void gemm_tile(char* lds, int K, const bf16* __restrict__ A, int lda, const float* __restrict__ W, int ldw,
                    RowMap rowmap, ColMap colmap, Epi epi) {
    bf16* sA = (bf16*)lds;
    bf16* sB = sA + 128 * 40;
    const int tid = threadIdx.x, lane = tid & 63, wid = tid >> 6, wm = wid >> 1, wn = wid & 1;
    const int ar = tid >> 2, ac = (tid & 3) * 8;
    const int src_row = rowmap(ar);
    const bf16* aptr = A + (size_t)(src_row < 0 ? 0 : src_row) * lda + ac;
    const int bk = tid >> 4, bn = (tid & 15) * 8;
    const int pcol = colmap(bn);
    const float* wptr = W + (size_t)bk * ldw + (pcol < 0 ? 0 : pcol);
    f32x4 acc[2][4];
#pragma unroll
    for (int a = 0; a < 2; ++a)
#pragma unroll
        for (int b = 0; b < 4; ++b) acc[a][b] = (f32x4){0.f, 0.f, 0.f, 0.f};
    u32x4 ra; f32x4 rb0, rb1;
    ra = (u32x4){0u, 0u, 0u, 0u}; rb0 = (f32x4){0.f, 0.f, 0.f, 0.f}; rb1 = rb0;
    if (src_row >= 0) ra = *(const u32x4*)(aptr);
    if (pcol >= 0) { rb0 = *(const f32x4*)(wptr); rb1 = *(const f32x4*)(wptr + 4); }
    for (int k0 = 0; k0 < K; k0 += 32) {
        *(u32x4*)(sA + ar * 40 + ac) = ra;
#pragma unroll
        for (int j = 0; j < 4; ++j) { sB[(bn + j) * 40 + bk] = (bf16)f2bf(rb0[j]); sB[(bn + 4 + j) * 40 + bk] = (bf16)f2bf(rb1[j]); }
        __syncthreads();
        if (k0 + 32 < K) {
            if (src_row >= 0) ra = *(const u32x4*)(aptr + k0 + 32);
            if (pcol >= 0) { rb0 = *(const f32x4*)(wptr + (size_t)(k0 + 32) * ldw); rb1 = *(const f32x4*)(wptr + (size_t)(k0 + 32) * ldw + 4); }
        }
        bf16x8 af[2], bfr[4];
#pragma unroll
        for (int mf = 0; mf < 2; ++mf) af[mf] = *(const bf16x8*)(sA + (wm * 32 + mf * 16 + (lane & 15)) * 40 + (lane >> 4) * 8);
#pragma unroll
        for (int nf = 0; nf < 4; ++nf) bfr[nf] = *(const bf16x8*)(sB + (wn * 64 + nf * 16 + (lane & 15)) * 40 + (lane >> 4) * 8);
#pragma unroll
        for (int mf = 0; mf < 2; ++mf)
#pragma unroll
            for (int nf = 0; nf < 4; ++nf) acc[mf][nf] = __builtin_amdgcn_mfma_f32_16x16x32_bf16(af[mf], bfr[nf], acc[mf][nf], 0, 0, 0);
        __syncthreads();
    }
    epi(acc, wm, wn, lane);
}
template <class F> DEVI void for_each_acc(const f32x4 (&acc)[2][4], int wm, int wn, int lane, F f) {
#pragma unroll
    for (int mf = 0; mf < 2; ++mf)
#pragma unroll
        for (int nf = 0; nf < 4; ++nf)
#pragma unroll
            for (int j = 0; j < 4; ++j) f(wm * 32 + mf * 16 + (lane >> 4) * 4 + j, wn * 64 + nf * 16 + (lane & 15), acc[mf][nf][j]);
}

template <class Store>
DEVI void gemm_dense(char* lds, int M, int N, int K, const bf16* A, int lda, const float* W, int ldw, Store store, int item0, int nitems_total, int bid, int nb) {
    const int ntn = (N + 127) / 128, ntm = M / 128, nt = ntm * ntn;
    (void)nitems_total;
    for (int it = bid; it < item0 + nt; it += nb) {
        if (it < item0) continue;
        const int t = it - item0, tm = t / ntn, tn = t % ntn;
        gemm_tile(lds, K, A, lda, W, ldw,
                  [&](int r) { return tm * 128 + r; },
                  [&](int c) { const int pc = tn * 128 + c; return pc < N ? pc : -1; },
                  [&](const f32x4 (&acc)[2][4], int wm, int wn, int lane) {
                      for_each_acc(acc, wm, wn, lane, [&](int r, int c, float v) { const int n = tn * 128 + c; if (n < N) store(tm * 128 + r, n, v); });
                  });
    }
}

template <int DK1, int DK2, int DV, class Bias>
DEVI void attn_range(const float* qs, const bf16* K1, int ldk1, const bf16* K2, int ldk2, const bf16* V, int ldv,
                     int j0, int j1, float scale, Bias bias, float& m, float& l, float (&o)[2], int lane) {
    for (int jb = j0; jb < j1; jb += 64) {
        const int j = jb + lane; const bool valid = j < j1;
        float s = -__builtin_inff();
        if (valid) {
            float acc = 0.f;
            const bf16* kr = K1 + (size_t)j * ldk1;
#pragma unroll 4
            for (int d = 0; d < DK1; d += 8) {
                const u32x4 kv = *(const u32x4*)(kr + d); const f32x4 q0 = *(const f32x4*)(qs + d), q1 = *(const f32x4*)(qs + d + 4);
                acc += q0[0] * bflo(kv[0]) + q0[1] * bfhi(kv[0]) + q0[2] * bflo(kv[1]) + q0[3] * bfhi(kv[1])
                     + q1[0] * bflo(kv[2]) + q1[1] * bfhi(kv[2]) + q1[2] * bflo(kv[3]) + q1[3] * bfhi(kv[3]);
            }
            if (DK2 > 0) {
                const bf16* kr2 = K2 + (size_t)j * ldk2;
#pragma unroll 4
                for (int d = 0; d < DK2; d += 8) {
                    const u32x4 kv = *(const u32x4*)(kr2 + d); const f32x4 q0 = *(const f32x4*)(qs + DK1 + d), q1 = *(const f32x4*)(qs + DK1 + d + 4);
                    acc += q0[0] * bflo(kv[0]) + q0[1] * bfhi(kv[0]) + q0[2] * bflo(kv[1]) + q0[3] * bfhi(kv[1])
                         + q1[0] * bflo(kv[2]) + q1[1] * bfhi(kv[2]) + q1[2] * bflo(kv[3]) + q1[3] * bfhi(kv[3]);
                }
            }
            s = acc * scale + bias(j);
        }
        const float cm = wave_max(s);
        const float mn = fmaxf(m, cm);
        const float alpha = __expf(m - mn);
        const float p = __expf(s - mn);
        l = l * alpha + wave_sum(p);
        o[0] *= alpha; o[1] *= alpha;
        m = mn;
        const int cnt = (j1 - jb) < 64 ? (j1 - jb) : 64;
        for (int jj = 0; jj < cnt; ++jj) {
            const float pj = __shfl(p, jj);
            const bf16* vr = V + (size_t)(jb + jj) * ldv;
            if (DV == 128) { const unsigned vv = *(const unsigned*)(vr + lane * 2); o[0] += pj * bflo(vv); o[1] += pj * bfhi(vv); }
            else { o[0] += pj * bf2f(vr[lane]); }
        }
    }
}

struct Args { const float* in[19]; float* out; unsigned char* ws; int ph_lo, ph_hi; };
enum { I_X = 0, I_WR, I_RB, I_EWIN, I_EQN, I_EWQ, I_EKVN, I_EWKV, I_EFB, I_EWOUT, I_OWIN, I_OSINK, I_OWOUT, I_LMG, I_LMB, I_LFG, I_LFB, I_WGU, I_WDN };
enum { PH_CVT = 0, PH_L0_IN, PH_L0_PREP, PH_L0_UP, PH_L0_ATT, PH_L0_OUT, PH_L0_LN1, PH_L0_MOE1, PH_L0_MOE2, PH_L0_LN2,
       PH_L1_IN, PH_L1_KM, PH_L1_ATT, PH_L1_OUT, PH_L1_LN1, PH_L1_MOE1, PH_L1_MOE2, PH_L1_LN2, NPH };

DEVI void ln_row(const float* hrow, float a, const float* y0, const float* y1, const float* g, const float* bta, int lane, f32x4 (&v)[8]) {
    float s = 0.f;
#pragma unroll
    for (int j = 0; j < 8; ++j) {
        f32x4 x = *(const f32x4*)(hrow + 4 * lane + 256 * j) * a;
        if (y0) x += *(const f32x4*)(y0 + 4 * lane + 256 * j);
        if (y1) x += *(const f32x4*)(y1 + 4 * lane + 256 * j);
        v[j] = x; s += (x[0] + x[1]) + (x[2] + x[3]);
    }
    const float mean = wave_sum(s) * (1.f / DM);
    float s2 = 0.f;
#pragma unroll
    for (int j = 0; j < 8; ++j) { v[j] = v[j] - mean; s2 += (v[j][0] * v[j][0] + v[j][1] * v[j][1]) + (v[j][2] * v[j][2] + v[j][3] * v[j][3]); }
    const float rstd = 1.f / sqrtf(wave_sum(s2) * (1.f / DM) + LN_EPS);
#pragma unroll
    for (int j = 0; j < 8; ++j) v[j] = v[j] * rstd * *(const f32x4*)(g + 4 * lane + 256 * j) + *(const f32x4*)(bta + 4 * lane + 256 * j);
}

DEVI void phase_ln1_route(const Args& a, float* xrow, int layer, const float* pre, float* hf, bf16* hb, int gw, int ngw, int lane) {
    unsigned* ctl = (unsigned*)(a.ws + WS_CTL);
    int* list = (int*)(a.ws + WS_LIST) + layer * NEXP * T;
    float* ew = (float*)(a.ws + WS_EW);
    const float* g = a.in[I_LMG] + layer * DM; const float* bta = a.in[I_LMB] + layer * DM;
    const float* wr = a.in[I_WR]; const float* rb = a.in[I_RB];
    for (int t = gw; t < T; t += ngw) {
        f32x4 v[8];
        ln_row(pre + (size_t)t * DM, 1.f, nullptr, nullptr, g, bta, lane, v);
#pragma unroll
        for (int j = 0; j < 8; ++j) {
            *(f32x4*)(hf + (size_t)t * DM + 4 * lane + 256 * j) = v[j];
            uint2 w; w.x = pk2(v[j][0], v[j][1]); w.y = pk2(v[j][2], v[j][3]);
            *(uint2*)(hb + (size_t)t * DM + 4 * lane + 256 * j) = w;
        }
#pragma unroll
        for (int j = 0; j < 8; ++j) *(f32x4*)(xrow + 4 * lane + 256 * j) = v[j];
        __builtin_amdgcn_s_waitcnt(0); __builtin_amdgcn_wave_barrier();
        float acc = 0.f;
        {
            const int e = lane & 31, i0 = (lane >> 5) * 1024;
            const float* wp = wr + (size_t)i0 * NEXP + e;
#pragma unroll 8
            for (int i = 0; i < 1024; ++i) acc += xrow[i0 + i] * wp[(size_t)i * NEXP];
        }
        acc += __shfl_xor(acc, 32);
        const float affl = 1.f / (1.f + __expf(-acc));
        const float sell = affl + rb[lane & 31];
        __builtin_amdgcn_wave_barrier();
        int best = 0; float bests = -__builtin_inff();
#pragma unroll
        for (int gI = 0; gI < 8; ++gI) {
            float m1 = -__builtin_inff(), m2 = -__builtin_inff();
#pragma unroll
            for (int q = 0; q < 4; ++q) { const float x = __shfl(sell, gI * 4 + q); if (x > m1) { m2 = m1; m1 = x; } else if (x > m2) m2 = x; }
            const float sc = m1 + m2;
            if (sc > bests) { bests = sc; best = gI; }
        }
        int e1 = 0, e2 = 0; float s1 = -__builtin_inff(), s2 = -__builtin_inff(), a1 = 0.f, a2 = 0.f;
#pragma unroll
        for (int q = 0; q < 4; ++q) {
            const float af = __shfl(affl, best * 4 + q), x = __shfl(sell, best * 4 + q);
            if (x > s1) { s2 = s1; e2 = e1; a2 = a1; s1 = x; e1 = best * 4 + q; a1 = af; } else if (x > s2) { s2 = x; e2 = best * 4 + q; a2 = af; }
        }
        if (lane == 0) {
            const float inv = 1.f / (a1 + a2);
            ew[t * 2 + 0] = a1 * inv; ew[t * 2 + 1] = a2 * inv;
            const unsigned p1 = atomicAdd(&ctl[CW_CNT + layer * NEXP + e1], 1u); list[e1 * T + p1] = t * 2 + 0;
            const unsigned p2 = atomicAdd(&ctl[CW_CNT + layer * NEXP + e2], 1u); list[e2 * T + p2] = t * 2 + 1;
        }
    }
}

DEVI void phase_moe(const Args& a, char* lds, int layer, int stage, const bf16* hb, int bid, int nb) {
    unsigned* ctl = (unsigned*)(a.ws + WS_CTL);
    const int* list = (const int*)(a.ws + WS_LIST) + layer * NEXP * T;
    const float* ew = (const float*)(a.ws + WS_EW);
    bf16* hdn = (bf16*)(a.ws + WS_HDN);
    float* Y = (float*)(a.ws + WS_Y);
    int* sh = (int*)(lds + 32768);
    const int ntn = stage == 1 ? 8 : 16;
    if (threadIdx.x == 0) {
        int so = 0, to = 0;
        for (int e = 0; e < NEXP; ++e) { const int c = (int)ctl[CW_CNT + layer * NEXP + e]; sh[e] = so; sh[33 + e] = to; so += c; to += ((c + 127) / 128) * ntn; }
        sh[32] = so; sh[33 + 32] = to;
    }
    __syncthreads();
    const int total = sh[33 + 32];
    for (int it = bid; it < total; it += nb) {
        int e = 0;
        while (sh[33 + e + 1] <= it) ++e;
        const int r = it - sh[33 + e], tm = r / ntn, tn = r % ntn;
        const int cnt = sh[e + 1] - sh[e], soff = sh[e];
        const int* le = list + e * T;
        if (stage == 1) {
            const float* W = a.in[I_WGU] + (size_t)(layer * NEXP + e) * DM * (2 * FF);
            gemm_tile(lds, DM, hb, DM, W, 2 * FF,
                      [&](int rr) { const int i = tm * 128 + rr; return i < cnt ? (le[i] >> 1) : -1; },
                      [&](int c) { const int gI = c >> 4; return ((gI & 1) ? FF : 0) + tn * 64 + (gI >> 1) * 16 + (c & 15); },
                      [&](const f32x4 (&acc)[2][4], int wm, int wn, int lane) {
#pragma unroll
                          for (int mf = 0; mf < 2; ++mf)
#pragma unroll
                              for (int h2 = 0; h2 < 2; ++h2)
#pragma unroll
                                  for (int j = 0; j < 4; ++j) {
                                      const int row = tm * 128 + wm * 32 + mf * 16 + (lane >> 4) * 4 + j;
                                      const int col = tn * 64 + (wn * 2 + h2) * 16 + (lane & 15);
                                      const float gv = acc[mf][2 * h2][j], uv = acc[mf][2 * h2 + 1][j];
                                      const float hv = gv / (1.f + __expf(-gv)) * uv;
                                      if (row < cnt) hdn[(size_t)(soff + row) * FF + col] = (bf16)f2bf(hv);
                                  }
                      });
        } else {
            const float* W = a.in[I_WDN] + (size_t)(layer * NEXP + e) * FF * DM;
            gemm_tile(lds, FF, hdn, FF, W, DM,
                      [&](int rr) { const int i = tm * 128 + rr; return i < cnt ? (soff + i) : -1; },
                      [&](int c) { return tn * 128 + c; },
                      [&](const f32x4 (&acc)[2][4], int wm, int wn, int lane) {
                          for_each_acc(acc, wm, wn, lane, [&](int rr, int c, float v) {
                              const int i = tm * 128 + rr;
                              if (i < cnt) { const int ent = le[i]; Y[(size_t)ent * DM + tn * 128 + c] = ew[ent] * v; }
                          });
                      });
        }
    }
    __syncthreads();
}

DEVI void phase_ln2(const Args& a, int layer, const float* hf, float* of, bf16* ob, int gw, int ngw, int lane) {
    const float* Y = (const float*)(a.ws + WS_Y);
    const float* g = a.in[I_LFG] + layer * DM; const float* bta = a.in[I_LFB] + layer * DM;
    for (int t = gw; t < T; t += ngw) {
        f32x4 v[8];
        ln_row(hf + (size_t)t * DM, ALPHA, Y + (size_t)(2 * t) * DM, Y + (size_t)(2 * t + 1) * DM, g, bta, lane, v);
#pragma unroll
        for (int j = 0; j < 8; ++j) {
            *(f32x4*)(of + (size_t)t * DM + 4 * lane + 256 * j) = v[j];
            if (ob) { uint2 w; w.x = pk2(v[j][0], v[j][1]); w.y = pk2(v[j][2], v[j][3]); *(uint2*)(ob + (size_t)t * DM + 4 * lane + 256 * j) = w; }
        }
    }
}

__global__ void __launch_bounds__(NTHREADS, 2) fwd(Args a) {
    extern __shared__ __attribute__((aligned(16))) char lds[];
    const int tid = threadIdx.x, lane = tid & 63, wid = tid >> 6;
    const int bid = blockIdx.x, nb = gridDim.x;
    const int gw = bid * NWAVES + wid, ngw = nb * NWAVES;
    unsigned char* ws = a.ws;
    unsigned* ctl = (unsigned*)(ws + WS_CTL);
    float* FL = (float*)(ws + WS_FL); float* LF = (float*)(ws + WS_LF); float* CUM = (float*)(ws + WS_CUM); float* KM = (float*)(ws + WS_KM);
    bf16* KPE = (bf16*)(ws + WS_KPE); bf16* XB = (bf16*)(ws + WS_XB); bf16* HB = (bf16*)(ws + WS_HB);
    float* HFA = (float*)(ws + WS_HFA); float* HFB = (float*)(ws + WS_HFB); float* PRE = (float*)(ws + WS_PRE);
    bf16* P = (bf16*)(ws + WS_P); bf16* CQN = (bf16*)(ws + WS_CQN); bf16* CKVN = (bf16*)(ws + WS_CKVN);
    bf16* QM = (bf16*)(ws + WS_QM); bf16* KVM = (bf16*)(ws + WS_KVM); bf16* AO = (bf16*)(ws + WS_AO);

    volatile LAS unsigned* xbw = (volatile LAS unsigned*)((LAS char*)lds + LDS_BYTES - 16);
    if (tid < 4) xbw[tid] = 0u;
    __syncthreads();
    XcdBarrier bar; bar.bar = ctl + CW_BAR; bar.x = 0; bar.st = xbw;
#if ONE_LAUNCH
    bar = xcd_barrier_post(ctl + CW_BAR, xbw);
#define SEAM(k) do { if ((k) + 1 < a.ph_hi) xcd_barrier(bar); } while (0)
#else
#define SEAM(k) do { } while (0)
#endif
#define IN(k) (a.ph_lo <= (k) && (k) < a.ph_hi)

    if (IN(PH_CVT)) {
        const float* x = a.in[I_X];
        for (size_t i = (size_t)bid * NTHREADS + tid; i < (size_t)T * DM / 8; i += (size_t)nb * NTHREADS) {
            const f32x4 v0 = *(const f32x4*)(x + i * 8), v1 = *(const f32x4*)(x + i * 8 + 4);
            u32x4 w; w[0] = pk2(v0[0], v0[1]); w[1] = pk2(v0[2], v0[3]); w[2] = pk2(v1[0], v1[1]); w[3] = pk2(v1[2], v1[3]);
            *(u32x4*)(XB + i * 8) = w;
        }
        SEAM(PH_CVT);
    }
    if (IN(PH_L0_IN)) {
        gemm_dense(lds, T, EVEN_IN, DM, XB, DM, a.in[I_EWIN], EVEN_IN,
                   [&](int m, int n, float v) { P[(size_t)m * LDP + n] = (bf16)f2bf(v); if (n >= E_FL) FL[m * 8 + (n - E_FL)] = v; }, 0, 0, bid, nb);
        SEAM(PH_L0_IN);
    }
    if (IN(PH_L0_PREP)) {
        const float* qn = a.in[I_EQN]; const float* kvn = a.in[I_EKVN]; const float* fb = a.in[I_EFB];
        for (int t = gw; t < T; t += ngw) {
            const bf16* pr = P + (size_t)t * LDP;
            {
                const u32x4 w = *(const u32x4*)(pr + E_CQ + lane * 8);
                float x[8] = {bflo(w[0]), bfhi(w[0]), bflo(w[1]), bfhi(w[1]), bflo(w[2]), bfhi(w[2]), bflo(w[3]), bfhi(w[3])};
                float ss = 0.f;
#pragma unroll
                for (int i = 0; i < 8; ++i) ss += x[i] * x[i];
                const float r = 1.f / sqrtf(wave_sum(ss) * (1.f / 512.f) + RMS_EPS);
                u32x4 o;
#pragma unroll
                for (int i = 0; i < 4; ++i) o[i] = pk2(x[2 * i] * r * qn[lane * 8 + 2 * i], x[2 * i + 1] * r * qn[lane * 8 + 2 * i + 1]);
                *(u32x4*)(CQN + (size_t)t * 512 + lane * 8) = o;
            }
            {
                const uint2 w = *(const uint2*)(pr + E_CKV + lane * 4);
                float x[4] = {bflo(w.x), bfhi(w.x), bflo(w.y), bfhi(w.y)};
                float ss = x[0] * x[0] + x[1] * x[1] + x[2] * x[2] + x[3] * x[3];
                const float r = 1.f / sqrtf(wave_sum(ss) * (1.f / 256.f) + RMS_EPS);
                uint2 o; o.x = pk2(x[0] * r * kvn[lane * 4], x[1] * r * kvn[lane * 4 + 1]); o.y = pk2(x[2] * r * kvn[lane * 4 + 2], x[3] * r * kvn[lane * 4 + 3]);
                *(uint2*)(CKVN + (size_t)t * 256 + lane * 4) = o;
            }
            if (lane < 32) {
                const float t1 = bf2f(pr[E_KR + lane]), t2 = bf2f(pr[E_KR + 32 + lane]);
                float c, s; rope_cs(t % S, lane, c, s);
                KPE[(size_t)t * 64 + lane] = (bf16)f2bf(t1 * c - t2 * s);
                KPE[(size_t)t * 64 + 32 + lane] = (bf16)f2bf(t1 * s + t2 * c);
            }
            if (lane < 8) {
                const float x = FL[t * 8 + lane] + fb[lane];
                LF[t * 8 + lane] = fminf(x, 0.f) - log1pf(__expf(-fabsf(x)));
            }
        }
        SEAM(PH_L0_PREP);
    }
    if (IN(PH_L0_UP)) {
        if (gw < 16) {
            const int b = gw >> 3, h = gw & 7;
            double loc = 0.0;
            for (int i = 0; i < 64; ++i) loc += (double)LF[(size_t)(b * S + lane * 64 + i) * 8 + h];
            double inc = loc;
#pragma unroll
            for (int o = 1; o < 64; o <<= 1) { const double nbv = __shfl_up(inc, o); if (lane >= o) inc += nbv; }
            double run = inc - loc;
            for (int i = 0; i < 64; ++i) { run += (double)LF[(size_t)(b * S + lane * 64 + i) * 8 + h]; CUM[(size_t)gw * S + lane * 64 + i] = (float)run; }
        }
        const int n1 = (T / 128) * (1536 / 128);
        gemm_dense(lds, T, 1536, 512, CQN, 512, a.in[I_EWQ], 1536, [&](int m, int n, float v) { QM[(size_t)m * 1536 + n] = (bf16)f2bf(v); }, 0, 0, bid, nb);
        gemm_dense(lds, T, 2048, 256, CKVN, 256, a.in[I_EWKV], 2048, [&](int m, int n, float v) { KVM[(size_t)m * 2048 + n] = (bf16)f2bf(v); }, n1 % nb, 0, bid, nb);
        SEAM(PH_L0_UP);
    }
    if (IN(PH_L0_ATT)) {
        float* qs = (float*)lds + wid * 256;
        const int nitems = 2 * 16 * S;
        for (int it = gw; it < nitems; it += ngw) {
            const int grp = it / S; int t = it % S; if (grp & 1) t = S - 1 - t;
            const int type = grp >> 4, bh = grp & 15, b = bh >> 3, h = bh & 7;
            const size_t tok = (size_t)b * S + t;
            float m = -1e30f, l = 0.f, o[2] = {0.f, 0.f};
            if (type == 0) {
                const bf16* qr = QM + tok * 1536 + h * 192;
                qs[lane] = bf2f(qr[lane]); qs[64 + lane] = bf2f(qr[64 + lane]);
                if (lane < 32) { const float t1 = bf2f(qr[128 + lane]), t2 = bf2f(qr[160 + lane]); float c, s; rope_cs(t, lane, c, s);
                    qs[128 + lane] = t1 * c - t2 * s; qs[160 + lane] = t1 * s + t2 * c; }
                __builtin_amdgcn_s_waitcnt(0); __builtin_amdgcn_wave_barrier();
                attn_range<128, 64, 128>(qs, KVM + (size_t)b * S * 2048 + h * 256, 2048, KPE + (size_t)b * S * 64, 64, KVM + (size_t)b * S * 2048 + h * 256 + 128, 2048,
                                         0, t + 1, 0.07216878364870322f, [&](int) { return 0.f; }, m, l, o, lane);
                *(unsigned*)(AO + tok * 2048 + h * 128 + lane * 2) = pk2(o[0] / l, o[1] / l);
            } else {
                const bf16* qr = P + tok * LDP + E_FQ + h * 128;
                qs[lane] = bf2f(qr[lane]); qs[64 + lane] = bf2f(qr[64 + lane]);
                __builtin_amdgcn_s_waitcnt(0); __builtin_amdgcn_wave_barrier();
                const float* cum = CUM + (size_t)bh * S; const float cq = cum[t];
                attn_range<128, 0, 128>(qs, P + (size_t)b * S * LDP + E_FK + h * 128, LDP, nullptr, 0, P + (size_t)b * S * LDP + E_FV + h * 128, LDP,
                                        0, t + 1, 0.08838834764831845f, [&](int j) { return cq - cum[j]; }, m, l, o, lane);
                *(unsigned*)(AO + tok * 2048 + 1024 + h * 128 + lane * 2) = pk2(o[0] / l, o[1] / l);
            }
            __builtin_amdgcn_wave_barrier();
        }
        SEAM(PH_L0_ATT);
    }
    if (IN(PH_L0_OUT)) {
        const float* x = a.in[I_X];
        gemm_dense(lds, T, DM, DM, AO, DM, a.in[I_EWOUT], DM, [&](int m, int n, float v) { PRE[(size_t)m * DM + n] = ALPHA * x[(size_t)m * DM + n] + v; }, 0, 0, bid, nb);
        SEAM(PH_L0_OUT);
    }
    if (IN(PH_L0_LN1)) { phase_ln1_route(a, (float*)lds + wid * 2048, 0, PRE, HFA, HB, gw, ngw, lane); SEAM(PH_L0_LN1); }
    if (IN(PH_L0_MOE1)) { phase_moe(a, lds, 0, 1, HB, bid, nb); SEAM(PH_L0_MOE1); }
    if (IN(PH_L0_MOE2)) { phase_moe(a, lds, 0, 2, HB, bid, nb); SEAM(PH_L0_MOE2); }
    if (IN(PH_L0_LN2)) { phase_ln2(a, 0, HFA, HFB, XB, gw, ngw, lane); SEAM(PH_L0_LN2); }

    if (IN(PH_L1_IN)) {
        gemm_dense(lds, T, ODD_IN, DM, XB, DM, a.in[I_OWIN], ODD_IN, [&](int m, int n, float v) { P[(size_t)m * LDP + n] = (bf16)f2bf(v); }, 0, 0, bid, nb);
        SEAM(PH_L1_IN);
    }
    if (IN(PH_L1_KM)) {
        for (int it = gw; it < 2 * 8 * 16; it += ngw) {
            const int b = it >> 7, h = (it >> 4) & 7, n = it & 15;
            float s0 = 0.f, s1 = 0.f;
            for (int j = 0; j < 256; ++j) { const unsigned w = *(const unsigned*)(P + ((size_t)b * S + n * 256 + j) * LDP + O_MK + h * 128 + lane * 2); s0 += bflo(w); s1 += bfhi(w); }
            KM[(size_t)it * 128 + lane * 2] = s0 * (1.f / 256.f); KM[(size_t)it * 128 + lane * 2 + 1] = s1 * (1.f / 256.f);
        }
        SEAM(PH_L1_KM);
    }
    if (IN(PH_L1_ATT)) {
        float* qs = (float*)lds + wid * 256;
        const float* sinks = a.in[I_OSINK];
        const int n_swa = 2 * 16 * S, n_moba = 2 * 8 * S;
        for (int it = gw; it < n_swa + n_moba; it += ngw) {
            float m = -1e30f, l = 0.f, o[2] = {0.f, 0.f};
            if (it < n_swa) {
                const int t = it % S, bh = it / S, b = bh >> 4, qh = bh & 15, kvh = qh >> 3;
                const size_t tok = (size_t)b * S + t;
                qs[lane] = bf2f(P[tok * LDP + O_SQ + qh * 64 + lane]);
                __builtin_amdgcn_s_waitcnt(0); __builtin_amdgcn_wave_barrier();
                const float slope = exp2f(-0.5f * (float)(qh + 1));
                const int j0 = t - 127 > 0 ? t - 127 : 0;
                attn_range<64, 0, 64>(qs, P + (size_t)b * S * LDP + O_SK + kvh * 64, LDP, nullptr, 0, P + (size_t)b * S * LDP + O_SV + kvh * 64, LDP,
                                      j0, t + 1, 0.125f, [&](int j) { return -slope * (float)(t - j); }, m, l, o, lane);
                const float sk = sinks[qh];
                const float mf = fmaxf(m, sk), al = __expf(m - mf);
                l = l * al + __expf(sk - mf); o[0] *= al;
                AO[tok * 2048 + qh * 64 + lane] = (bf16)f2bf(o[0] / l);
            } else {
                const int i2 = it - n_swa, t = i2 % S, bh = i2 / S, b = bh >> 3, h = bh & 7;
                const size_t tok = (size_t)b * S + t;
                const bf16* qr = P + tok * LDP + O_MQ + h * 128;
                qs[lane] = bf2f(qr[lane]); qs[64 + lane] = bf2f(qr[64 + lane]);
                __builtin_amdgcn_s_waitcnt(0); __builtin_amdgcn_wave_barrier();
                const int blk = t >> 8;
                float gate = -__builtin_inff();
                if (lane < blk) { const float* km = KM + ((size_t)bh * 16 + lane) * 128; float acc = 0.f; for (int d = 0; d < 128; ++d) acc += qs[d] * km[d]; gate = acc; }
                const float slope = exp2f(-(float)(h + 1));
                const bf16* Kb = P + (size_t)b * S * LDP + O_MK + h * 128; const bf16* Vb = P + (size_t)b * S * LDP + O_MV + h * 128;
                auto bias = [&](int j) { return -slope * (float)(t - j); };
                for (int r = 0; r < 3; ++r) {
                    float bv = -__builtin_inff(); int bi = -1;
                    for (int n = 0; n < 16; ++n) { const float gv = __shfl(gate, n); if (gv > bv) { bv = gv; bi = n; } }
                    if (bi < 0) break;
                    if (lane == bi) gate = -__builtin_inff();
                    attn_range<128, 0, 128>(qs, Kb, LDP, nullptr, 0, Vb, LDP, bi * 256, bi * 256 + 256, 0.08838834764831845f, bias, m, l, o, lane);
                }
                attn_range<128, 0, 128>(qs, Kb, LDP, nullptr, 0, Vb, LDP, blk * 256, t + 1, 0.08838834764831845f, bias, m, l, o, lane);
                *(unsigned*)(AO + tok * 2048 + 1024 + h * 128 + lane * 2) = pk2(o[0] / l, o[1] / l);
            }
            __builtin_amdgcn_wave_barrier();
        }
        SEAM(PH_L1_ATT);
    }
    if (IN(PH_L1_OUT)) {
        gemm_dense(lds, T, DM, DM, AO, DM, a.in[I_OWOUT], DM, [&](int m, int n, float v) { PRE[(size_t)m * DM + n] = ALPHA * HFB[(size_t)m * DM + n] + v; }, 0, 0, bid, nb);
        SEAM(PH_L1_OUT);
    }
    if (IN(PH_L1_LN1)) { phase_ln1_route(a, (float*)lds + wid * 2048, 1, PRE, HFA, HB, gw, ngw, lane); SEAM(PH_L1_LN1); }
    if (IN(PH_L1_MOE1)) { phase_moe(a, lds, 1, 1, HB, bid, nb); SEAM(PH_L1_MOE1); }
    if (IN(PH_L1_MOE2)) { phase_moe(a, lds, 1, 2, HB, bid, nb); SEAM(PH_L1_MOE2); }
    if (IN(PH_L1_LN2)) { phase_ln2(a, 1, HFA, a.out, nullptr, gw, ngw, lane); }
#undef IN
#undef SEAM
}

extern "C" void kernel_launch(void* const* d_in, const int* in_sizes, int n_in, void* d_out, int out_size, void* d_ws, size_t ws_size, hipStream_t stream) {
    static int grid = 0;
    if (grid == 0) {
        if (n_in != 19 || out_size != T * DM || ws_size < WS_END) { fprintf(stderr, "kernel_launch: unexpected shapes (n_in %d out %d ws %zu)\n", n_in, out_size, ws_size); grid = -1; return; }
        int dev = 0, cus = 0;
        if (hipGetDevice(&dev) != hipSuccess || hipDeviceGetAttribute(&cus, hipDeviceAttributeMultiprocessorCount, dev) != hipSuccess || cus <= 0) cus = 256;
        (void)hipFuncSetAttribute((const void*)fwd, hipFuncAttributeMaxDynamicSharedMemorySize, LDS_BYTES);
        int per_cu = 0;
        if (hipOccupancyMaxActiveBlocksPerMultiprocessor(&per_cu, (const void*)fwd, NTHREADS, LDS_BYTES) != hipSuccess || per_cu < 1) fprintf(stderr, "kernel_launch: occupancy query says %d\n", per_cu);
        (void)hipGetLastError();
        grid = cus;
    }
    if (grid < 0) return;
    (void)in_sizes;
    (void)hipMemsetAsync((char*)d_ws + WS_CTL, 0, CTL_BYTES, stream);
    Args a{};
    for (int i = 0; i < 19; ++i) a.in[i] = (const float*)d_in[i];
    a.out = (float*)d_out; a.ws = (unsigned char*)d_ws;
#if ONE_LAUNCH
    a.ph_lo = 0; a.ph_hi = NPH;
    hipLaunchKernelGGL(fwd, dim3(grid), dim3(NTHREADS), LDS_BYTES, stream, a);
#else
    for (int p = 0; p < NPH; ++p) { a.ph_lo = p; a.ph_hi = p + 1; hipLaunchKernelGGL(fwd, dim3(grid), dim3(NTHREADS), LDS_BYTES, stream, a); }
#endif
}
```

```cpp
#include <hip/hip_runtime.h>
#include <stdint.h>
#include <stdio.h>

#ifndef ONE_LAUNCH
#define ONE_LAUNCH 1
#endif

#define DEVI __device__ __forceinline__
#define LAS __attribute__((address_space(3)))
typedef unsigned short bf16;
typedef short bf16x8 __attribute__((ext_vector_type(8)));
typedef float f32x4 __attribute__((ext_vector_type(4)));
typedef unsigned u32x4 __attribute__((ext_vector_type(4)));

constexpr int S = 4096, NBATCH = 2, T = NBATCH * S, DM = 2048;
constexpr int LDP = 4352;
constexpr int EVEN_IN = 3912, ODD_IN = 4352;
constexpr float LN_EPS = 1e-5f, RMS_EPS = 1e-6f;
constexpr float ALPHA = 1.4142135623730951f;
constexpr int NEXP = 32, FF = 512;
constexpr int E_CQ = 0, E_CKV = 512, E_KR = 768, E_FQ = 832, E_FK = 1856, E_FV = 2880, E_FL = 3904;
constexpr int O_SQ = 0, O_SK = 1024, O_SV = 1152, O_MQ = 1280, O_MK = 2304, O_MV = 3328;

constexpr size_t MiB = 1u << 20;
constexpr size_t WS_CTL = 0, CTL_BYTES = 1 * MiB;
constexpr int CW_CNT = 1024;
constexpr int CW_BAR = 4096;
constexpr int CW_Q = 1100;
constexpr size_t WS_LIST = 2 * MiB;
constexpr size_t WS_EW = 4 * MiB;
constexpr size_t WS_FL = 5 * MiB;
constexpr size_t WS_LF = 5 * MiB + 512 * 1024;
constexpr size_t WS_CUM = 6 * MiB;
constexpr size_t WS_KM = 6 * MiB + 512 * 1024;
constexpr size_t WS_KPE = 7 * MiB;
constexpr size_t WS_XB = 16 * MiB;
constexpr size_t WS_HB = 48 * MiB;
constexpr size_t WS_HFA = 80 * MiB;
constexpr size_t WS_HFB = 144 * MiB;
constexpr size_t WS_PRE = 208 * MiB;
constexpr size_t WS_P = 272 * MiB;
constexpr size_t WS_CQN = 340 * MiB;
constexpr size_t WS_CKVN = 348 * MiB;
constexpr size_t WS_QM = 352 * MiB;
constexpr size_t WS_KVM = 376 * MiB;
constexpr size_t WS_AO = 408 * MiB;
constexpr size_t WS_HDN = 440 * MiB;
constexpr size_t WS_Y = 464 * MiB;
constexpr size_t WS_END = 600 * MiB;

constexpr int LDS_BYTES = 98304;
constexpr int NTHREADS = 512, NWAVES = 8;

DEVI unsigned f2bf(float f) { unsigned u = __float_as_uint(f); return (u + 0x7fffu + ((u >> 16) & 1u)) >> 16; }
DEVI float bf2f(unsigned b) { return __uint_as_float(b << 16); }
DEVI float bflo(unsigned w) { return __uint_as_float(w << 16); }
DEVI float bfhi(unsigned w) { return __uint_as_float(w & 0xffff0000u); }
DEVI unsigned pk2(float lo, float hi) { return f2bf(lo) | (f2bf(hi) << 16); }
DEVI float wave_sum(float v) {
#pragma unroll
    for (int o = 1; o < 64; o <<= 1) v += __shfl_xor(v, o);
    return v;
}
DEVI float wave_max(float v) {
#pragma unroll
    for (int o = 1; o < 64; o <<= 1) v = fmaxf(v, __shfl_xor(v, o));
    return v;
}
DEVI void rope_cs(int t, int i, float& c, float& s) {
    const float inv_freq = exp2f(-(float)i * (13.287712379549449f / 32.0f));
    double rev = (double)t * (double)inv_freq * 0.15915494309189535;
    rev -= floor(rev);
    const float a = (float)(rev * 6.283185307179586);
    c = __cosf(a); s = __sinf(a);
}

#define XB_TMO      128
#define XB_XCNT(j)  (256  + 64 * (j))
#define XB_XSUB(j)  (1280 + 64 * (j))
#define XB_XGEN(j)  (2304 + 64 * (j))
#define XB_TOP      3328
#define XB_TOPGEN   3392
#define XCD_BAR_WORDS 3456
#define XB_SPIN_CAP (1u << 18)
DEVI unsigned xb_ld(unsigned* p)              { return __hip_atomic_load(p, __ATOMIC_RELAXED, __HIP_MEMORY_SCOPE_AGENT); }
DEVI unsigned xb_add(unsigned* p, unsigned v) { return __hip_atomic_fetch_add(p, v, __ATOMIC_RELAXED, __HIP_MEMORY_SCOPE_AGENT); }
DEVI unsigned xb_xcc_id() { return (unsigned)__builtin_amdgcn_s_getreg((3 << 11) | 20) & 0xFu; }
#define XB_SPIN(cond, bar) do { unsigned _sp = 0; while (cond) { __builtin_amdgcn_s_sleep(1); \
    if ((++_sp & 255u) == 0u) { if (xb_ld(&(bar)[XB_TMO])) break; if (_sp > XB_SPIN_CAP) { atomicAdd(&(bar)[XB_TMO], 1u); break; } } } } while (0)
struct XcdBarrier { unsigned* bar; unsigned x; volatile LAS unsigned* st; };
DEVI XcdBarrier xcd_barrier_post(unsigned* bar, volatile LAS unsigned* st) {
    XcdBarrier b; b.bar = bar; b.x = xb_xcc_id(); b.st = st;
    if (threadIdx.x == 0) (void)xb_add(&bar[XB_XCNT(b.x)], 1u);
    return b;
}
DEVI void xcd_barrier_complete(unsigned* bar, unsigned x, unsigned& nloc, unsigned& nx) {
    const unsigned G = gridDim.x * gridDim.y * gridDim.z;
    unsigned sum, cnt, mine, sp = 0u;
    for (;;) {
        sum = 0u; cnt = 0u; mine = 0u;
#pragma unroll
        for (unsigned j = 0; j < 16; ++j) { const unsigned c = xb_ld(&bar[XB_XCNT(j)]); sum += c; cnt += (c > 0u) ? 1u : 0u; mine = (j == x) ? c : mine; }
        if (sum == G) break;
        __builtin_amdgcn_s_sleep(1);
        if ((++sp & 255u) == 0u) { if (xb_ld(&bar[XB_TMO])) break; if (sp > XB_SPIN_CAP) { atomicAdd(&bar[XB_TMO], 1u); break; } }
    }
    nloc = mine > 0u ? mine : 1u; nx = cnt > 0u ? cnt : 1u;
}
DEVI void xcd_barrier(const XcdBarrier& b) {
    asm volatile("s_waitcnt vmcnt(0)" ::: "memory");
    __syncthreads();
    if (threadIdx.x == 0) {
        unsigned* bar = b.bar;
        __builtin_amdgcn_s_waitcnt(0);
        unsigned nloc = b.st[0], nx = b.st[1];
        if (nloc == 0u) { xcd_barrier_complete(bar, b.x, nloc, nx); b.st[0] = nloc; b.st[1] = nx; }
        const unsigned old = xb_add(&bar[XB_XSUB(b.x)], 1u);
        const unsigned gen = old / nloc;
        if (old + 1u == (gen + 1u) * nloc) {
            __builtin_amdgcn_fence(__ATOMIC_RELEASE, "agent");
            asm volatile("s_waitcnt vmcnt(0)" ::: "memory");
            const unsigned og = xb_add(&bar[XB_TOP], 1u);
            const unsigned tg = og / nx;
            if (og + 1u == (tg + 1u) * nx) xb_add(&bar[XB_TOPGEN], 1u);
            else XB_SPIN(xb_ld(&bar[XB_TOPGEN]) == tg, bar);
            __builtin_amdgcn_fence(__ATOMIC_ACQUIRE, "agent");
            xb_add(&bar[XB_XGEN(b.x)], 1u);
            asm volatile("s_waitcnt vmcnt(0)" ::: "memory");
        } else {
            XB_SPIN(xb_ld(&bar[XB_XGEN(b.x)]) == gen, bar);
            __builtin_amdgcn_fence(__ATOMIC_ACQUIRE, "agent");
            asm volatile("s_waitcnt vmcnt(0)" ::: "memory");
        }
    }
    __syncthreads();
}

template <class RowMap, class ColMap, class Epi>
DEVI void gemm_tile(char* lds, int K, const bf16* __restrict__ A, int lda, const float* __restrict__ W, int ldw,
                    RowMap rowmap, ColMap colmap, Epi epi) {
    bf16* sA = (bf16*)lds;
    bf16* sB = sA + 128 * 40;
    const int tid = threadIdx.x, lane = tid & 63, wid = tid >> 6, wm = wid >> 1, wn = wid & 1;
    const int ar = tid >> 2, ac = (tid & 3) * 8;
    const int src_row = rowmap(ar);
    const bf16* aptr = A + (size_t)(src_row < 0 ? 0 : src_row) * lda + ac;
    const int bk = tid >> 4, bn = (tid & 15) * 8;
    const int pcol = colmap(bn);
    const float* wptr = W + (size_t)bk * ldw + (pcol < 0 ? 0 : pcol);
    f32x4 acc[2][4];
#pragma unroll
    for (int a = 0; a < 2; ++a)
#pragma unroll
        for (int b = 0; b < 4; ++b) acc[a][b] = (f32x4){0.f, 0.f, 0.f, 0.f};
    u32x4 ra; f32x4 rb0, rb1;
    ra = (u32x4){0u, 0u, 0u, 0u}; rb0 = (f32x4){0.f, 0.f, 0.f, 0.f}; rb1 = rb0;
    if (src_row >= 0) ra = *(const u32x4*)(aptr);
    if (pcol >= 0) { rb0 = *(const f32x4*)(wptr); rb1 = *(const f32x4*)(wptr + 4); }
    for (int k0 = 0; k0 < K; k0 += 32) {
        *(u32x4*)(sA + ar * 40 + ac) = ra;
#pragma unroll
        for (int j = 0; j < 4; ++j) { sB[(bn + j) * 40 + bk] = (bf16)f2bf(rb0[j]); sB[(bn + 4 + j) * 40 + bk] = (bf16)f2bf(rb1[j]); }
        __syncthreads();
        if (k0 + 32 < K) {
            if (src_row >= 0) ra = *(const u32x4*)(aptr + k0 + 32);
            if (pcol >= 0) { rb0 = *(const f32x4*)(wptr + (size_t)(k0 + 32) * ldw); rb1 = *(const f32x4*)(wptr + (size_t)(k0 + 32) * ldw + 4); }
        }
        bf16x8 af[2], bfr[4];
#pragma unroll
        for (int mf = 0; mf < 2; ++mf) af[mf] = *(const bf16x8*)(sA + (wm * 32 + mf * 16 + (lane & 15)) * 40 + (lane >> 4) * 8);
#pragma unroll
        for (int nf = 0; nf < 4; ++nf) bfr[nf] = *(const bf16x8*)(sB + (wn * 64 + nf * 16 + (lane & 15)) * 40 + (lane >> 4) * 8);
#pragma unroll
        for (int mf = 0; mf < 2; ++mf)
#pragma unroll
            for (int nf = 0; nf < 4; ++nf) acc[mf][nf] = __builtin_amdgcn_mfma_f32_16x16x32_bf16(af[mf], bfr[nf], acc[mf][nf], 0, 0, 0);
        __syncthreads();
    }
    epi(acc, wm, wn, lane);
}
template <class F> DEVI void for_each_acc(const f32x4 (&acc)[2][4], int wm, int wn, int lane, F f) {
#pragma unroll
    for (int mf = 0; mf < 2; ++mf)
#pragma unroll
        for (int nf = 0; nf < 4; ++nf)
#pragma unroll
            for (int j = 0; j < 4; ++j) f(wm * 32 + mf * 16 + (lane >> 4) * 4 + j, wn * 64 + nf * 16 + (lane & 15), acc[mf][nf][j]);
}

template <class Store>
DEVI void gemm_dense(char* lds, int M, int N, int K, const bf16* A, int lda, const float* W, int ldw, Store store, int item0, int nitems_total, int bid, int nb) {
    const int ntn = (N + 127) / 128, ntm = M / 128, nt = ntm * ntn;
    (void)nitems_total;
    for (int it = bid; it < item0 + nt; it += nb) {
        if (it < item0) continue;
        const int t = it - item0, tm = t / ntn, tn = t % ntn;
        gemm_tile(lds, K, A, lda, W, ldw,
                  [&](int r) { return tm * 128 + r; },
                  [&](int c) { const int pc = tn * 128 + c; return pc < N ? pc : -1; },
                  [&](const f32x4 (&acc)[2][4], int wm, int wn, int lane) {
                      for_each_acc(acc, wm, wn, lane, [&](int r, int c, float v) { const int n = tn * 128 + c; if (n < N) store(tm * 128 + r, n, v); });
                  });
    }
}

template <int DK1, int DK2, int DV, class Bias>
DEVI void attn_range(const float* qs, const bf16* K1, int ldk1, const bf16* K2, int ldk2, const bf16* V, int ldv,
                     int j0, int j1, float scale, Bias bias, float& m, float& l, float (&o)[2], int lane) {
    for (int jb = j0; jb < j1; jb += 64) {
        const int j = jb + lane; const bool valid = j < j1;
        float s = -__builtin_inff();
        if (valid) {
            float acc = 0.f;
            const bf16* kr = K1 + (size_t)j * ldk1;
#pragma unroll 4
            for (int d = 0; d < DK1; d += 8) {
                const u32x4 kv = *(const u32x4*)(kr + d); const f32x4 q0 = *(const f32x4*)(qs + d), q1 = *(const f32x4*)(qs + d + 4);
                acc += q0[0] * bflo(kv[0]) + q0[1] * bfhi(kv[0]) + q0[2] * bflo(kv[1]) + q0[3] * bfhi(kv[1])
                     + q1[0] * bflo(kv[2]) + q1[1] * bfhi(kv[2]) + q1[2] * bflo(kv[3]) + q1[3] * bfhi(kv[3]);
            }
            if (DK2 > 0) {
                const bf16* kr2 = K2 + (size_t)j * ldk2;
#pragma unroll 4
                for (int d = 0; d < DK2; d += 8) {
                    const u32x4 kv = *(const u32x4*)(kr2 + d); const f32x4 q0 = *(const f32x4*)(qs + DK1 + d), q1 = *(const f32x4*)(qs + DK1 + d + 4);
                    acc += q0[0] * bflo(kv[0]) + q0[1] * bfhi(kv[0]) + q0[2] * bflo(kv[1]) + q0[3] * bfhi(kv[1])
                         + q1[0] * bflo(kv[2]) + q1[1] * bfhi(kv[2]) + q1[2] * bflo(kv[3]) + q1[3] * bfhi(kv[3]);
                }
            }
            s = acc * scale + bias(j);
        }
        const float cm = wave_max(s);
        const float mn = fmaxf(m, cm);
        const float alpha = __expf(m - mn);
        const float p = __expf(s - mn);
        l = l * alpha + wave_sum(p);
        o[0] *= alpha; o[1] *= alpha;
        m = mn;
        const int cnt = (j1 - jb) < 64 ? (j1 - jb) : 64;
        for (int jj = 0; jj < cnt; ++jj) {
            const float pj = __shfl(p, jj);
            const bf16* vr = V + (size_t)(jb + jj) * ldv;
            if (DV == 128) { const unsigned vv = *(const unsigned*)(vr + lane * 2); o[0] += pj * bflo(vv); o[1] += pj * bfhi(vv); }
            else { o[0] += pj * bf2f(vr[lane]); }
        }
    }
}


typedef short s16x4 __attribute__((ext_vector_type(4)));
typedef float f32x16 __attribute__((ext_vector_type(16)));
constexpr int FA_V = 0, FA_K = 32768, FA_KR = 65536, FA_CUM = 81920, FA_WS = 82432, FA_Q = 84480, FA_KM = 84992, FA_END = 93184;
constexpr int SHM_K = 16384, SHM_V = 16384, SHM_KR = 8192;
#define KSWZ(row, colB) ((row) * 256 + ((colB) ^ (((row) & 7) << 4)))
DEVI int v_st(int k, int c) { const int kk = (k & ~0xC) | ((k & 4) << 1) | ((k & 8) >> 1); return ((kk >> 3) * 4 + (c >> 5)) * 512 + ((kk & 7) * 32 + (c & 31)) * 2; }
DEVI int v_rd_base(int lane) { return ((lane & 3) << 3) | (((lane >> 2) & 3) << 6) | (((lane >> 4) & 1) << 5) | (((lane >> 5) & 1) << 8); }
DEVI int crow(int r, int hi) { return (r & 3) + 8 * (r >> 2) + 4 * hi; }
DEVI unsigned cvtpk(float lo, float hi) { unsigned r; asm volatile("v_cvt_pk_bf16_f32 %0, %1, %2" : "=v"(r) : "v"(lo), "v"(hi)); return r; }
enum { FM_MLA = 0, FM_FOX = 1, FM_MOBA = 2 };

template <int MODE>
DEVI void flash_unit(char* lds, const bf16* Qp, int ldq, const bf16* Kp, int ldk, const bf16* Vp, int ldv, const bf16* KRp,
                     const float* cum, const float* km, float slope, int q0, bf16* Op, int ldo) {
    const int tid = threadIdx.x, wid = __builtin_amdgcn_readfirstlane(tid >> 6), lane = tid & 63, r32 = lane & 31, hi = lane >> 5;
    char* V_lds = lds + FA_V; char* K_lds = lds + FA_K; char* KR_lds = lds + FA_KR;
    float* cumt = (float*)(lds + FA_CUM);
    float* wsf = (float*)(lds + FA_WS) + wid * 64; float* li_l = wsf; float* al_l = wsf + 32;
    const int qrow = q0 + wid * 32 + r32;
    constexpr float LOG2E = 1.4426950408889634f;
    constexpr float SC = (MODE == FM_MLA ? 0.07216878364870322f : 0.08838834764831845f) * LOG2E;
    constexpr int NQ = MODE == FM_MLA ? 12 : 8;
    bf16x8 qr[NQ];
    const bf16* qp = Qp + (size_t)qrow * ldq;
#pragma unroll
    for (int d0 = 0; d0 < 8; ++d0) qr[d0] = *(const bf16x8*)(qp + d0 * 16 + hi * 8);
    if constexpr (MODE == FM_MLA) {
        const bf16x8 a0 = *(const bf16x8*)(qp + 128 + hi * 8), a1 = *(const bf16x8*)(qp + 144 + hi * 8);
        const bf16x8 b0 = *(const bf16x8*)(qp + 160 + hi * 8), b1 = *(const bf16x8*)(qp + 176 + hi * 8);
        bf16x8 ra0, ra1, rb0, rb1;
#pragma unroll
        for (int e = 0; e < 8; ++e) {
            float c, s_;
            rope_cs(qrow, hi * 8 + e, c, s_);
            { const float t1 = bf2f((unsigned short)a0[e]), t2 = bf2f((unsigned short)b0[e]); ra0[e] = (short)f2bf(t1 * c - t2 * s_); rb0[e] = (short)f2bf(t1 * s_ + t2 * c); }
            rope_cs(qrow, 16 + hi * 8 + e, c, s_);
            { const float t1 = bf2f((unsigned short)a1[e]), t2 = bf2f((unsigned short)b1[e]); ra1[e] = (short)f2bf(t1 * c - t2 * s_); rb1[e] = (short)f2bf(t1 * s_ + t2 * c); }
        }
        qr[8] = ra0; qr[9] = ra1; qr[10] = rb0; qr[11] = rb1;
    }
    const int j_hi = (q0 >> 6) + 4;
    unsigned sel = 0xffffffffu, umask = 0xffffffffu;
    if constexpr (MODE == FM_MOBA) {
        const int blk = q0 >> 8;
        float* kml = (float*)(lds + FA_KM);
        unsigned* um = (unsigned*)(lds + FA_Q) + 4;
        *(f32x4*)(kml + tid * 4) = *(const f32x4*)(km + tid * 4);
        if (tid == 0) *um = 0u;
        __syncthreads();
        float g[15];
#pragma unroll
        for (int n = 0; n < 15; ++n) g[n] = 0.f;
        for (int dd = 0; dd < 64; dd += 8) {
            const bf16x8 qv = *(const bf16x8*)(qp + hi * 64 + dd);
            float qf[8];
#pragma unroll
            for (int e = 0; e < 8; ++e) qf[e] = bf2f((unsigned short)qv[e]);
#pragma unroll
            for (int n = 0; n < 15; ++n)
                if (n < blk) {
                    const f32x4 k0 = *(const f32x4*)(kml + n * 128 + hi * 64 + dd), k1 = *(const f32x4*)(kml + n * 128 + hi * 64 + dd + 4);
                    g[n] += qf[0] * k0[0] + qf[1] * k0[1] + qf[2] * k0[2] + qf[3] * k0[3] + qf[4] * k1[0] + qf[5] * k1[1] + qf[6] * k1[2] + qf[7] * k1[3];
                }
        }
#pragma unroll
        for (int n = 0; n < 15; ++n) g[n] += __shfl_xor(g[n], 32);
        sel = 1u << blk;
#pragma unroll
        for (int r = 0; r < 3; ++r) {
            float best = -__builtin_inff(); int bi = -1;
#pragma unroll
            for (int n = 0; n < 15; ++n) if (n < blk && !((sel >> n) & 1u) && g[n] > best) { best = g[n]; bi = n; }
            if (bi >= 0) sel |= 1u << bi;
        }
        unsigned wm_ = 0u;
#pragma unroll
        for (int n = 0; n < 16; ++n) if (__any((sel >> n) & 1u)) wm_ |= 1u << n;
        if (lane == 0) atomicOr(um, wm_);
        __syncthreads();
        umask = *um;
    }
    auto nxt = [&](int j) { do { ++j; } while (j < j_hi && !((umask >> (j >> 2)) & 1u)); return j; };
    int jc = nxt(-1);
    const int sr = tid >> 4, sc = (tid & 15) * 8;
    const int kws = KSWZ(sr, sc * 2), vst0 = v_st(sr, sc), vst1 = v_st(32 + sr, sc);
    const int krk = tid >> 3, krc = tid & 7, krw = krk * 128 + ((krc ^ (krk & 7)) << 4);
    bf16x8 st_k0, st_k1, st_v0, st_v1, st_kr; float st_c = 0.f;
#define FA_GL(kb) do { const unsigned ko_ = (unsigned)(((kb) + sr) * ldk + sc) * 2u, vo_ = (unsigned)(((kb) + sr) * ldv + sc) * 2u; \
        st_k0 = *(const bf16x8*)((const char*)Kp + ko_); st_k1 = *(const bf16x8*)((const char*)Kp + ko_ + (unsigned)(64 * ldk)); \
        st_v0 = *(const bf16x8*)((const char*)Vp + vo_); st_v1 = *(const bf16x8*)((const char*)Vp + vo_ + (unsigned)(64 * ldv)); \
        if constexpr (MODE == FM_MLA) st_kr = *(const bf16x8*)((const char*)KRp + (unsigned)(((kb) + krk) * 64 + krc * 8) * 2u); \
        if constexpr (MODE == FM_FOX) { if (tid < 64) st_c = cum[(kb) + tid]; } } while (0)
#define FA_SW(bf) do { *(bf16x8*)(K_lds + (bf) * SHM_K + kws) = st_k0; *(bf16x8*)(K_lds + (bf) * SHM_K + kws + 32 * 256) = st_k1; \
        *(bf16x8*)(V_lds + (bf) * SHM_V + vst0) = st_v0; *(bf16x8*)(V_lds + (bf) * SHM_V + vst1) = st_v1; \
        if constexpr (MODE == FM_MLA) *(bf16x8*)(KR_lds + (bf) * SHM_KR + krw) = st_kr; \
        if constexpr (MODE == FM_FOX) { if (tid < 64) cumt[(bf) * 64 + tid] = st_c; } } while (0)
    FA_GL(jc * 64);
    asm volatile("s_waitcnt vmcnt(0)" ::: "memory");
    FA_SW(0);
    float m_reg = -1e30f, l_reg = 0.f;
    f32x16 o[4];
#pragma unroll
    for (int d = 0; d < 4; ++d)
#pragma unroll
        for (int r = 0; r < 16; ++r) o[d][r] = 0.f;
    float cqL = 0.f;
    if constexpr (MODE == FM_FOX) cqL = cum[qrow];
    const float slopeL = slope * LOG2E;
    const int vb0 = (int)(unsigned)(size_t)((LAS char*)V_lds) + v_rd_base(lane);
    int bf = 0;
    while (jc < j_hi) {
        const int kb = jc * 64;
        const int jn = nxt(jc);
        __syncthreads();
        if (jn < j_hi) FA_GL(jn * 64);
        f32x16 p0, p1;
#pragma unroll
        for (int r = 0; r < 16; ++r) { p0[r] = 0.f; p1[r] = 0.f; }
        {
            const char* kbase = K_lds + bf * SHM_K;
            const char* kbp[4];
#pragma unroll
            for (int dd = 0; dd < 4; ++dd) kbp[dd] = kbase + KSWZ(r32, (dd * 16 + hi * 8) * 2);
#pragma unroll
            for (int d0 = 0; d0 < 8; ++d0) {
                const char* ap = kbp[d0 & 3] + (d0 >> 2) * 128;
                const bf16x8 b0 = *(const bf16x8*)(ap), b1 = *(const bf16x8*)(ap + 32 * 256);
                p0 = __builtin_amdgcn_mfma_f32_32x32x16_bf16(b0, qr[d0], p0, 0, 0, 0);
                p1 = __builtin_amdgcn_mfma_f32_32x32x16_bf16(b1, qr[d0], p1, 0, 0, 0);
            }
            if constexpr (MODE == FM_MLA) {
                const char* krb = KR_lds + bf * SHM_KR + r32 * 128;
#pragma unroll
                for (int d = 0; d < 4; ++d) {
                    const int off = (((d * 2 + hi) ^ (r32 & 7)) << 4);
                    const bf16x8 b0 = *(const bf16x8*)(krb + off), b1 = *(const bf16x8*)(krb + 32 * 128 + off);
                    p0 = __builtin_amdgcn_mfma_f32_32x32x16_bf16(b0, qr[8 + d], p0, 0, 0, 0);
                    p1 = __builtin_amdgcn_mfma_f32_32x32x16_bf16(b1, qr[8 + d], p1, 0, 0, 0);
                }
            }
        }
        if (jn < j_hi) { asm volatile("s_waitcnt vmcnt(0)" ::: "memory"); FA_SW(bf ^ 1); }
        if constexpr (MODE == FM_FOX) {
#pragma unroll
            for (int g4 = 0; g4 < 4; ++g4) {
                const f32x4 c0 = *(const f32x4*)(cumt + bf * 64 + 8 * g4 + 4 * hi), c1 = *(const f32x4*)(cumt + bf * 64 + 32 + 8 * g4 + 4 * hi);
#pragma unroll
                for (int i = 0; i < 4; ++i) { p0[4 * g4 + i] = p0[4 * g4 + i] * SC + (cqL - c0[i]) * LOG2E; p1[4 * g4 + i] = p1[4 * g4 + i] * SC + (cqL - c1[i]) * LOG2E; }
            }
        } else if constexpr (MODE == FM_MOBA) {
            const float dq = (float)(qrow - kb - 4 * hi);
#pragma unroll
            for (int r = 0; r < 16; ++r) { const float c = (float)((r & 3) + 8 * (r >> 2));
                p0[r] = p0[r] * SC - slopeL * (dq - c); p1[r] = p1[r] * SC - slopeL * (dq - c - 32.f); }
        } else {
#pragma unroll
            for (int r = 0; r < 16; ++r) { p0[r] *= SC; p1[r] *= SC; }
        }
        const float NEG = -__builtin_inff();
        if (kb + 63 > q0 + wid * 32) {
            const int dqi = qrow - kb - 4 * hi;
#pragma unroll
            for (int r = 0; r < 16; ++r) { const int c = (r & 3) + 8 * (r >> 2); if (c > dqi) p0[r] = NEG; if (c + 32 > dqi) p1[r] = NEG; }
        }
        if constexpr (MODE == FM_MOBA) {
            if (!((sel >> (kb >> 8)) & 1u)) {
#pragma unroll
                for (int r = 0; r < 16; ++r) { p0[r] = NEG; p1[r] = NEG; }
            }
        }
        float pmax = p0[0];
#pragma unroll
        for (int r = 1; r < 16; ++r) pmax = fmaxf(pmax, p0[r]);
#pragma unroll
        for (int r = 0; r < 16; ++r) pmax = fmaxf(pmax, p1[r]);
        { auto rr = __builtin_amdgcn_permlane32_swap(__float_as_uint(pmax), __float_as_uint(pmax), false, false);
          pmax = fmaxf(__uint_as_float(rr[0]), __uint_as_float(rr[1])); }
        const float mn = fmaxf(m_reg, pmax);
        const float alpha = __builtin_amdgcn_exp2f(m_reg - mn);
        m_reg = mn;
        float ps = 0.f;
#pragma unroll
        for (int r = 0; r < 16; ++r) { p0[r] = __builtin_amdgcn_exp2f(p0[r] - mn); p1[r] = __builtin_amdgcn_exp2f(p1[r] - mn); ps += p0[r] + p1[r]; }
        { auto rr = __builtin_amdgcn_permlane32_swap(__float_as_uint(ps), __float_as_uint(ps), false, false);
          ps = __uint_as_float(rr[0]) + __uint_as_float(rr[1]); }
        l_reg = l_reg * alpha + ps;
        bf16x8 pa0, pa1, pa2, pa3;
#define PK4(P, B_, OUT) do { unsigned a0_ = cvtpk(P[B_ + 0], P[B_ + 1]), a1_ = cvtpk(P[B_ + 2], P[B_ + 3]); \
        unsigned b0_ = cvtpk(P[B_ + 4], P[B_ + 5]), b1_ = cvtpk(P[B_ + 6], P[B_ + 7]); \
        auto r0_ = __builtin_amdgcn_permlane32_swap(a0_, b0_, false, false); auto r1_ = __builtin_amdgcn_permlane32_swap(a1_, b1_, false, false); \
        u32x4 w_ = {r0_[0], r1_[0], r0_[1], r1_[1]}; OUT = *reinterpret_cast<bf16x8*>(&w_); } while (0)
        PK4(p0, 0, pa0); PK4(p0, 8, pa1); PK4(p1, 0, pa2); PK4(p1, 8, pa3);
#undef PK4
        if (__any(alpha < 1.f)) {
            if (hi == 0) al_l[r32] = alpha;
            asm volatile("s_waitcnt lgkmcnt(0)" ::: "memory");
#pragma unroll
            for (int d = 0; d < 4; ++d)
#pragma unroll
                for (int r = 0; r < 16; ++r) o[d][r] *= al_l[crow(r, hi)];
        }
        {
            const int vb = vb0 + bf * SHM_V;
#define TRRD(dst, off) asm volatile("ds_read_b64_tr_b16 %0, %1 offset:%2" : "=&v"(dst) : "v"(vb), "i"(off) : "memory")
#define PV_D0(d0) do { s16x4 l0, l1, l2, l3, h0, h1, h2, h3; constexpr int b_ = (d0) * 512; \
        TRRD(l0, b_); TRRD(h0, b_ + 2048); TRRD(l1, b_ + 4096); TRRD(h1, b_ + 6144); TRRD(l2, b_ + 8192); TRRD(h2, b_ + 10240); TRRD(l3, b_ + 12288); TRRD(h3, b_ + 14336); \
        asm volatile("s_waitcnt lgkmcnt(0)" ::: "memory"); __builtin_amdgcn_sched_barrier(0); \
        o[d0] = __builtin_amdgcn_mfma_f32_32x32x16_bf16(pa0, (bf16x8){l0[0], l0[1], l0[2], l0[3], h0[0], h0[1], h0[2], h0[3]}, o[d0], 0, 0, 0); \
        o[d0] = __builtin_amdgcn_mfma_f32_32x32x16_bf16(pa1, (bf16x8){l1[0], l1[1], l1[2], l1[3], h1[0], h1[1], h1[2], h1[3]}, o[d0], 0, 0, 0); \
        o[d0] = __builtin_amdgcn_mfma_f32_32x32x16_bf16(pa2, (bf16x8){l2[0], l2[1], l2[2], l2[3], h2[0], h2[1], h2[2], h2[3]}, o[d0], 0, 0, 0); \
        o[d0] = __builtin_amdgcn_mfma_f32_32x32x16_bf16(pa3, (bf16x8){l3[0], l3[1], l3[2], l3[3], h3[0], h3[1], h3[2], h3[3]}, o[d0], 0, 0, 0); } while (0)
            PV_D0(0); PV_D0(1); PV_D0(2); PV_D0(3);
#undef PV_D0
#undef TRRD
        }
        bf ^= 1; jc = jn;
    }
#undef FA_GL
#undef FA_SW
    if (hi == 0) li_l[r32] = l_reg;
    asm volatile("s_waitcnt lgkmcnt(0)" ::: "memory");
    int tz = lane; asm volatile("" : "+v"(tz));
    const int hz = tz >> 5, rz = tz & 31;
    bf16* Ow = Op + (size_t)(q0 + wid * 32) * ldo;
#pragma unroll
    for (int r = 0; r < 16; ++r) {
        const int orow = crow(r, hz);
        const float rl = 1.f / li_l[orow];
        const unsigned obase = (unsigned)(orow * ldo + rz);
#pragma unroll
        for (int d0 = 0; d0 < 4; ++d0) {
            const float v = o[d0][r] * rl;
            const float vn = __shfl_xor(v, 1);
            if ((rz & 1) == 0) *(unsigned*)(Ow + obase + d0 * 32) = cvtpk(v, vn);
        }
    }
    __syncthreads();
}

struct Args { const float* in[19]; float* out; unsigned char* ws; int ph_lo, ph_hi; };
enum { I_X = 0, I_WR, I_RB, I_EWIN, I_EQN, I_EWQ, I_EKVN, I_EWKV, I_EFB, I_EWOUT, I_OWIN, I_OSINK, I_OWOUT, I_LMG, I_LMB, I_LFG, I_LFB, I_WGU, I_WDN };
enum { PH_CVT = 0, PH_L0_IN, PH_L0_PREP, PH_L0_UP, PH_L0_ATT, PH_L0_OUT, PH_L0_LN1, PH_L0_MOE1, PH_L0_MOE2, PH_L0_LN2,
       PH_L1_IN, PH_L1_KM, PH_L1_ATT, PH_L1_OUT, PH_L1_LN1, PH_L1_MOE1, PH_L1_MOE2, PH_L1_LN2, NPH };

DEVI void ln_row(const float* hrow, float a, const float* y0, const float* y1, const float* g, const float* bta, int lane, f32x4 (&v)[8]) {
    float s = 0.f;
#pragma unroll
    for (int j = 0; j < 8; ++j) {
        f32x4 x = *(const f32x4*)(hrow + 4 * lane + 256 * j) * a;
        if (y0) x += *(const f32x4*)(y0 + 4 * lane + 256 * j);
        if (y1) x += *(const f32x4*)(y1 + 4 * lane + 256 * j);
        v[j] = x; s += (x[0] + x[1]) + (x[2] + x[3]);
    }
    const float mean = wave_sum(s) * (1.f / DM);
    float s2 = 0.f;
#pragma unroll
    for (int j = 0; j < 8; ++j) { v[j] = v[j] - mean; s2 += (v[j][0] * v[j][0] + v[j][1] * v[j][1]) + (v[j][2] * v[j][2] + v[j][3] * v[j][3]); }
    const float rstd = 1.f / sqrtf(wave_sum(s2) * (1.f / DM) + LN_EPS);
#pragma unroll
    for (int j = 0; j < 8; ++j) v[j] = v[j] * rstd * *(const f32x4*)(g + 4 * lane + 256 * j) + *(const f32x4*)(bta + 4 * lane + 256 * j);
}

DEVI void phase_ln1_route(const Args& a, float* xrow, int layer, const float* pre, float* hf, bf16* hb, int gw, int ngw, int lane) {
    unsigned* ctl = (unsigned*)(a.ws + WS_CTL);
    int* list = (int*)(a.ws + WS_LIST) + layer * NEXP * T;
    float* ew = (float*)(a.ws + WS_EW);
    const float* g = a.in[I_LMG] + layer * DM; const float* bta = a.in[I_LMB] + layer * DM;
    const float* wr = a.in[I_WR]; const float* rb = a.in[I_RB];
    for (int t = gw; t < T; t += ngw) {
        f32x4 v[8];
        ln_row(pre + (size_t)t * DM, 1.f, nullptr, nullptr, g, bta, lane, v);
#pragma unroll
        for (int j = 0; j < 8; ++j) {
            *(f32x4*)(hf + (size_t)t * DM + 4 * lane + 256 * j) = v[j];
            uint2 w; w.x = pk2(v[j][0], v[j][1]); w.y = pk2(v[j][2], v[j][3]);
            *(uint2*)(hb + (size_t)t * DM + 4 * lane + 256 * j) = w;
        }
#pragma unroll
        for (int j = 0; j < 8; ++j) *(f32x4*)(xrow + 4 * lane + 256 * j) = v[j];
        __builtin_amdgcn_s_waitcnt(0); __builtin_amdgcn_wave_barrier();
        float acc = 0.f;
        {
            const int e = lane & 31, i0 = (lane >> 5) * 1024;
            const float* wp = wr + (size_t)i0 * NEXP + e;
#pragma unroll 8
            for (int i = 0; i < 1024; ++i) acc += xrow[i0 + i] * wp[(size_t)i * NEXP];
        }
        acc += __shfl_xor(acc, 32);
        const float affl = 1.f / (1.f + __expf(-acc));
        const float sell = affl + rb[lane & 31];
        __builtin_amdgcn_wave_barrier();
        int best = 0; float bests = -__builtin_inff();
#pragma unroll
        for (int gI = 0; gI < 8; ++gI) {
            float m1 = -__builtin_inff(), m2 = -__builtin_inff();
#pragma unroll
            for (int q = 0; q < 4; ++q) { const float x = __shfl(sell, gI * 4 + q); if (x > m1) { m2 = m1; m1 = x; } else if (x > m2) m2 = x; }
            const float sc = m1 + m2;
            if (sc > bests) { bests = sc; best = gI; }
        }
        int e1 = 0, e2 = 0; float s1 = -__builtin_inff(), s2 = -__builtin_inff(), a1 = 0.f, a2 = 0.f;
#pragma unroll
        for (int q = 0; q < 4; ++q) {
            const float af = __shfl(affl, best * 4 + q), x = __shfl(sell, best * 4 + q);
            if (x > s1) { s2 = s1; e2 = e1; a2 = a1; s1 = x; e1 = best * 4 + q; a1 = af; } else if (x > s2) { s2 = x; e2 = best * 4 + q; a2 = af; }
        }
        if (lane == 0) {
            const float inv = 1.f / (a1 + a2);
            ew[t * 2 + 0] = a1 * inv; ew[t * 2 + 1] = a2 * inv;
            const unsigned p1 = atomicAdd(&ctl[CW_CNT + layer * NEXP + e1], 1u); list[e1 * T + p1] = t * 2 + 0;
            const unsigned p2 = atomicAdd(&ctl[CW_CNT + layer * NEXP + e2], 1u); list[e2 * T + p2] = t * 2 + 1;
        }
    }
}

DEVI void phase_moe(const Args& a, char* lds, int layer, int stage, const bf16* hb, int bid, int nb) {
    unsigned* ctl = (unsigned*)(a.ws + WS_CTL);
    const int* list = (const int*)(a.ws + WS_LIST) + layer * NEXP * T;
    const float* ew = (const float*)(a.ws + WS_EW);
    bf16* hdn = (bf16*)(a.ws + WS_HDN);
    float* Y = (float*)(a.ws + WS_Y);
    int* sh = (int*)(lds + 32768);
    const int ntn = stage == 1 ? 8 : 16;
    if (threadIdx.x == 0) {
        int so = 0, to = 0;
        for (int e = 0; e < NEXP; ++e) { const int c = (int)ctl[CW_CNT + layer * NEXP + e]; sh[e] = so; sh[33 + e] = to; so += c; to += ((c + 127) / 128) * ntn; }
        sh[32] = so; sh[33 + 32] = to;
    }
    __syncthreads();
    const int total = sh[33 + 32];
    for (int it = bid; it < total; it += nb) {
        int e = 0;
        while (sh[33 + e + 1] <= it) ++e;
        const int r = it - sh[33 + e], tm = r / ntn, tn = r % ntn;
        const int cnt = sh[e + 1] - sh[e], soff = sh[e];
        const int* le = list + e * T;
        if (stage == 1) {
            const float* W = a.in[I_WGU] + (size_t)(layer * NEXP + e) * DM * (2 * FF);
            gemm_tile(lds, DM, hb, DM, W, 2 * FF,
                      [&](int rr) { const int i = tm * 128 + rr; return i < cnt ? (le[i] >> 1) : -1; },
                      [&](int c) { const int gI = c >> 4; return ((gI & 1) ? FF : 0) + tn * 64 + (gI >> 1) * 16 + (c & 15); },
                      [&](const f32x4 (&acc)[2][4], int wm, int wn, int lane) {
#pragma unroll
                          for (int mf = 0; mf < 2; ++mf)
#pragma unroll
                              for (int h2 = 0; h2 < 2; ++h2)
#pragma unroll
                                  for (int j = 0; j < 4; ++j) {
                                      const int row = tm * 128 + wm * 32 + mf * 16 + (lane >> 4) * 4 + j;
                                      const int col = tn * 64 + (wn * 2 + h2) * 16 + (lane & 15);
                                      const float gv = acc[mf][2 * h2][j], uv = acc[mf][2 * h2 + 1][j];
                                      const float hv = gv / (1.f + __expf(-gv)) * uv;
                                      if (row < cnt) hdn[(size_t)(soff + row) * FF + col] = (bf16)f2bf(hv);
                                  }
                      });
        } else {
            const float* W = a.in[I_WDN] + (size_t)(layer * NEXP + e) * FF * DM;
            gemm_tile(lds, FF, hdn, FF, W, DM,
                      [&](int rr) { const int i = tm * 128 + rr; return i < cnt ? (soff + i) : -1; },
                      [&](int c) { return tn * 128 + c; },
                      [&](const f32x4 (&acc)[2][4], int wm, int wn, int lane) {
                          for_each_acc(acc, wm, wn, lane, [&](int rr, int c, float v) {
                              const int i = tm * 128 + rr;
                              if (i < cnt) { const int ent = le[i]; Y[(size_t)ent * DM + tn * 128 + c] = ew[ent] * v; }
                          });
                      });
        }
    }
    __syncthreads();
}

DEVI void phase_ln2(const Args& a, int layer, const float* hf, float* of, bf16* ob, int gw, int ngw, int lane) {
    const float* Y = (const float*)(a.ws + WS_Y);
    const float* g = a.in[I_LFG] + layer * DM; const float* bta = a.in[I_LFB] + layer * DM;
    for (int t = gw; t < T; t += ngw) {
        f32x4 v[8];
        ln_row(hf + (size_t)t * DM, ALPHA, Y + (size_t)(2 * t) * DM, Y + (size_t)(2 * t + 1) * DM, g, bta, lane, v);
#pragma unroll
        for (int j = 0; j < 8; ++j) {
            *(f32x4*)(of + (size_t)t * DM + 4 * lane + 256 * j) = v[j];
            if (ob) { uint2 w; w.x = pk2(v[j][0], v[j][1]); w.y = pk2(v[j][2], v[j][3]); *(uint2*)(ob + (size_t)t * DM + 4 * lane + 256 * j) = w; }
        }
    }
}

__global__ void __launch_bounds__(NTHREADS, 2) fwd(Args a) {
    extern __shared__ __attribute__((aligned(16))) char lds[];
    const int tid = threadIdx.x, lane = tid & 63, wid = tid >> 6;
    const int bid = blockIdx.x, nb = gridDim.x;
    const int gw = bid * NWAVES + wid, ngw = nb * NWAVES;
    unsigned char* ws = a.ws;
    unsigned* ctl = (unsigned*)(ws + WS_CTL);
    float* FL = (float*)(ws + WS_FL); float* LF = (float*)(ws + WS_LF); float* CUM = (float*)(ws + WS_CUM); float* KM = (float*)(ws + WS_KM);
    bf16* KPE = (bf16*)(ws + WS_KPE); bf16* XB = (bf16*)(ws + WS_XB); bf16* HB = (bf16*)(ws + WS_HB);
    float* HFA = (float*)(ws + WS_HFA); float* HFB = (float*)(ws + WS_HFB); float* PRE = (float*)(ws + WS_PRE);
    bf16* P = (bf16*)(ws + WS_P); bf16* CQN = (bf16*)(ws + WS_CQN); bf16* CKVN = (bf16*)(ws + WS_CKVN);
    bf16* QM = (bf16*)(ws + WS_QM); bf16* KVM = (bf16*)(ws + WS_KVM); bf16* AO = (bf16*)(ws + WS_AO);

    volatile LAS unsigned* xbw = (volatile LAS unsigned*)((LAS char*)lds + LDS_BYTES - 16);
    if (tid < 4) xbw[tid] = 0u;
    __syncthreads();
    XcdBarrier bar; bar.bar = ctl + CW_BAR; bar.x = 0; bar.st = xbw;
#if ONE_LAUNCH
    bar = xcd_barrier_post(ctl + CW_BAR, xbw);
#define SEAM(k) do { if ((k) + 1 < a.ph_hi) xcd_barrier(bar); } while (0)
#else
#define SEAM(k) do { } while (0)
#endif
#define IN(k) (a.ph_lo <= (k) && (k) < a.ph_hi)

    if (IN(PH_CVT)) {
        const float* x = a.in[I_X];
        for (size_t i = (size_t)bid * NTHREADS + tid; i < (size_t)T * DM / 8; i += (size_t)nb * NTHREADS) {
            const f32x4 v0 = *(const f32x4*)(x + i * 8), v1 = *(const f32x4*)(x + i * 8 + 4);
            u32x4 w; w[0] = pk2(v0[0], v0[1]); w[1] = pk2(v0[2], v0[3]); w[2] = pk2(v1[0], v1[1]); w[3] = pk2(v1[2], v1[3]);
            *(u32x4*)(XB + i * 8) = w;
        }
        SEAM(PH_CVT);
    }
    if (IN(PH_L0_IN)) {
        gemm_dense(lds, T, EVEN_IN, DM, XB, DM, a.in[I_EWIN], EVEN_IN,
                   [&](int m, int n, float v) { P[(size_t)m * LDP + n] = (bf16)f2bf(v); if (n >= E_FL) FL[m * 8 + (n - E_FL)] = v; }, 0, 0, bid, nb);
        SEAM(PH_L0_IN);
    }
    if (IN(PH_L0_PREP)) {
        const float* qn = a.in[I_EQN]; const float* kvn = a.in[I_EKVN]; const float* fb = a.in[I_EFB];
        for (int t = gw; t < T; t += ngw) {
            const bf16* pr = P + (size_t)t * LDP;
            {
                const u32x4 w = *(const u32x4*)(pr + E_CQ + lane * 8);
                float x[8] = {bflo(w[0]), bfhi(w[0]), bflo(w[1]), bfhi(w[1]), bflo(w[2]), bfhi(w[2]), bflo(w[3]), bfhi(w[3])};
                float ss = 0.f;
#pragma unroll
                for (int i = 0; i < 8; ++i) ss += x[i] * x[i];
                const float r = 1.f / sqrtf(wave_sum(ss) * (1.f / 512.f) + RMS_EPS);
                u32x4 o;
#pragma unroll
                for (int i = 0; i < 4; ++i) o[i] = pk2(x[2 * i] * r * qn[lane * 8 + 2 * i], x[2 * i + 1] * r * qn[lane * 8 + 2 * i + 1]);
                *(u32x4*)(CQN + (size_t)t * 512 + lane * 8) = o;
            }
            {
                const uint2 w = *(const uint2*)(pr + E_CKV + lane * 4);
                float x[4] = {bflo(w.x), bfhi(w.x), bflo(w.y), bfhi(w.y)};
                float ss = x[0] * x[0] + x[1] * x[1] + x[2] * x[2] + x[3] * x[3];
                const float r = 1.f / sqrtf(wave_sum(ss) * (1.f / 256.f) + RMS_EPS);
                uint2 o; o.x = pk2(x[0] * r * kvn[lane * 4], x[1] * r * kvn[lane * 4 + 1]); o.y = pk2(x[2] * r * kvn[lane * 4 + 2], x[3] * r * kvn[lane * 4 + 3]);
                *(uint2*)(CKVN + (size_t)t * 256 + lane * 4) = o;
            }
            if (lane < 32) {
                const float t1 = bf2f(pr[E_KR + lane]), t2 = bf2f(pr[E_KR + 32 + lane]);
                float c, s; rope_cs(t % S, lane, c, s);
                KPE[(size_t)t * 64 + lane] = (bf16)f2bf(t1 * c - t2 * s);
                KPE[(size_t)t * 64 + 32 + lane] = (bf16)f2bf(t1 * s + t2 * c);
            }
            if (lane < 8) {
                const float x = FL[t * 8 + lane] + fb[lane];
                LF[t * 8 + lane] = fminf(x, 0.f) - log1pf(__expf(-fabsf(x)));
            }
        }
        SEAM(PH_L0_PREP);
    }
    if (IN(PH_L0_UP)) {
        if (gw < 16) {
            const int b = gw >> 3, h = gw & 7;
            double loc = 0.0;
            for (int i = 0; i < 64; ++i) loc += (double)LF[(size_t)(b * S + lane * 64 + i) * 8 + h];
            double inc = loc;
#pragma unroll
            for (int o = 1; o < 64; o <<= 1) { const double nbv = __shfl_up(inc, o); if (lane >= o) inc += nbv; }
            double run = inc - loc;
            for (int i = 0; i < 64; ++i) { run += (double)LF[(size_t)(b * S + lane * 64 + i) * 8 + h]; CUM[(size_t)gw * S + lane * 64 + i] = (float)run; }
        }
        const int n1 = (T / 128) * (1536 / 128);
        gemm_dense(lds, T, 1536, 512, CQN, 512, a.in[I_EWQ], 1536, [&](int m, int n, float v) { QM[(size_t)m * 1536 + n] = (bf16)f2bf(v); }, 0, 0, bid, nb);
        gemm_dense(lds, T, 2048, 256, CKVN, 256, a.in[I_EWKV], 2048, [&](int m, int n, float v) { KVM[(size_t)m * 2048 + n] = (bf16)f2bf(v); }, n1 % nb, 0, bid, nb);
        SEAM(PH_L0_UP);
    }
    if (IN(PH_L0_ATT)) {
        volatile unsigned* qslot = (volatile unsigned*)(lds + FA_Q);
        for (;;) {
            if (tid == 0) *qslot = atomicAdd(&ctl[CW_Q + 0], 1u);
            __syncthreads();
            const int item = __builtin_amdgcn_readfirstlane((int)*qslot);
            __syncthreads();
            if (item >= 256) break;
            const int qb = 15 - (item >> 4), bh = item & 15, b = bh >> 3, h = bh & 7;
            flash_unit<FM_MLA>(lds, QM + (size_t)b * S * 1536 + h * 192, 1536, KVM + (size_t)b * S * 2048 + h * 256, 2048, KVM + (size_t)b * S * 2048 + h * 256 + 128, 2048,
                               KPE + (size_t)b * S * 64, nullptr, nullptr, 0.f, qb * 256, AO + (size_t)b * S * 2048 + h * 128, 2048);
        }
        for (;;) {
            if (tid == 0) *qslot = atomicAdd(&ctl[CW_Q + 1], 1u);
            __syncthreads();
            const int item = __builtin_amdgcn_readfirstlane((int)*qslot);
            __syncthreads();
            if (item >= 256) break;
            const int qb = 15 - (item >> 4), bh = item & 15, b = bh >> 3, h = bh & 7;
            flash_unit<FM_FOX>(lds, P + (size_t)b * S * LDP + E_FQ + h * 128, LDP, P + (size_t)b * S * LDP + E_FK + h * 128, LDP, P + (size_t)b * S * LDP + E_FV + h * 128, LDP,
                               nullptr, CUM + (size_t)bh * S, nullptr, 0.f, qb * 256, AO + (size_t)b * S * 2048 + 1024 + h * 128, 2048);
        }
        SEAM(PH_L0_ATT);
    }
    if (IN(PH_L0_OUT)) {
        const float* x = a.in[I_X];
        gemm_dense(lds, T, DM, DM, AO, DM, a.in[I_EWOUT], DM, [&](int m, int n, float v) { PRE[(size_t)m * DM + n] = ALPHA * x[(size_t)m * DM + n] + v; }, 0, 0, bid, nb);
        SEAM(PH_L0_OUT);
    }
    if (IN(PH_L0_LN1)) { phase_ln1_route(a, (float*)lds + wid * 2048, 0, PRE, HFA, HB, gw, ngw, lane); SEAM(PH_L0_LN1); }
    if (IN(PH_L0_MOE1)) { phase_moe(a, lds, 0, 1, HB, bid, nb); SEAM(PH_L0_MOE1); }
    if (IN(PH_L0_MOE2)) { phase_moe(a, lds, 0, 2, HB, bid, nb); SEAM(PH_L0_MOE2); }
    if (IN(PH_L0_LN2)) { phase_ln2(a, 0, HFA, HFB, XB, gw, ngw, lane); SEAM(PH_L0_LN2); }

    if (IN(PH_L1_IN)) {
        gemm_dense(lds, T, ODD_IN, DM, XB, DM, a.in[I_OWIN], ODD_IN, [&](int m, int n, float v) { P[(size_t)m * LDP + n] = (bf16)f2bf(v); }, 0, 0, bid, nb);
        SEAM(PH_L1_IN);
    }
    if (IN(PH_L1_KM)) {
        for (int it = gw; it < 2 * 8 * 16; it += ngw) {
            const int b = it >> 7, h = (it >> 4) & 7, n = it & 15;
            float s0 = 0.f, s1 = 0.f;
            for (int j = 0; j < 256; ++j) { const unsigned w = *(const unsigned*)(P + ((size_t)b * S + n * 256 + j) * LDP + O_MK + h * 128 + lane * 2); s0 += bflo(w); s1 += bfhi(w); }
            KM[(size_t)it * 128 + lane * 2] = s0 * (1.f / 256.f); KM[(size_t)it * 128 + lane * 2 + 1] = s1 * (1.f / 256.f);
        }
        SEAM(PH_L1_KM);
    }
    if (IN(PH_L1_ATT)) {
        volatile unsigned* qslot = (volatile unsigned*)(lds + FA_Q);
        const float* sinks = a.in[I_OSINK];
        for (;;) {
            if (tid == 0) *qslot = atomicAdd(&ctl[CW_Q + 2], 1u);
            __syncthreads();
            const int item = __builtin_amdgcn_readfirstlane((int)*qslot);
            __syncthreads();
            if (item >= 256) break;
            const int qb = 15 - (item >> 4), bh = item & 15, b = bh >> 3, h = bh & 7;
            flash_unit<FM_MOBA>(lds, P + (size_t)b * S * LDP + O_MQ + h * 128, LDP, P + (size_t)b * S * LDP + O_MK + h * 128, LDP, P + (size_t)b * S * LDP + O_MV + h * 128, LDP,
                                nullptr, nullptr, KM + (size_t)bh * 16 * 128, exp2f(-(float)(h + 1)), qb * 256, AO + (size_t)b * S * 2048 + 1024 + h * 128, 2048);
        }
        for (;;) {
            if (tid == 0) *qslot = atomicAdd(&ctl[CW_Q + 3], 1u);
            __syncthreads();
            const int item = __builtin_amdgcn_readfirstlane((int)*qslot);
            __syncthreads();
            if (item >= 256) break;
            float* qs = (float*)lds + wid * 256;
            const int base = item * 512 + wid * 64;
            for (int it = base; it < base + 64; ++it) {
                float m = -1e30f, l = 0.f, o[2] = {0.f, 0.f};
                const int t = it % S, bh = it / S, b = bh >> 4, qh = bh & 15, kvh = qh >> 3;
                const size_t tok = (size_t)b * S + t;
                qs[lane] = bf2f(P[tok * LDP + O_SQ + qh * 64 + lane]);
                __builtin_amdgcn_s_waitcnt(0); __builtin_amdgcn_wave_barrier();
                const float slope = exp2f(-0.5f * (float)(qh + 1));
                const int j0 = t - 127 > 0 ? t - 127 : 0;
                attn_range<64, 0, 64>(qs, P + (size_t)b * S * LDP + O_SK + kvh * 64, LDP, nullptr, 0, P + (size_t)b * S * LDP + O_SV + kvh * 64, LDP,
                                      j0, t + 1, 0.125f, [&](int j) { return -slope * (float)(t - j); }, m, l, o, lane);
                const float sk = sinks[qh];
                const float mf = fmaxf(m, sk), al = __expf(m - mf);
                l = l * al + __expf(sk - mf); o[0] *= al;
                AO[tok * 2048 + qh * 64 + lane] = (bf16)f2bf(o[0] / l);
                __builtin_amdgcn_wave_barrier();
            }
        }
        SEAM(PH_L1_ATT);
    }
    if (IN(PH_L1_OUT)) {
        gemm_dense(lds, T, DM, DM, AO, DM, a.in[I_OWOUT], DM, [&](int m, int n, float v) { PRE[(size_t)m * DM + n] = ALPHA * HFB[(size_t)m * DM + n] + v; }, 0, 0, bid, nb);
        SEAM(PH_L1_OUT);
    }
    if (IN(PH_L1_LN1)) { phase_ln1_route(a, (float*)lds + wid * 2048, 1, PRE, HFA, HB, gw, ngw, lane); SEAM(PH_L1_LN1); }
    if (IN(PH_L1_MOE1)) { phase_moe(a, lds, 1, 1, HB, bid, nb); SEAM(PH_L1_MOE1); }
    if (IN(PH_L1_MOE2)) { phase_moe(a, lds, 1, 2, HB, bid, nb); SEAM(PH_L1_MOE2); }
    if (IN(PH_L1_LN2)) { phase_ln2(a, 1, HFA, a.out, nullptr, gw, ngw, lane); }
#undef IN
#undef SEAM
}

extern "C" void kernel_launch(void* const* d_in, const int* in_sizes, int n_in, void* d_out, int out_size, void* d_ws, size_t ws_size, hipStream_t stream) {
    static int grid = 0;
    if (grid == 0) {
        if (n_in != 19 || out_size != T * DM || ws_size < WS_END) { fprintf(stderr, "kernel_launch: unexpected shapes (n_in %d out %d ws %zu)\n", n_in, out_size, ws_size); grid = -1; return; }
        int dev = 0, cus = 0;
        if (hipGetDevice(&dev) != hipSuccess || hipDeviceGetAttribute(&cus, hipDeviceAttributeMultiprocessorCount, dev) != hipSuccess || cus <= 0) cus = 256;
        (void)hipFuncSetAttribute((const void*)fwd, hipFuncAttributeMaxDynamicSharedMemorySize, LDS_BYTES);
        int per_cu = 0;
        if (hipOccupancyMaxActiveBlocksPerMultiprocessor(&per_cu, (const void*)fwd, NTHREADS, LDS_BYTES) != hipSuccess || per_cu < 1) fprintf(stderr, "kernel_launch: occupancy query says %d\n", per_cu);
        (void)hipGetLastError();
        grid = cus;
    }
    if (grid < 0) return;
    (void)in_sizes;
    (void)hipMemsetAsync((char*)d_ws + WS_CTL, 0, CTL_BYTES, stream);
    Args a{};
    for (int i = 0; i < 19; ++i) a.in[i] = (const float*)d_in[i];
    a.out = (float*)d_out; a.ws = (unsigned char*)d_ws;
#if ONE_LAUNCH
    a.ph_lo = 0; a.ph_hi = NPH;
    hipLaunchKernelGGL(fwd, dim3(grid), dim3(NTHREADS), LDS_BYTES, stream, a);
#else
    for (int p = 0; p < NPH; ++p) { a.ph_lo = p; a.ph_hi = p + 1; hipLaunchKernelGGL(fwd, dim3(grid), dim3(NTHREADS), LDS_BYTES, stream, a); }
#endif
}
```

```cpp
#include <hip/hip_runtime.h>
#include <stdint.h>
#include <stdio.h>

#ifndef PROBE_REP
#define PROBE_REP -1
#endif
#define REPS(k) ((PROBE_REP) == (k) ? 2 : 1)
#ifndef ONE_LAUNCH
#define ONE_LAUNCH 1
#endif

#define DEVI __device__ __forceinline__
#define LAS __attribute__((address_space(3)))
typedef unsigned short bf16;
typedef short bf16x8 __attribute__((ext_vector_type(8)));
typedef float f32x4 __attribute__((ext_vector_type(4)));
typedef unsigned u32x4 __attribute__((ext_vector_type(4)));

constexpr int S = 4096, NBATCH = 2, T = NBATCH * S, DM = 2048;
constexpr int LDP = 4352;
constexpr int EVEN_IN = 3912, ODD_IN = 4352;
constexpr float LN_EPS = 1e-5f, RMS_EPS = 1e-6f;
constexpr float ALPHA = 1.4142135623730951f;
constexpr int NEXP = 32, FF = 512;
constexpr int E_CQ = 0, E_CKV = 512, E_KR = 768, E_FQ = 832, E_FK = 1856, E_FV = 2880, E_FL = 3904;
constexpr int O_SQ = 0, O_SK = 1024, O_SV = 1152, O_MQ = 1280, O_MK = 2304, O_MV = 3328;

constexpr size_t MiB = 1u << 20;
constexpr size_t WS_CTL = 0, CTL_BYTES = 1 * MiB;
constexpr int CW_CNT = 1024;
constexpr int CW_BAR = 4096;
constexpr int CW_Q = 1100;
constexpr size_t WS_LIST = 2 * MiB;
constexpr size_t WS_EW = 4 * MiB;
constexpr size_t WS_FL = 5 * MiB;
constexpr size_t WS_LF = 5 * MiB + 512 * 1024;
constexpr size_t WS_CUM = 6 * MiB;
constexpr size_t WS_KM = 6 * MiB + 512 * 1024;
constexpr size_t WS_KPE = 7 * MiB;
constexpr size_t WS_XB = 16 * MiB;
constexpr size_t WS_HB = 48 * MiB;
constexpr size_t WS_HFA = 80 * MiB;
constexpr size_t WS_HFB = 144 * MiB;
constexpr size_t WS_PRE = 208 * MiB;
constexpr size_t WS_P = 272 * MiB;
constexpr size_t WS_CQN = 340 * MiB;
constexpr size_t WS_CKVN = 348 * MiB;
constexpr size_t WS_QM = 352 * MiB;
constexpr size_t WS_KVM = 376 * MiB;
constexpr size_t WS_AO = 408 * MiB;
constexpr size_t WS_HDN = 440 * MiB;
constexpr size_t WS_Y = 464 * MiB;
constexpr size_t WS_WIN0 = 600 * MiB;
constexpr size_t WS_WQU = 616 * MiB;
constexpr size_t WS_WKVU = 618 * MiB;
constexpr size_t WS_WOUT0 = 620 * MiB;
constexpr size_t WS_WIN1 = 628 * MiB;
constexpr size_t WS_WOUT1 = 646 * MiB;
constexpr size_t WS_WGU = 656 * MiB;
constexpr size_t WS_WDN = 912 * MiB;
constexpr size_t WS_END = 1040 * MiB;

constexpr int LDS_BYTES = 147456;
constexpr int NTHREADS = 512, NWAVES = 8;

DEVI unsigned f2bf(float f) { unsigned u = __float_as_uint(f); return (u + 0x7fffu + ((u >> 16) & 1u)) >> 16; }
DEVI float bf2f(unsigned b) { return __uint_as_float(b << 16); }
DEVI float bflo(unsigned w) { return __uint_as_float(w << 16); }
DEVI float bfhi(unsigned w) { return __uint_as_float(w & 0xffff0000u); }
DEVI unsigned pk2(float lo, float hi) { return f2bf(lo) | (f2bf(hi) << 16); }
DEVI float wave_sum(float v) {
#pragma unroll
    for (int o = 1; o < 64; o <<= 1) v += __shfl_xor(v, o);
    return v;
}
DEVI float wave_max(float v) {
#pragma unroll
    for (int o = 1; o < 64; o <<= 1) v = fmaxf(v, __shfl_xor(v, o));
    return v;
}
DEVI void rope_cs(int t, int i, float& c, float& s) {
    const float inv_freq = exp2f(-(float)i * (13.287712379549449f / 32.0f));
    double rev = (double)t * (double)inv_freq * 0.15915494309189535;
    rev -= floor(rev);
    const float a = (float)(rev * 6.283185307179586);
    c = __cosf(a); s = __sinf(a);
}

#define XB_TMO      128
#define XB_XCNT(j)  (256  + 64 * (j))
#define XB_XSUB(j)  (1280 + 64 * (j))
#define XB_XGEN(j)  (2304 + 64 * (j))
#define XB_TOP      3328
#define XB_TOPGEN   3392
#define XCD_BAR_WORDS 3456
#define XB_SPIN_CAP (1u << 18)
DEVI unsigned xb_ld(unsigned* p)              { return __hip_atomic_load(p, __ATOMIC_RELAXED, __HIP_MEMORY_SCOPE_AGENT); }
DEVI unsigned xb_add(unsigned* p, unsigned v) { return __hip_atomic_fetch_add(p, v, __ATOMIC_RELAXED, __HIP_MEMORY_SCOPE_AGENT); }
DEVI unsigned xb_xcc_id() { return (unsigned)__builtin_amdgcn_s_getreg((3 << 11) | 20) & 0xFu; }
#define XB_SPIN(cond, bar) do { unsigned _sp = 0; while (cond) { __builtin_amdgcn_s_sleep(1); \
    if ((++_sp & 255u) == 0u) { if (xb_ld(&(bar)[XB_TMO])) break; if (_sp > XB_SPIN_CAP) { atomicAdd(&(bar)[XB_TMO], 1u); break; } } } } while (0)
struct XcdBarrier { unsigned* bar; unsigned x; volatile LAS unsigned* st; };
DEVI XcdBarrier xcd_barrier_post(unsigned* bar, volatile LAS unsigned* st) {
    XcdBarrier b; b.bar = bar; b.x = xb_xcc_id(); b.st = st;
    if (threadIdx.x == 0) (void)xb_add(&bar[XB_XCNT(b.x)], 1u);
    return b;
}
DEVI void xcd_barrier_complete(unsigned* bar, unsigned x, unsigned& nloc, unsigned& nx) {
    const unsigned G = gridDim.x * gridDim.y * gridDim.z;
    unsigned sum, cnt, mine, sp = 0u;
    for (;;) {
        sum = 0u; cnt = 0u; mine = 0u;
#pragma unroll
        for (unsigned j = 0; j < 16; ++j) { const unsigned c = xb_ld(&bar[XB_XCNT(j)]); sum += c; cnt += (c > 0u) ? 1u : 0u; mine = (j == x) ? c : mine; }
        if (sum == G) break;
        __builtin_amdgcn_s_sleep(1);
        if ((++sp & 255u) == 0u) { if (xb_ld(&bar[XB_TMO])) break; if (sp > XB_SPIN_CAP) { atomicAdd(&bar[XB_TMO], 1u); break; } }
    }
    nloc = mine > 0u ? mine : 1u; nx = cnt > 0u ? cnt : 1u;
}
DEVI void xcd_barrier(const XcdBarrier& b) {
    asm volatile("s_waitcnt vmcnt(0)" ::: "memory");
    __syncthreads();
    if (threadIdx.x == 0) {
        unsigned* bar = b.bar;
        __builtin_amdgcn_s_waitcnt(0);
        unsigned nloc = b.st[0], nx = b.st[1];
        if (nloc == 0u) { xcd_barrier_complete(bar, b.x, nloc, nx); b.st[0] = nloc; b.st[1] = nx; }
        const unsigned old = xb_add(&bar[XB_XSUB(b.x)], 1u);
        const unsigned gen = old / nloc;
        if (old + 1u == (gen + 1u) * nloc) {
            __builtin_amdgcn_fence(__ATOMIC_RELEASE, "agent");
            asm volatile("s_waitcnt vmcnt(0)" ::: "memory");
            const unsigned og = xb_add(&bar[XB_TOP], 1u);
            const unsigned tg = og / nx;
            if (og + 1u == (tg + 1u) * nx) xb_add(&bar[XB_TOPGEN], 1u);
            else XB_SPIN(xb_ld(&bar[XB_TOPGEN]) == tg, bar);
            __builtin_amdgcn_fence(__ATOMIC_ACQUIRE, "agent");
            xb_add(&bar[XB_XGEN(b.x)], 1u);
            asm volatile("s_waitcnt vmcnt(0)" ::: "memory");
        } else {
            XB_SPIN(xb_ld(&bar[XB_XGEN(b.x)]) == gen, bar);
            __builtin_amdgcn_fence(__ATOMIC_ACQUIRE, "agent");
            asm volatile("s_waitcnt vmcnt(0)" ::: "memory");
        }
    }
    __syncthreads();
}

template <class RowMap, class ColMap, class Epi>
DEVI void gemm_tile(char* lds, int K, const bf16* __restrict__ A, int lda, const float* __restrict__ W, int ldw,
                    RowMap rowmap, ColMap colmap, Epi epi) {
    bf16* sA = (bf16*)lds;
    bf16* sB = sA + 128 * 40;
    const int tid = threadIdx.x, lane = tid & 63, wid = tid >> 6, wm = wid >> 1, wn = wid & 1;
    const int ar = tid >> 2, ac = (tid & 3) * 8;
    const int src_row = rowmap(ar);
    const bf16* aptr = A + (size_t)(src_row < 0 ? 0 : src_row) * lda + ac;
    const int bk = tid >> 4, bn = (tid & 15) * 8;
    const int pcol = colmap(bn);
    const float* wptr = W + (size_t)bk * ldw + (pcol < 0 ? 0 : pcol);
    f32x4 acc[2][4];
#pragma unroll
    for (int a = 0; a < 2; ++a)
#pragma unroll
        for (int b = 0; b < 4; ++b) acc[a][b] = (f32x4){0.f, 0.f, 0.f, 0.f};
    u32x4 ra; f32x4 rb0, rb1;
    ra = (u32x4){0u, 0u, 0u, 0u}; rb0 = (f32x4){0.f, 0.f, 0.f, 0.f}; rb1 = rb0;
    if (src_row >= 0) ra = *(const u32x4*)(aptr);
    if (pcol >= 0) { rb0 = *(const f32x4*)(wptr); rb1 = *(const f32x4*)(wptr + 4); }
    for (int k0 = 0; k0 < K; k0 += 32) {
        *(u32x4*)(sA + ar * 40 + ac) = ra;
#pragma unroll
        for (int j = 0; j < 4; ++j) { sB[(bn + j) * 40 + bk] = (bf16)f2bf(rb0[j]); sB[(bn + 4 + j) * 40 + bk] = (bf16)f2bf(rb1[j]); }
        __syncthreads();
        if (k0 + 32 < K) {
            if (src_row >= 0) ra = *(const u32x4*)(aptr + k0 + 32);
            if (pcol >= 0) { rb0 = *(const f32x4*)(wptr + (size_t)(k0 + 32) * ldw); rb1 = *(const f32x4*)(wptr + (size_t)(k0 + 32) * ldw + 4); }
        }
        bf16x8 af[2], bfr[4];
#pragma unroll
        for (int mf = 0; mf < 2; ++mf) af[mf] = *(const bf16x8*)(sA + (wm * 32 + mf * 16 + (lane & 15)) * 40 + (lane >> 4) * 8);
#pragma unroll
        for (int nf = 0; nf < 4; ++nf) bfr[nf] = *(const bf16x8*)(sB + (wn * 64 + nf * 16 + (lane & 15)) * 40 + (lane >> 4) * 8);
#pragma unroll
        for (int mf = 0; mf < 2; ++mf)
#pragma unroll
            for (int nf = 0; nf < 4; ++nf) acc[mf][nf] = __builtin_amdgcn_mfma_f32_16x16x32_bf16(af[mf], bfr[nf], acc[mf][nf], 0, 0, 0);
        __syncthreads();
    }
    epi(acc, wm, wn, lane);
}
template <class F> DEVI void for_each_acc(const f32x4 (&acc)[2][4], int wm, int wn, int lane, F f) {
#pragma unroll
    for (int mf = 0; mf < 2; ++mf)
#pragma unroll
        for (int nf = 0; nf < 4; ++nf)
#pragma unroll
            for (int j = 0; j < 4; ++j) f(wm * 32 + mf * 16 + (lane >> 4) * 4 + j, wn * 64 + nf * 16 + (lane & 15), acc[mf][nf][j]);
}

template <class Store>
DEVI void gemm_dense(char* lds, int M, int N, int K, const bf16* A, int lda, const float* W, int ldw, Store store, int item0, int nitems_total, int bid, int nb) {
    const int ntn = (N + 127) / 128, ntm = M / 128, nt = ntm * ntn;
    (void)nitems_total;
    for (int it = bid; it < item0 + nt; it += nb) {
        if (it < item0) continue;
        const int t = it - item0, tm = t / ntn, tn = t % ntn;
        gemm_tile(lds, K, A, lda, W, ldw,
                  [&](int r) { return tm * 128 + r; },
                  [&](int c) { const int pc = tn * 128 + c; return pc < N ? pc : -1; },
                  [&](const f32x4 (&acc)[2][4], int wm, int wn, int lane) {
                      for_each_acc(acc, wm, wn, lane, [&](int r, int c, float v) { const int n = tn * 128 + c; if (n < N) store(tm * 128 + r, n, v); });
                  });
    }
}


namespace g8 {
constexpr int BM = 256, BK = 64, HALF = 128, HTB = HALF * BK * 2, STAGE_BYTES = 8 * HTB, NXCD = 8, WGM = 8;
DEVI int lds_byte(int r, int c) { const int st = (r >> 4) * 2 + (c >> 5), rr = r & 15, cc = c & 31, ob = rr * 64 + cc * 2; return st * 1024 + (ob ^ (((ob >> 9) & 1) << 5)); }
DEVI void stage_rc(int b, int& R, int& C) { const int st = b / 1024, sb = b % 1024, swz = sb ^ (((sb >> 9) & 1) << 5); R = (st >> 1) * 16 + swz / 64; C = (st & 1) * 32 + (swz % 64) / 2; }
struct U { int pm, pn; const char* A; const char* Bt; int x0, x1, x2, x3; };
struct DenseOrder {
    int nM, nN, nwg, G, c, lda, K; const char* A; const char* Bt;
    DEVI void init(const bf16* A_, int lda_, const bf16* Bt_, int M, int N, int K_, int G_, int c_) { nM = M / BM; nN = N / BM; nwg = nM * nN; G = G_; c = c_; lda = lda_; K = K_; A = (const char*)A_; Bt = (const char*)Bt_; }
    DEVI bool next(int i, U& u) const {
        const long L = (long)i * G + c; if (L >= nwg) return false;
        int wgid = (int)L; { const int q = nwg / NXCD, r = nwg % NXCD, xcd = wgid % NXCD, off = wgid / NXCD; wgid = (xcd < r ? xcd * (q + 1) : r * (q + 1) + (xcd - r) * q) + off; }
        const int nig = WGM * nN, gid = wgid / nig, fm = gid * WGM, gsz = (nM - fm) < WGM ? (nM - fm) : WGM;
        u.pm = fm + ((wgid % nig) % gsz); u.pn = (wgid % nig) / gsz; u.A = A; u.Bt = Bt + (size_t)u.pn * BM * K * 2; return true;
    }
    DEVI unsigned a_off(const U& u, int h, int R, int C) const { return (unsigned)((u.pm * BM + h * HALF + R) * lda + C) * 2u; }
};
template <class Sched, class Epi>
DEVI void gemm8(LAS unsigned char* lds, const int K, const Sched& S, const Epi& E) {
    const int tid = threadIdx.x, wid = __builtin_amdgcn_readfirstlane(tid >> 6), lane = tid & 63, wr = wid >> 2, wc = wid & 3, fr = lane & 15, fq = lane >> 4;
    const int nt = K / BK;
    int Rr[2], Cc[2]; unsigned vb[2];
#pragma unroll
    for (int i = 0; i < 2; ++i) { stage_rc(tid * 16 + i * 8192, Rr[i], Cc[i]); vb[i] = (unsigned)(Rr[i] * K + Cc[i]) * 2u; }
    const size_t kstep = (size_t)(BK * 2), hstepB = (size_t)HALF * K * 2;
    const unsigned ldsw = (unsigned)wid * 1024u;
    const int aoff = lds_byte(wr * 64 + fr, fq * 8), boff = lds_byte(wc * 32 + fr, fq * 8);
#define G8_SA(b, h) (((b) * 2 + (h)) * HTB)
#define G8_SB(b, h) ((4 + (b) * 2 + (h)) * HTB)
#define G8_STAGE(bufoff, gbase, v0, v1) do { \
        __builtin_amdgcn_global_load_lds((const unsigned*)((const char*)(gbase) + (v0)), (LAS unsigned*)(lds + (bufoff) + ldsw), 16, 0, 0); \
        __builtin_amdgcn_global_load_lds((const unsigned*)((const char*)(gbase) + (v1)), (LAS unsigned*)(lds + (bufoff) + ldsw + 8192), 16, 0, 0); } while (0)
#define G8_LDA(dst, b, h) do { _Pragma("unroll") for (int m = 0; m < 4; ++m) _Pragma("unroll") for (int k = 0; k < 2; ++k) dst[m][k] = *(const LAS bf16x8*)(lds + G8_SA(b, h) + aoff + m * 2048 + k * 1024); } while (0)
#define G8_LDB(dst, b, h) do { _Pragma("unroll") for (int n = 0; n < 2; ++n) _Pragma("unroll") for (int k = 0; k < 2; ++k) dst[n][k] = *(const LAS bf16x8*)(lds + G8_SB(b, h) + boff + n * 2048 + k * 1024); } while (0)
#define G8_MMA(ai, bj, At, Bt) do { __builtin_amdgcn_s_setprio(1); _Pragma("unroll") for (int m = 0; m < 4; ++m) _Pragma("unroll") for (int n = 0; n < 2; ++n) _Pragma("unroll") for (int k = 0; k < 2; ++k) \
        acc[ai][bj][m][n] = __builtin_amdgcn_mfma_f32_16x16x32_bf16(Bt[n][k], At[m][k], acc[ai][bj][m][n], 0, 0, 0); __builtin_amdgcn_s_setprio(0); } while (0)
#define G8_WAIT_V(n) asm volatile("s_waitcnt vmcnt(" #n ")" ::: "memory")
#define G8_WAIT_L(n) asm volatile("s_waitcnt lgkmcnt(" #n ")" ::: "memory")
#define G8_BAR __builtin_amdgcn_s_barrier()
#define G8_SCHED __builtin_amdgcn_sched_barrier(0)
    U cur, nxt; int ui = 0;
    if (!S.next(0, cur)) return;
    f32x4 acc[2][2][4][2];
#pragma unroll
    for (int a = 0; a < 2; ++a)
#pragma unroll
        for (int b = 0; b < 2; ++b)
#pragma unroll
            for (int m = 0; m < 4; ++m)
#pragma unroll
                for (int n = 0; n < 2; ++n) acc[a][b][m][n] = (f32x4){0.f, 0.f, 0.f, 0.f};
    bf16x8 At[4][2], B0[2][2], B1[2][2];
    unsigned ac00 = S.a_off(cur, 0, Rr[0], Cc[0]), ac01 = S.a_off(cur, 0, Rr[1], Cc[1]), ac10 = S.a_off(cur, 1, Rr[0], Cc[0]), ac11 = S.a_off(cur, 1, Rr[1], Cc[1]);
    const char* cA = cur.A; const char* cB = cur.Bt;
    G8_STAGE(G8_SB(0, 0), cB, vb[0], vb[1]); G8_STAGE(G8_SA(0, 0), cA, ac00, ac01); G8_STAGE(G8_SB(0, 1), cB + hstepB, vb[0], vb[1]); G8_STAGE(G8_SA(0, 1), cA, ac10, ac11);
    if (wr == 1) G8_BAR;
    G8_WAIT_V(4); G8_BAR;
    G8_STAGE(G8_SB(1, 0), cB + kstep, vb[0], vb[1]); G8_STAGE(G8_SA(1, 0), cA + kstep, ac00, ac01); G8_STAGE(G8_SB(1, 1), cB + hstepB + kstep, vb[0], vb[1]);
    G8_WAIT_V(6); G8_BAR;
    for (;;) {
        const bool has_next = S.next(ui + 1, nxt);
        const char* nA = has_next ? nxt.A : cA; const char* nB = has_next ? nxt.Bt : cB;
        unsigned an00 = ac00, an01 = ac01, an10 = ac10, an11 = ac11;
        if (has_next) { an00 = S.a_off(nxt, 0, Rr[0], Cc[0]); an01 = S.a_off(nxt, 0, Rr[1], Cc[1]); an10 = S.a_off(nxt, 1, Rr[0], Cc[0]); an11 = S.a_off(nxt, 1, Rr[1], Cc[1]); }
        for (int t = 0; t < nt; t += 2) {
            const bool last = (t == nt - 2);
            const char* a1 = cA + (size_t)(t + 1) * kstep;
            const char* a2 = last ? nA : cA + (size_t)(t + 2) * kstep; const char* b2 = last ? nB : cB + (size_t)(t + 2) * kstep;
            const char* a3 = a2 + kstep; const char* b3 = b2 + kstep;
            const unsigned s00 = last ? an00 : ac00, s01 = last ? an01 : ac01, s10 = last ? an10 : ac10, s11 = last ? an11 : ac11;
            G8_LDB(B0, 0, 0); G8_SCHED; G8_LDA(At, 0, 0); G8_STAGE(G8_SA(1, 1), a1, ac10, ac11);
            G8_WAIT_L(8); G8_BAR; G8_WAIT_L(0); G8_MMA(0, 0, At, B0); G8_BAR; G8_SCHED;
            G8_LDB(B1, 0, 1); G8_STAGE(G8_SB(0, 0), b2, vb[0], vb[1]);
            G8_BAR; G8_WAIT_L(0); G8_MMA(0, 1, At, B1); G8_BAR;
            G8_LDA(At, 0, 1); G8_STAGE(G8_SA(0, 0), a2, s00, s01);
            G8_BAR; G8_WAIT_L(0); G8_MMA(1, 0, At, B0); G8_BAR; G8_SCHED;
            G8_STAGE(G8_SB(0, 1), b2 + hstepB, vb[0], vb[1]);
            G8_WAIT_V(6); G8_BAR; G8_MMA(1, 1, At, B1); G8_BAR;
            G8_LDB(B0, 1, 0); G8_SCHED; G8_LDA(At, 1, 0); G8_STAGE(G8_SA(0, 1), a2, s10, s11);
            G8_WAIT_L(8); G8_BAR; G8_WAIT_L(0); G8_MMA(0, 0, At, B0); G8_BAR; G8_SCHED;
            G8_LDB(B1, 1, 1); G8_STAGE(G8_SB(1, 0), b3, vb[0], vb[1]);
            G8_BAR; G8_WAIT_L(0); G8_MMA(0, 1, At, B1); G8_BAR;
            G8_LDA(At, 1, 1); G8_STAGE(G8_SA(1, 0), a3, s00, s01);
            G8_BAR; G8_WAIT_L(0); G8_MMA(1, 0, At, B0); G8_BAR; G8_SCHED;
            G8_STAGE(G8_SB(1, 1), b3 + hstepB, vb[0], vb[1]);
            G8_WAIT_V(6); G8_BAR; G8_MMA(1, 1, At, B1); G8_BAR;
        }
        E(acc, cur, wr, wc, fr, fq);
        if (!has_next) break;
#pragma unroll
        for (int a = 0; a < 2; ++a)
#pragma unroll
            for (int b = 0; b < 2; ++b)
#pragma unroll
                for (int m = 0; m < 4; ++m)
#pragma unroll
                    for (int n = 0; n < 2; ++n) acc[a][b][m][n] = (f32x4){0.f, 0.f, 0.f, 0.f};
        cur = nxt; cA = nA; cB = nB; ac00 = an00; ac01 = an01; ac10 = an10; ac11 = an11; ++ui;
    }
    G8_WAIT_V(0);
    if (wr == 0) G8_BAR;
    G8_BAR;
#undef G8_SA
#undef G8_SB
#undef G8_STAGE
#undef G8_LDA
#undef G8_LDB
#undef G8_MMA
#undef G8_WAIT_V
#undef G8_WAIT_L
#undef G8_BAR
#undef G8_SCHED
}
struct EpiBf16 {
    bf16* O; int ld, ncols; float* FL; int fl0;
    DEVI void operator()(const f32x4 (&acc)[2][2][4][2], const U& u, int wr, int wc, int fr, int fq) const {
        const int row0 = u.pm * BM + wr * 64 + fr, col0 = u.pn * BM + wc * 32 + 4 * fq;
#pragma unroll
        for (int ai = 0; ai < 2; ++ai)
#pragma unroll
            for (int m = 0; m < 4; ++m) { const int row = row0 + ai * HALF + m * 16;
#pragma unroll
                for (int bj = 0; bj < 2; ++bj)
#pragma unroll
                    for (int n = 0; n < 2; ++n) { const int col = col0 + bj * HALF + n * 16; const f32x4 v = acc[ai][bj][m][n];
                        if (col < ncols) { uint2 w; w.x = pk2(v[0], v[1]); w.y = pk2(v[2], v[3]); *(uint2*)(O + (size_t)row * ld + col) = w;
                            if (FL && col >= fl0) *(f32x4*)(FL + (size_t)row * 8 + (col - fl0)) = v; } } }
    }
};
struct EpiRes {
    float* C; const float* res; int ld; float alpha;
    DEVI void operator()(const f32x4 (&acc)[2][2][4][2], const U& u, int wr, int wc, int fr, int fq) const {
        const int row0 = u.pm * BM + wr * 64 + fr, col0 = u.pn * BM + wc * 32 + 4 * fq;
#pragma unroll
        for (int ai = 0; ai < 2; ++ai)
#pragma unroll
            for (int m = 0; m < 4; ++m) { const size_t ro = (size_t)(row0 + ai * HALF + m * 16) * ld + col0;
#pragma unroll
                for (int bj = 0; bj < 2; ++bj)
#pragma unroll
                    for (int n = 0; n < 2; ++n) { const size_t o = ro + bj * HALF + n * 16; *(f32x4*)(C + o) = *(const f32x4*)(res + o) * alpha + acc[ai][bj][m][n]; } }
    }
};

struct MoeOrder {
    const LAS int* sh; const int* list; const char* A; const char* W; int lda, K, ntn, G, c, stage; size_t wstride;
    DEVI bool next(int i, U& u) const {
        const int L = i * G + c; if (L >= sh[33 + 32]) return false;
        int e = 0; while (sh[33 + e + 1] <= L) ++e;
        const int r = L - sh[33 + e]; u.pm = r / ntn; u.pn = r % ntn; u.x0 = e; u.x1 = sh[e + 1] - sh[e]; u.x2 = sh[e];
        u.A = A; u.Bt = W + (size_t)e * wstride + (size_t)u.pn * BM * K * 2; return true;
    }
    DEVI unsigned a_off(const U& u, int h, int R, int C) const {
        int i = u.pm * BM + h * HALF + R; if (i > u.x1 - 1) i = u.x1 - 1;
        const int row = stage == 1 ? (list[u.x0 * T + i] >> 1) : (u.x2 + i);
        return (unsigned)(row * lda + C) * 2u;
    }
};
struct EpiMoe1 {
    bf16* hdn;
    DEVI void operator()(const f32x4 (&acc)[2][2][4][2], const U& u, int wr, int wc, int fr, int fq) const {
        const int i0 = u.pm * BM + wr * 64 + fr, j0 = u.pn * HALF + wc * 32 + 4 * fq;
#pragma unroll
        for (int ai = 0; ai < 2; ++ai)
#pragma unroll
            for (int m = 0; m < 4; ++m) { const int i = i0 + ai * HALF + m * 16;
                if (i < u.x1) {
#pragma unroll
                    for (int n = 0; n < 2; ++n) { const f32x4 gv = acc[ai][0][m][n], uv = acc[ai][1][m][n]; float hv[4];
#pragma unroll
                        for (int q = 0; q < 4; ++q) hv[q] = gv[q] / (1.f + __expf(-gv[q])) * uv[q];
                        uint2 w; w.x = pk2(hv[0], hv[1]); w.y = pk2(hv[2], hv[3]);
                        *(uint2*)(hdn + (size_t)(u.x2 + i) * FF + j0 + n * 16) = w; } } }
    }
};
struct EpiMoe2 {
    float* Y; const int* list; const float* ew;
    DEVI void operator()(const f32x4 (&acc)[2][2][4][2], const U& u, int wr, int wc, int fr, int fq) const {
        const int i0 = u.pm * BM + wr * 64 + fr, col0 = u.pn * BM + wc * 32 + 4 * fq;
#pragma unroll
        for (int ai = 0; ai < 2; ++ai)
#pragma unroll
            for (int m = 0; m < 4; ++m) { const int i = i0 + ai * HALF + m * 16;
                if (i < u.x1) { const int ent = list[u.x0 * T + i]; const float wt = ew[ent]; float* yr = Y + (size_t)ent * DM + col0;
#pragma unroll
                    for (int bj = 0; bj < 2; ++bj)
#pragma unroll
                        for (int n = 0; n < 2; ++n) *(f32x4*)(yr + bj * HALF + n * 16) = acc[ai][bj][m][n] * wt; } }
    }
};
}

DEVI void transpose_item(const float* W, int K, int Nsrc, int src_c0, bf16* WT, int dst_r0, int k0, LAS float* scr, int lane) {
    const int cc = src_c0 + (lane & 31); const bool ok = src_c0 >= 0 && cc < Nsrc;
#pragma unroll 8
    for (int i = 0; i < 32; ++i) { const int kk = 2 * i + (lane >> 5); scr[kk * 33 + (lane & 31)] = ok ? W[(size_t)(k0 + kk) * Nsrc + cc] : 0.f; }
    asm volatile("s_waitcnt lgkmcnt(0)" ::: "memory");
    const int c = lane & 7;
#pragma unroll
    for (int j = 0; j < 4; ++j) { const int n = (lane >> 3) + 8 * j; const LAS float* sp = scr + (8 * c) * 33 + n;
        u32x4 o; o[0] = pk2(sp[0 * 33], sp[1 * 33]); o[1] = pk2(sp[2 * 33], sp[3 * 33]); o[2] = pk2(sp[4 * 33], sp[5 * 33]); o[3] = pk2(sp[6 * 33], sp[7 * 33]);
        *(u32x4*)(WT + (size_t)(dst_r0 + n) * K + k0 + 8 * c) = o; }
    asm volatile("s_waitcnt lgkmcnt(0)" ::: "memory");
}
template <class Map>
DEVI void cvt_matrix(const float* W, int K, int Nsrc, int Ndst, bf16* WT, Map smap, LAS float* scr, int gw, int ngw, int lane, int& base) {
    const int nblk = Ndst / 32, n = (K / 64) * nblk;
    int first = (gw - base % ngw + ngw) % ngw;
    for (int it = first; it < n; it += ngw) { const int kb = it / nblk, nb_ = it % nblk; transpose_item(W, K, Nsrc, smap(nb_ * 32), WT, nb_ * 32, kb * 64, scr, lane); }
    base += n;
}

template <int DK1, int DK2, int DV, class Bias>
DEVI void attn_range(const float* qs, const bf16* K1, int ldk1, const bf16* K2, int ldk2, const bf16* V, int ldv,
                     int j0, int j1, float scale, Bias bias, float& m, float& l, float (&o)[2], int lane) {
    for (int jb = j0; jb < j1; jb += 64) {
        const int j = jb + lane; const bool valid = j < j1;
        float s = -__builtin_inff();
        if (valid) {
            float acc = 0.f;
            const bf16* kr = K1 + (size_t)j * ldk1;
#pragma unroll 4
            for (int d = 0; d < DK1; d += 8) {
                const u32x4 kv = *(const u32x4*)(kr + d); const f32x4 q0 = *(const f32x4*)(qs + d), q1 = *(const f32x4*)(qs + d + 4);
                acc += q0[0] * bflo(kv[0]) + q0[1] * bfhi(kv[0]) + q0[2] * bflo(kv[1]) + q0[3] * bfhi(kv[1])
                     + q1[0] * bflo(kv[2]) + q1[1] * bfhi(kv[2]) + q1[2] * bflo(kv[3]) + q1[3] * bfhi(kv[3]);
            }
            if (DK2 > 0) {
                const bf16* kr2 = K2 + (size_t)j * ldk2;
#pragma unroll 4
                for (int d = 0; d < DK2; d += 8) {
                    const u32x4 kv = *(const u32x4*)(kr2 + d); const f32x4 q0 = *(const f32x4*)(qs + DK1 + d), q1 = *(const f32x4*)(qs + DK1 + d + 4);
                    acc += q0[0] * bflo(kv[0]) + q0[1] * bfhi(kv[0]) + q0[2] * bflo(kv[1]) + q0[3] * bfhi(kv[1])
                         + q1[0] * bflo(kv[2]) + q1[1] * bfhi(kv[2]) + q1[2] * bflo(kv[3]) + q1[3] * bfhi(kv[3]);
                }
            }
            s = acc * scale + bias(j);
        }
        const float cm = wave_max(s);
        const float mn = fmaxf(m, cm);
        const float alpha = __expf(m - mn);
        const float p = __expf(s - mn);
        l = l * alpha + wave_sum(p);
        o[0] *= alpha; o[1] *= alpha;
        m = mn;
        const int cnt = (j1 - jb) < 64 ? (j1 - jb) : 64;
        for (int jj = 0; jj < cnt; ++jj) {
            const float pj = __shfl(p, jj);
            const bf16* vr = V + (size_t)(jb + jj) * ldv;
            if (DV == 128) { const unsigned vv = *(const unsigned*)(vr + lane * 2); o[0] += pj * bflo(vv); o[1] += pj * bfhi(vv); }
            else { o[0] += pj * bf2f(vr[lane]); }
        }
    }
}


typedef short s16x4 __attribute__((ext_vector_type(4)));
typedef float f32x16 __attribute__((ext_vector_type(16)));
constexpr int FA_V = 0, FA_K = 32768, FA_KR = 65536, FA_CUM = 81920, FA_WS = 82432, FA_Q = 131072 + 512, FA_KM = 84992, FA_END = 93184;
constexpr int SHM_K = 16384, SHM_V = 16384, SHM_KR = 8192;
#define KSWZ(row, colB) ((row) * 256 + ((colB) ^ (((row) & 7) << 4)))
DEVI int v_st(int k, int c) { const int kk = (k & ~0xC) | ((k & 4) << 1) | ((k & 8) >> 1); return ((kk >> 3) * 4 + (c >> 5)) * 512 + ((kk & 7) * 32 + (c & 31)) * 2; }
DEVI int v_rd_base(int lane) { return ((lane & 3) << 3) | (((lane >> 2) & 3) << 6) | (((lane >> 4) & 1) << 5) | (((lane >> 5) & 1) << 8); }
DEVI int crow(int r, int hi) { return (r & 3) + 8 * (r >> 2) + 4 * hi; }
DEVI unsigned cvtpk(float lo, float hi) { unsigned r; asm volatile("v_cvt_pk_bf16_f32 %0, %1, %2" : "=v"(r) : "v"(lo), "v"(hi)); return r; }
enum { FM_MLA = 0, FM_FOX = 1, FM_MOBA = 2 };

template <int MODE>
DEVI void flash_unit(char* lds, const bf16* Qp, int ldq, const bf16* Kp, int ldk, const bf16* Vp, int ldv, const bf16* KRp,
                     const float* cum, const float* km, float slope, int q0, bf16* Op, int ldo) {
    const int tid = threadIdx.x, wid = __builtin_amdgcn_readfirstlane(tid >> 6), lane = tid & 63, r32 = lane & 31, hi = lane >> 5;
    char* V_lds = lds + FA_V; char* K_lds = lds + FA_K; char* KR_lds = lds + FA_KR;
    float* cumt = (float*)(lds + FA_CUM);
    float* wsf = (float*)(lds + FA_WS) + wid * 64; float* li_l = wsf; float* al_l = wsf + 32;
    const int qrow = q0 + wid * 32 + r32;
    constexpr float LOG2E = 1.4426950408889634f;
    constexpr float SC = (MODE == FM_MLA ? 0.07216878364870322f : 0.08838834764831845f) * LOG2E;
    constexpr int NQ = MODE == FM_MLA ? 12 : 8;
    bf16x8 qr[NQ];
    const bf16* qp = Qp + (size_t)qrow * ldq;
#pragma unroll
    for (int d0 = 0; d0 < 8; ++d0) qr[d0] = *(const bf16x8*)(qp + d0 * 16 + hi * 8);
    if constexpr (MODE == FM_MLA) {
        const bf16x8 a0 = *(const bf16x8*)(qp + 128 + hi * 8), a1 = *(const bf16x8*)(qp + 144 + hi * 8);
        const bf16x8 b0 = *(const bf16x8*)(qp + 160 + hi * 8), b1 = *(const bf16x8*)(qp + 176 + hi * 8);
        bf16x8 ra0, ra1, rb0, rb1;
#pragma unroll
        for (int e = 0; e < 8; ++e) {
            float c, s_;
            rope_cs(qrow, hi * 8 + e, c, s_);
            { const float t1 = bf2f((unsigned short)a0[e]), t2 = bf2f((unsigned short)b0[e]); ra0[e] = (short)f2bf(t1 * c - t2 * s_); rb0[e] = (short)f2bf(t1 * s_ + t2 * c); }
            rope_cs(qrow, 16 + hi * 8 + e, c, s_);
            { const float t1 = bf2f((unsigned short)a1[e]), t2 = bf2f((unsigned short)b1[e]); ra1[e] = (short)f2bf(t1 * c - t2 * s_); rb1[e] = (short)f2bf(t1 * s_ + t2 * c); }
        }
        qr[8] = ra0; qr[9] = ra1; qr[10] = rb0; qr[11] = rb1;
    }
    const int j_hi = (q0 >> 6) + 4;
    unsigned sel = 0xffffffffu, umask = 0xffffffffu;
    if constexpr (MODE == FM_MOBA) {
        const int blk = q0 >> 8;
        float* kml = (float*)(lds + FA_KM);
        unsigned* um = (unsigned*)(lds + FA_Q) + 4;
        *(f32x4*)(kml + tid * 4) = *(const f32x4*)(km + tid * 4);
        if (tid == 0) *um = 0u;
        __syncthreads();
        float g[15];
#pragma unroll
        for (int n = 0; n < 15; ++n) g[n] = 0.f;
        for (int dd = 0; dd < 64; dd += 8) {
            const bf16x8 qv = *(const bf16x8*)(qp + hi * 64 + dd);
            float qf[8];
#pragma unroll
            for (int e = 0; e < 8; ++e) qf[e] = bf2f((unsigned short)qv[e]);
#pragma unroll
            for (int n = 0; n < 15; ++n)
                if (n < blk) {
                    const f32x4 k0 = *(const f32x4*)(kml + n * 128 + hi * 64 + dd), k1 = *(const f32x4*)(kml + n * 128 + hi * 64 + dd + 4);
                    g[n] += qf[0] * k0[0] + qf[1] * k0[1] + qf[2] * k0[2] + qf[3] * k0[3] + qf[4] * k1[0] + qf[5] * k1[1] + qf[6] * k1[2] + qf[7] * k1[3];
                }
        }
#pragma unroll
        for (int n = 0; n < 15; ++n) g[n] += __shfl_xor(g[n], 32);
        sel = 1u << blk;
#pragma unroll
        for (int r = 0; r < 3; ++r) {
            float best = -__builtin_inff(); int bi = -1;
#pragma unroll
            for (int n = 0; n < 15; ++n) if (n < blk && !((sel >> n) & 1u) && g[n] > best) { best = g[n]; bi = n; }
            if (bi >= 0) sel |= 1u << bi;
        }
        unsigned wm_ = 0u;
#pragma unroll
        for (int n = 0; n < 16; ++n) if (__any((sel >> n) & 1u)) wm_ |= 1u << n;
        if (lane == 0) atomicOr(um, wm_);
        __syncthreads();
        umask = *um;
    }
    auto nxt = [&](int j) { do { ++j; } while (j < j_hi && !((umask >> (j >> 2)) & 1u)); return j; };
    int jc = nxt(-1);
    const int sr = tid >> 4, sc = (tid & 15) * 8;
    const int kws = KSWZ(sr, sc * 2), vst0 = v_st(sr, sc), vst1 = v_st(32 + sr, sc);
    const int krk = tid >> 3, krc = tid & 7, krw = krk * 128 + ((krc ^ (krk & 7)) << 4);
    bf16x8 st_k0, st_k1, st_v0, st_v1, st_kr; float st_c = 0.f;
#define FA_GL(kb) do { const unsigned ko_ = (unsigned)(((kb) + sr) * ldk + sc) * 2u, vo_ = (unsigned)(((kb) + sr) * ldv + sc) * 2u; \
        st_k0 = *(const bf16x8*)((const char*)Kp + ko_); st_k1 = *(const bf16x8*)((const char*)Kp + ko_ + (unsigned)(64 * ldk)); \
        st_v0 = *(const bf16x8*)((const char*)Vp + vo_); st_v1 = *(const bf16x8*)((const char*)Vp + vo_ + (unsigned)(64 * ldv)); \
        if constexpr (MODE == FM_MLA) st_kr = *(const bf16x8*)((const char*)KRp + (unsigned)(((kb) + krk) * 64 + krc * 8) * 2u); \
        if constexpr (MODE == FM_FOX) { if (tid < 64) st_c = cum[(kb) + tid]; } } while (0)
#define FA_SW(bf) do { *(bf16x8*)(K_lds + (bf) * SHM_K + kws) = st_k0; *(bf16x8*)(K_lds + (bf) * SHM_K + kws + 32 * 256) = st_k1; \
        *(bf16x8*)(V_lds + (bf) * SHM_V + vst0) = st_v0; *(bf16x8*)(V_lds + (bf) * SHM_V + vst1) = st_v1; \
        if constexpr (MODE == FM_MLA) *(bf16x8*)(KR_lds + (bf) * SHM_KR + krw) = st_kr; \
        if constexpr (MODE == FM_FOX) { if (tid < 64) cumt[(bf) * 64 + tid] = st_c; } } while (0)
    FA_GL(jc * 64);
    asm volatile("s_waitcnt vmcnt(0)" ::: "memory");
    FA_SW(0);
    float m_reg = -1e30f, l_reg = 0.f;
    f32x16 o[4];
#pragma unroll
    for (int d = 0; d < 4; ++d)
#pragma unroll
        for (int r = 0; r < 16; ++r) o[d][r] = 0.f;
    float cqL = 0.f;
    if constexpr (MODE == FM_FOX) cqL = cum[qrow];
    const float slopeL = slope * LOG2E;
    const int vb0 = (int)(unsigned)(size_t)((LAS char*)V_lds) + v_rd_base(lane);
    int bf = 0;
    while (jc < j_hi) {
        const int kb = jc * 64;
        const int jn = nxt(jc);
        __syncthreads();
        if (jn < j_hi) FA_GL(jn * 64);
        f32x16 p0, p1;
#pragma unroll
        for (int r = 0; r < 16; ++r) { p0[r] = 0.f; p1[r] = 0.f; }
        {
            const char* kbase = K_lds + bf * SHM_K;
            const char* kbp[4];
#pragma unroll
            for (int dd = 0; dd < 4; ++dd) kbp[dd] = kbase + KSWZ(r32, (dd * 16 + hi * 8) * 2);
#pragma unroll
            for (int d0 = 0; d0 < 8; ++d0) {
                const char* ap = kbp[d0 & 3] + (d0 >> 2) * 128;
                const bf16x8 b0 = *(const bf16x8*)(ap), b1 = *(const bf16x8*)(ap + 32 * 256);
                p0 = __builtin_amdgcn_mfma_f32_32x32x16_bf16(b0, qr[d0], p0, 0, 0, 0);
                p1 = __builtin_amdgcn_mfma_f32_32x32x16_bf16(b1, qr[d0], p1, 0, 0, 0);
            }
            if constexpr (MODE == FM_MLA) {
                const char* krb = KR_lds + bf * SHM_KR + r32 * 128;
#pragma unroll
                for (int d = 0; d < 4; ++d) {
                    const int off = (((d * 2 + hi) ^ (r32 & 7)) << 4);
                    const bf16x8 b0 = *(const bf16x8*)(krb + off), b1 = *(const bf16x8*)(krb + 32 * 128 + off);
                    p0 = __builtin_amdgcn_mfma_f32_32x32x16_bf16(b0, qr[8 + d], p0, 0, 0, 0);
                    p1 = __builtin_amdgcn_mfma_f32_32x32x16_bf16(b1, qr[8 + d], p1, 0, 0, 0);
                }
            }
        }
        if (jn < j_hi) { asm volatile("s_waitcnt vmcnt(0)" ::: "memory"); FA_SW(bf ^ 1); }
        if constexpr (MODE == FM_FOX) {
#pragma unroll
            for (int g4 = 0; g4 < 4; ++g4) {
                const f32x4 c0 = *(const f32x4*)(cumt + bf * 64 + 8 * g4 + 4 * hi), c1 = *(const f32x4*)(cumt + bf * 64 + 32 + 8 * g4 + 4 * hi);
#pragma unroll
                for (int i = 0; i < 4; ++i) { p0[4 * g4 + i] = p0[4 * g4 + i] * SC + (cqL - c0[i]) * LOG2E; p1[4 * g4 + i] = p1[4 * g4 + i] * SC + (cqL - c1[i]) * LOG2E; }
            }
        } else if constexpr (MODE == FM_MOBA) {
            const float dq = (float)(qrow - kb - 4 * hi);
#pragma unroll
            for (int r = 0; r < 16; ++r) { const float c = (float)((r & 3) + 8 * (r >> 2));
                p0[r] = p0[r] * SC - slopeL * (dq - c); p1[r] = p1[r] * SC - slopeL * (dq - c - 32.f); }
        } else {
#pragma unroll
            for (int r = 0; r < 16; ++r) { p0[r] *= SC; p1[r] *= SC; }
        }
        const float NEG = -__builtin_inff();
        if (kb + 63 > q0 + wid * 32) {
            const int dqi = qrow - kb - 4 * hi;
#pragma unroll
            for (int r = 0; r < 16; ++r) { const int c = (r & 3) + 8 * (r >> 2); if (c > dqi) p0[r] = NEG; if (c + 32 > dqi) p1[r] = NEG; }
        }
        if constexpr (MODE == FM_MOBA) {
            if (!((sel >> (kb >> 8)) & 1u)) {
#pragma unroll
                for (int r = 0; r < 16; ++r) { p0[r] = NEG; p1[r] = NEG; }
            }
        }
        float pmax = p0[0];
#pragma unroll
        for (int r = 1; r < 16; ++r) pmax = fmaxf(pmax, p0[r]);
#pragma unroll
        for (int r = 0; r < 16; ++r) pmax = fmaxf(pmax, p1[r]);
        { auto rr = __builtin_amdgcn_permlane32_swap(__float_as_uint(pmax), __float_as_uint(pmax), false, false);
          pmax = fmaxf(__uint_as_float(rr[0]), __uint_as_float(rr[1])); }
        const float mn = fmaxf(m_reg, pmax);
        const float alpha = __builtin_amdgcn_exp2f(m_reg - mn);
        m_reg = mn;
        float ps = 0.f;
#pragma unroll
        for (int r = 0; r < 16; ++r) { p0[r] = __builtin_amdgcn_exp2f(p0[r] - mn); p1[r] = __builtin_amdgcn_exp2f(p1[r] - mn); ps += p0[r] + p1[r]; }
        { auto rr = __builtin_amdgcn_permlane32_swap(__float_as_uint(ps), __float_as_uint(ps), false, false);
          ps = __uint_as_float(rr[0]) + __uint_as_float(rr[1]); }
        l_reg = l_reg * alpha + ps;
        bf16x8 pa0, pa1, pa2, pa3;
#define PK4(P, B_, OUT) do { unsigned a0_ = cvtpk(P[B_ + 0], P[B_ + 1]), a1_ = cvtpk(P[B_ + 2], P[B_ + 3]); \
        unsigned b0_ = cvtpk(P[B_ + 4], P[B_ + 5]), b1_ = cvtpk(P[B_ + 6], P[B_ + 7]); \
        auto r0_ = __builtin_amdgcn_permlane32_swap(a0_, b0_, false, false); auto r1_ = __builtin_amdgcn_permlane32_swap(a1_, b1_, false, false); \
        u32x4 w_ = {r0_[0], r1_[0], r0_[1], r1_[1]}; OUT = *reinterpret_cast<bf16x8*>(&w_); } while (0)
        PK4(p0, 0, pa0); PK4(p0, 8, pa1); PK4(p1, 0, pa2); PK4(p1, 8, pa3);
#undef PK4
        if (__any(alpha < 1.f)) {
            if (hi == 0) al_l[r32] = alpha;
            asm volatile("s_waitcnt lgkmcnt(0)" ::: "memory");
#pragma unroll
            for (int d = 0; d < 4; ++d)
#pragma unroll
                for (int r = 0; r < 16; ++r) o[d][r] *= al_l[crow(r, hi)];
        }
        {
            const int vb = vb0 + bf * SHM_V;
#define TRRD(dst, off) asm volatile("ds_read_b64_tr_b16 %0, %1 offset:%2" : "=&v"(dst) : "v"(vb), "i"(off) : "memory")
#define PV_D0(d0) do { s16x4 l0, l1, l2, l3, h0, h1, h2, h3; constexpr int b_ = (d0) * 512; \
        TRRD(l0, b_); TRRD(h0, b_ + 2048); TRRD(l1, b_ + 4096); TRRD(h1, b_ + 6144); TRRD(l2, b_ + 8192); TRRD(h2, b_ + 10240); TRRD(l3, b_ + 12288); TRRD(h3, b_ + 14336); \
        asm volatile("s_waitcnt lgkmcnt(0)" ::: "memory"); __builtin_amdgcn_sched_barrier(0); \
        o[d0] = __builtin_amdgcn_mfma_f32_32x32x16_bf16(pa0, (bf16x8){l0[0], l0[1], l0[2], l0[3], h0[0], h0[1], h0[2], h0[3]}, o[d0], 0, 0, 0); \
        o[d0] = __builtin_amdgcn_mfma_f32_32x32x16_bf16(pa1, (bf16x8){l1[0], l1[1], l1[2], l1[3], h1[0], h1[1], h1[2], h1[3]}, o[d0], 0, 0, 0); \
        o[d0] = __builtin_amdgcn_mfma_f32_32x32x16_bf16(pa2, (bf16x8){l2[0], l2[1], l2[2], l2[3], h2[0], h2[1], h2[2], h2[3]}, o[d0], 0, 0, 0); \
        o[d0] = __builtin_amdgcn_mfma_f32_32x32x16_bf16(pa3, (bf16x8){l3[0], l3[1], l3[2], l3[3], h3[0], h3[1], h3[2], h3[3]}, o[d0], 0, 0, 0); } while (0)
            PV_D0(0); PV_D0(1); PV_D0(2); PV_D0(3);
#undef PV_D0
#undef TRRD
        }
        bf ^= 1; jc = jn;
    }
#undef FA_GL
#undef FA_SW
    if (hi == 0) li_l[r32] = l_reg;
    asm volatile("s_waitcnt lgkmcnt(0)" ::: "memory");
    int tz = lane; asm volatile("" : "+v"(tz));
    const int hz = tz >> 5, rz = tz & 31;
    bf16* Ow = Op + (size_t)(q0 + wid * 32) * ldo;
#pragma unroll
    for (int r = 0; r < 16; ++r) {
        const int orow = crow(r, hz);
        const float rl = 1.f / li_l[orow];
        const unsigned obase = (unsigned)(orow * ldo + rz);
#pragma unroll
        for (int d0 = 0; d0 < 4; ++d0) {
            const float v = o[d0][r] * rl;
            const float vn = __shfl_xor(v, 1);
            if ((rz & 1) == 0) *(unsigned*)(Ow + obase + d0 * 32) = cvtpk(v, vn);
        }
    }
    __syncthreads();
}


constexpr int SW_V = 0, SW_K = 49152, SW_WS = 98304;
DEVI void swa_unit(char* lds, const bf16* Pb  , int kvh, int q0, const float* sinks, bf16* Ob  ) {
    const int tid = threadIdx.x, wid = __builtin_amdgcn_readfirstlane(tid >> 6), lane = tid & 63, r32 = lane & 31, hi = lane >> 5;
    char* V_lds = lds + SW_V; char* K_lds = lds + SW_K;
    float* wsf = (float*)(lds + SW_WS) + wid * 64; float* li_l = wsf; float* al_l = wsf + 32;
    constexpr float LOG2E = 1.4426950408889634f, SC = 0.125f * LOG2E;
    const int qh = kvh * 8 + wid;
    const float slopeL = exp2f(-0.5f * (float)(qh + 1)) * LOG2E, sinkL = sinks[qh] * LOG2E;
    {
        const int key = tid >> 3, ch = tid & 7;
        const int kws = KSWZ(key, ch * 16), vws = v_st(key, ch * 8);
        bf16x8 sk[3], sv[3];
#pragma unroll
        for (int jt = 0; jt < 3; ++jt) {
            const int kb = q0 - 128 + jt * 64;
            if (kb >= 0) {
                const unsigned o_ = (unsigned)((kb + key) * LDP + ch * 8) * 2u;
                sk[jt] = *(const bf16x8*)((const char*)Pb + o_ + (unsigned)(O_SK + kvh * 64) * 2u);
                sv[jt] = *(const bf16x8*)((const char*)Pb + o_ + (unsigned)(O_SV + kvh * 64) * 2u);
            }
        }
#pragma unroll
        for (int jt = 0; jt < 3; ++jt) {
            const int kb = q0 - 128 + jt * 64;
            if (kb >= 0) { *(bf16x8*)(K_lds + jt * SHM_K + kws) = sk[jt]; *(bf16x8*)(V_lds + jt * SHM_V + vws) = sv[jt]; }
        }
    }
    __syncthreads();
    const int vb0 = (int)(unsigned)(size_t)((LAS char*)V_lds) + v_rd_base(lane);
    for (int rg = 0; rg < 2; ++rg) {
        const int qrow = q0 + rg * 32 + r32;
        bf16x8 qr[4];
        const bf16* qp = Pb + (size_t)qrow * LDP + O_SQ + qh * 64;
#pragma unroll
        for (int d0 = 0; d0 < 4; ++d0) qr[d0] = *(const bf16x8*)(qp + d0 * 16 + hi * 8);
        float m_reg = -1e30f, l_reg = 0.f;
        f32x16 o[2];
#pragma unroll
        for (int d = 0; d < 2; ++d)
#pragma unroll
            for (int r = 0; r < 16; ++r) o[d][r] = 0.f;
#pragma unroll 1
        for (int jt = 0; jt < 3; ++jt) {
            const int kb = q0 - 128 + jt * 64;
            if (kb < 0) continue;
            f32x16 p0, p1;
#pragma unroll
            for (int r = 0; r < 16; ++r) { p0[r] = 0.f; p1[r] = 0.f; }
            {
                const char* kbase = K_lds + jt * SHM_K;
#pragma unroll
                for (int d0 = 0; d0 < 4; ++d0) {
                    const char* ap = kbase + KSWZ(r32, (d0 * 16 + hi * 8) * 2);
                    const bf16x8 b0 = *(const bf16x8*)(ap), b1 = *(const bf16x8*)(ap + 32 * 256);
                    p0 = __builtin_amdgcn_mfma_f32_32x32x16_bf16(b0, qr[d0], p0, 0, 0, 0);
                    p1 = __builtin_amdgcn_mfma_f32_32x32x16_bf16(b1, qr[d0], p1, 0, 0, 0);
                }
            }
            const float NEG = -__builtin_inff();
            const int dqi = qrow - kb - 4 * hi;
#pragma unroll
            for (int r = 0; r < 16; ++r) {
                const int c = (r & 3) + 8 * (r >> 2);
                const int d0_ = dqi - c, d1_ = dqi - c - 32;
                p0[r] = ((unsigned)d0_ < 128u) ? p0[r] * SC - slopeL * (float)d0_ : NEG;
                p1[r] = ((unsigned)d1_ < 128u) ? p1[r] * SC - slopeL * (float)d1_ : NEG;
            }
            float pmax = p0[0];
#pragma unroll
            for (int r = 1; r < 16; ++r) pmax = fmaxf(pmax, p0[r]);
#pragma unroll
            for (int r = 0; r < 16; ++r) pmax = fmaxf(pmax, p1[r]);
            { auto rr = __builtin_amdgcn_permlane32_swap(__float_as_uint(pmax), __float_as_uint(pmax), false, false);
              pmax = fmaxf(__uint_as_float(rr[0]), __uint_as_float(rr[1])); }
            const float mn = fmaxf(m_reg, pmax);
            const float alpha = __builtin_amdgcn_exp2f(m_reg - mn);
            m_reg = mn;
            float ps = 0.f;
#pragma unroll
            for (int r = 0; r < 16; ++r) { p0[r] = __builtin_amdgcn_exp2f(p0[r] - mn); p1[r] = __builtin_amdgcn_exp2f(p1[r] - mn); ps += p0[r] + p1[r]; }
            { auto rr = __builtin_amdgcn_permlane32_swap(__float_as_uint(ps), __float_as_uint(ps), false, false);
              ps = __uint_as_float(rr[0]) + __uint_as_float(rr[1]); }
            l_reg = l_reg * alpha + ps;
            bf16x8 pa0, pa1, pa2, pa3;
#define PK4(P, B_, OUT) do { unsigned a0_ = cvtpk(P[B_ + 0], P[B_ + 1]), a1_ = cvtpk(P[B_ + 2], P[B_ + 3]); \
        unsigned b0_ = cvtpk(P[B_ + 4], P[B_ + 5]), b1_ = cvtpk(P[B_ + 6], P[B_ + 7]); \
        auto r0_ = __builtin_amdgcn_permlane32_swap(a0_, b0_, false, false); auto r1_ = __builtin_amdgcn_permlane32_swap(a1_, b1_, false, false); \
        u32x4 w_ = {r0_[0], r1_[0], r0_[1], r1_[1]}; OUT = *reinterpret_cast<bf16x8*>(&w_); } while (0)
            PK4(p0, 0, pa0); PK4(p0, 8, pa1); PK4(p1, 0, pa2); PK4(p1, 8, pa3);
#undef PK4
            if (__any(alpha < 1.f)) {
                if (hi == 0) al_l[r32] = alpha;
                asm volatile("s_waitcnt lgkmcnt(0)" ::: "memory");
#pragma unroll
                for (int d = 0; d < 2; ++d)
#pragma unroll
                    for (int r = 0; r < 16; ++r) o[d][r] *= al_l[crow(r, hi)];
            }
            {
                const int vb = vb0 + jt * SHM_V;
#define TRRD(dst, off) asm volatile("ds_read_b64_tr_b16 %0, %1 offset:%2" : "=&v"(dst) : "v"(vb), "i"(off) : "memory")
#define PV_D0(d0) do { s16x4 l0, l1, l2, l3, h0, h1, h2, h3; constexpr int b_ = (d0) * 512; \
        TRRD(l0, b_); TRRD(h0, b_ + 2048); TRRD(l1, b_ + 4096); TRRD(h1, b_ + 6144); TRRD(l2, b_ + 8192); TRRD(h2, b_ + 10240); TRRD(l3, b_ + 12288); TRRD(h3, b_ + 14336); \
        asm volatile("s_waitcnt lgkmcnt(0)" ::: "memory"); __builtin_amdgcn_sched_barrier(0); \
        o[d0] = __builtin_amdgcn_mfma_f32_32x32x16_bf16(pa0, (bf16x8){l0[0], l0[1], l0[2], l0[3], h0[0], h0[1], h0[2], h0[3]}, o[d0], 0, 0, 0); \
        o[d0] = __builtin_amdgcn_mfma_f32_32x32x16_bf16(pa1, (bf16x8){l1[0], l1[1], l1[2], l1[3], h1[0], h1[1], h1[2], h1[3]}, o[d0], 0, 0, 0); \
        o[d0] = __builtin_amdgcn_mfma_f32_32x32x16_bf16(pa2, (bf16x8){l2[0], l2[1], l2[2], l2[3], h2[0], h2[1], h2[2], h2[3]}, o[d0], 0, 0, 0); \
        o[d0] = __builtin_amdgcn_mfma_f32_32x32x16_bf16(pa3, (bf16x8){l3[0], l3[1], l3[2], l3[3], h3[0], h3[1], h3[2], h3[3]}, o[d0], 0, 0, 0); } while (0)
                PV_D0(0); PV_D0(1);
#undef PV_D0
#undef TRRD
            }
        }
        const float mf = fmaxf(m_reg, sinkL), al = __builtin_amdgcn_exp2f(m_reg - mf);
        const float lf = l_reg * al + __builtin_amdgcn_exp2f(sinkL - mf);
        if (hi == 0) li_l[r32] = al / lf;
        asm volatile("s_waitcnt lgkmcnt(0)" ::: "memory");
        int tz = lane; asm volatile("" : "+v"(tz));
        const int hz = tz >> 5, rz = tz & 31;
        bf16* Ow = Ob + (size_t)(q0 + rg * 32) * 2048 + qh * 64;
#pragma unroll
        for (int r = 0; r < 16; ++r) {
            const int orow = crow(r, hz);
            const float rl = li_l[orow];
            const unsigned obase = (unsigned)(orow * 2048 + rz);
#pragma unroll
            for (int d0 = 0; d0 < 2; ++d0) {
                const float v = o[d0][r] * rl;
                const float vn = __shfl_xor(v, 1);
                if ((rz & 1) == 0) *(unsigned*)(Ow + obase + d0 * 32) = cvtpk(v, vn);
            }
        }
        asm volatile("s_waitcnt lgkmcnt(0)" ::: "memory");
    }
    __syncthreads();
}

struct Args { const float* in[19]; float* out; unsigned char* ws; int ph_lo, ph_hi; };
enum { I_X = 0, I_WR, I_RB, I_EWIN, I_EQN, I_EWQ, I_EKVN, I_EWKV, I_EFB, I_EWOUT, I_OWIN, I_OSINK, I_OWOUT, I_LMG, I_LMB, I_LFG, I_LFB, I_WGU, I_WDN };
enum { PH_CVT = 0, PH_L0_IN, PH_L0_PREP, PH_L0_UP, PH_L0_ATT, PH_L0_OUT, PH_L0_LN1, PH_L0_MOE1, PH_L0_MOE2, PH_L0_LN2,
       PH_L1_IN, PH_L1_KM, PH_L1_ATT, PH_L1_OUT, PH_L1_LN1, PH_L1_MOE1, PH_L1_MOE2, PH_L1_LN2, NPH };

DEVI void ln_row(const float* hrow, float a, const float* y0, const float* y1, const float* g, const float* bta, int lane, f32x4 (&v)[8]) {
    float s = 0.f;
#pragma unroll
    for (int j = 0; j < 8; ++j) {
        f32x4 x = *(const f32x4*)(hrow + 4 * lane + 256 * j) * a;
        if (y0) x += *(const f32x4*)(y0 + 4 * lane + 256 * j);
        if (y1) x += *(const f32x4*)(y1 + 4 * lane + 256 * j);
        v[j] = x; s += (x[0] + x[1]) + (x[2] + x[3]);
    }
    const float mean = wave_sum(s) * (1.f / DM);
    float s2 = 0.f;
#pragma unroll
    for (int j = 0; j < 8; ++j) { v[j] = v[j] - mean; s2 += (v[j][0] * v[j][0] + v[j][1] * v[j][1]) + (v[j][2] * v[j][2] + v[j][3] * v[j][3]); }
    const float rstd = 1.f / sqrtf(wave_sum(s2) * (1.f / DM) + LN_EPS);
#pragma unroll
    for (int j = 0; j < 8; ++j) v[j] = v[j] * rstd * *(const f32x4*)(g + 4 * lane + 256 * j) + *(const f32x4*)(bta + 4 * lane + 256 * j);
}

DEVI void phase_ln1_route(const Args& a, float* xrow, int layer, const float* pre, float* hf, bf16* hb, int gw, int ngw, int lane) {
    unsigned* ctl = (unsigned*)(a.ws + WS_CTL);
    int* list = (int*)(a.ws + WS_LIST) + layer * NEXP * T;
    float* ew = (float*)(a.ws + WS_EW);
    const float* g = a.in[I_LMG] + layer * DM; const float* bta = a.in[I_LMB] + layer * DM;
    const float* wr = a.in[I_WR]; const float* rb = a.in[I_RB];
    for (int t = gw; t < T; t += ngw) {
        f32x4 v[8];
        ln_row(pre + (size_t)t * DM, 1.f, nullptr, nullptr, g, bta, lane, v);
#pragma unroll
        for (int j = 0; j < 8; ++j) {
            *(f32x4*)(hf + (size_t)t * DM + 4 * lane + 256 * j) = v[j];
            uint2 w; w.x = pk2(v[j][0], v[j][1]); w.y = pk2(v[j][2], v[j][3]);
            *(uint2*)(hb + (size_t)t * DM + 4 * lane + 256 * j) = w;
        }
#pragma unroll
        for (int j = 0; j < 8; ++j) *(f32x4*)(xrow + 4 * lane + 256 * j) = v[j];
        __builtin_amdgcn_s_waitcnt(0); __builtin_amdgcn_wave_barrier();
        float acc = 0.f;
        {
            const int e = lane & 31, i0 = (lane >> 5) * 1024;
            const float* wp = wr + (size_t)i0 * NEXP + e;
#pragma unroll 8
            for (int i = 0; i < 1024; ++i) acc += xrow[i0 + i] * wp[(size_t)i * NEXP];
        }
        acc += __shfl_xor(acc, 32);
        const float affl = 1.f / (1.f + __expf(-acc));
        const float sell = affl + rb[lane & 31];
        __builtin_amdgcn_wave_barrier();
        int best = 0; float bests = -__builtin_inff();
#pragma unroll
        for (int gI = 0; gI < 8; ++gI) {
            float m1 = -__builtin_inff(), m2 = -__builtin_inff();
#pragma unroll
            for (int q = 0; q < 4; ++q) { const float x = __shfl(sell, gI * 4 + q); if (x > m1) { m2 = m1; m1 = x; } else if (x > m2) m2 = x; }
            const float sc = m1 + m2;
            if (sc > bests) { bests = sc; best = gI; }
        }
        int e1 = 0, e2 = 0; float s1 = -__builtin_inff(), s2 = -__builtin_inff(), a1 = 0.f, a2 = 0.f;
#pragma unroll
        for (int q = 0; q < 4; ++q) {
            const float af = __shfl(affl, best * 4 + q), x = __shfl(sell, best * 4 + q);
            if (x > s1) { s2 = s1; e2 = e1; a2 = a1; s1 = x; e1 = best * 4 + q; a1 = af; } else if (x > s2) { s2 = x; e2 = best * 4 + q; a2 = af; }
        }
        if (lane == 0) {
            const float inv = 1.f / (a1 + a2);
            ew[t * 2 + 0] = a1 * inv; ew[t * 2 + 1] = a2 * inv;
            const unsigned p1 = atomicAdd(&ctl[CW_CNT + layer * NEXP + e1], 1u); list[e1 * T + p1] = t * 2 + 0;
            const unsigned p2 = atomicAdd(&ctl[CW_CNT + layer * NEXP + e2], 1u); list[e2 * T + p2] = t * 2 + 1;
        }
    }
}

DEVI void phase_moe(const Args& a, char* lds, int layer, int stage, const bf16* hb, int bid, int nb) {
    unsigned* ctl = (unsigned*)(a.ws + WS_CTL);
    const int* list = (const int*)(a.ws + WS_LIST) + layer * NEXP * T;
    const float* ew = (const float*)(a.ws + WS_EW);
    bf16* hdn = (bf16*)(a.ws + WS_HDN);
    float* Y = (float*)(a.ws + WS_Y);
    int* sh = (int*)(lds + 131072 + 1024);
    const int ntn = stage == 1 ? 4 : 8;
    if (threadIdx.x == 0) {
        int so = 0, to = 0;
        for (int e = 0; e < NEXP; ++e) { const int c = (int)ctl[CW_CNT + layer * NEXP + e]; sh[e] = so; sh[33 + e] = to; so += c; to += ((c + 255) / 256) * ntn; }
        sh[32] = so; sh[33 + 32] = to;
    }
    __syncthreads();
    g8::MoeOrder S_;
    S_.sh = (const LAS int*)sh; S_.list = list; S_.G = nb; S_.c = bid; S_.stage = stage; S_.ntn = ntn;
    if (stage == 1) {
        S_.A = (const char*)hb; S_.lda = DM; S_.K = DM; S_.W = (const char*)(a.ws + WS_WGU) + (size_t)layer * NEXP * 1024 * DM * 2; S_.wstride = (size_t)1024 * DM * 2;
        g8::EpiMoe1 E_{hdn};
        g8::gemm8((LAS unsigned char*)lds, DM, S_, E_);
    } else {
        S_.A = (const char*)hdn; S_.lda = FF; S_.K = FF; S_.W = (const char*)(a.ws + WS_WDN) + (size_t)layer * NEXP * DM * FF * 2; S_.wstride = (size_t)DM * FF * 2;
        g8::EpiMoe2 E_{Y, list, ew};
        g8::gemm8((LAS unsigned char*)lds, FF, S_, E_);
    }
    __syncthreads();
}

DEVI void phase_ln2(const Args& a, int layer, const float* hf, float* of, bf16* ob, int gw, int ngw, int lane) {
    const float* Y = (const float*)(a.ws + WS_Y);
    const float* g = a.in[I_LFG] + layer * DM; const float* bta = a.in[I_LFB] + layer * DM;
    for (int t = gw; t < T; t += ngw) {
        f32x4 v[8];
        ln_row(hf + (size_t)t * DM, ALPHA, Y + (size_t)(2 * t) * DM, Y + (size_t)(2 * t + 1) * DM, g, bta, lane, v);
#pragma unroll
        for (int j = 0; j < 8; ++j) {
            *(f32x4*)(of + (size_t)t * DM + 4 * lane + 256 * j) = v[j];
            if (ob) { uint2 w; w.x = pk2(v[j][0], v[j][1]); w.y = pk2(v[j][2], v[j][3]); *(uint2*)(ob + (size_t)t * DM + 4 * lane + 256 * j) = w; }
        }
    }
}

__global__ void __launch_bounds__(NTHREADS, 2) fwd(Args a) {
    extern __shared__ __attribute__((aligned(16))) char lds[];
    const int tid = threadIdx.x, lane = tid & 63, wid = tid >> 6;
    const int bid = blockIdx.x, nb = gridDim.x;
    const int gw = bid * NWAVES + wid, ngw = nb * NWAVES;
    unsigned char* ws = a.ws;
    unsigned* ctl = (unsigned*)(ws + WS_CTL);
    float* FL = (float*)(ws + WS_FL); float* LF = (float*)(ws + WS_LF); float* CUM = (float*)(ws + WS_CUM); float* KM = (float*)(ws + WS_KM);
    bf16* KPE = (bf16*)(ws + WS_KPE); bf16* XB = (bf16*)(ws + WS_XB); bf16* HB = (bf16*)(ws + WS_HB);
    float* HFA = (float*)(ws + WS_HFA); float* HFB = (float*)(ws + WS_HFB); float* PRE = (float*)(ws + WS_PRE);
    bf16* P = (bf16*)(ws + WS_P); bf16* CQN = (bf16*)(ws + WS_CQN); bf16* CKVN = (bf16*)(ws + WS_CKVN);
    bf16* QM = (bf16*)(ws + WS_QM); bf16* KVM = (bf16*)(ws + WS_KVM); bf16* AO = (bf16*)(ws + WS_AO);

    volatile LAS unsigned* xbw = (volatile LAS unsigned*)((LAS char*)lds + LDS_BYTES - 16);
    if (tid < 4) xbw[tid] = 0u;
    __syncthreads();
    XcdBarrier bar; bar.bar = ctl + CW_BAR; bar.x = 0; bar.st = xbw;
#if ONE_LAUNCH
    bar = xcd_barrier_post(ctl + CW_BAR, xbw);
#define SEAM(k) do { if ((k) + 1 < a.ph_hi) xcd_barrier(bar); } while (0)
#else
#define SEAM(k) do { } while (0)
#endif
#define IN(k) (a.ph_lo <= (k) && (k) < a.ph_hi)

    if (IN(PH_CVT)) { for (int rep_ = 0; rep_ < REPS(PH_CVT); ++rep_) {
        const float* x = a.in[I_X];
        for (size_t i = (size_t)bid * NTHREADS + tid; i < (size_t)T * DM / 8; i += (size_t)nb * NTHREADS) {
            const f32x4 v0 = *(const f32x4*)(x + i * 8), v1 = *(const f32x4*)(x + i * 8 + 4);
            u32x4 w; w[0] = pk2(v0[0], v0[1]); w[1] = pk2(v0[2], v0[3]); w[2] = pk2(v1[0], v1[1]); w[3] = pk2(v1[2], v1[3]);
            *(u32x4*)(XB + i * 8) = w;
        }
        {
            LAS float* scr = (LAS float*)((LAS char*)lds + wid * 8448);
            int base = 0;
            auto ident = [](int n0) { return n0; };
            cvt_matrix(a.in[I_EWIN], DM, EVEN_IN, 4096, (bf16*)(ws + WS_WIN0), [](int n0) { return n0 < EVEN_IN ? n0 : -1; }, scr, gw, ngw, lane, base);
            cvt_matrix(a.in[I_EWQ], 512, 1536, 1536, (bf16*)(ws + WS_WQU), ident, scr, gw, ngw, lane, base);
            cvt_matrix(a.in[I_EWKV], 256, 2048, 2048, (bf16*)(ws + WS_WKVU), ident, scr, gw, ngw, lane, base);
            cvt_matrix(a.in[I_EWOUT], DM, DM, DM, (bf16*)(ws + WS_WOUT0), ident, scr, gw, ngw, lane, base);
            cvt_matrix(a.in[I_OWIN], DM, ODD_IN, ODD_IN, (bf16*)(ws + WS_WIN1), ident, scr, gw, ngw, lane, base);
            cvt_matrix(a.in[I_OWOUT], DM, DM, DM, (bf16*)(ws + WS_WOUT1), ident, scr, gw, ngw, lane, base);
            for (int le = 0; le < 2 * NEXP; ++le)
                cvt_matrix(a.in[I_WGU] + (size_t)le * DM * 1024, DM, 1024, 1024, (bf16*)(ws + WS_WGU) + (size_t)le * 1024 * DM,
                           [](int n0) { return ((n0 >> 7) & 1) * 512 + (n0 >> 8) * 128 + (n0 & 127); }, scr, gw, ngw, lane, base);
            for (int le = 0; le < 2 * NEXP; ++le)
                cvt_matrix(a.in[I_WDN] + (size_t)le * FF * DM, FF, DM, DM, (bf16*)(ws + WS_WDN) + (size_t)le * DM * FF, ident, scr, gw, ngw, lane, base);
        }
        }
        SEAM(PH_CVT);
    }
    if (IN(PH_L0_IN)) { for (int rep_ = 0; rep_ < REPS(PH_L0_IN); ++rep_) {
        { g8::DenseOrder S_; S_.init(XB, DM, (const bf16*)(ws + WS_WIN0), T, 4096, DM, nb, bid); g8::EpiBf16 E_{P, LDP, EVEN_IN, FL, E_FL}; g8::gemm8((LAS unsigned char*)lds, DM, S_, E_); }
        }
        SEAM(PH_L0_IN);
    }
    if (IN(PH_L0_PREP)) { for (int rep_ = 0; rep_ < REPS(PH_L0_PREP); ++rep_) {
        const float* qn = a.in[I_EQN]; const float* kvn = a.in[I_EKVN]; const float* fb = a.in[I_EFB];
        for (int t = gw; t < T; t += ngw) {
            const bf16* pr = P + (size_t)t * LDP;
            {
                const u32x4 w = *(const u32x4*)(pr + E_CQ + lane * 8);
                float x[8] = {bflo(w[0]), bfhi(w[0]), bflo(w[1]), bfhi(w[1]), bflo(w[2]), bfhi(w[2]), bflo(w[3]), bfhi(w[3])};
                float ss = 0.f;
#pragma unroll
                for (int i = 0; i < 8; ++i) ss += x[i] * x[i];
                const float r = 1.f / sqrtf(wave_sum(ss) * (1.f / 512.f) + RMS_EPS);
                u32x4 o;
#pragma unroll
                for (int i = 0; i < 4; ++i) o[i] = pk2(x[2 * i] * r * qn[lane * 8 + 2 * i], x[2 * i + 1] * r * qn[lane * 8 + 2 * i + 1]);
                *(u32x4*)(CQN + (size_t)t * 512 + lane * 8) = o;
            }
            {
                const uint2 w = *(const uint2*)(pr + E_CKV + lane * 4);
                float x[4] = {bflo(w.x), bfhi(w.x), bflo(w.y), bfhi(w.y)};
                float ss = x[0] * x[0] + x[1] * x[1] + x[2] * x[2] + x[3] * x[3];
                const float r = 1.f / sqrtf(wave_sum(ss) * (1.f / 256.f) + RMS_EPS);
                uint2 o; o.x = pk2(x[0] * r * kvn[lane * 4], x[1] * r * kvn[lane * 4 + 1]); o.y = pk2(x[2] * r * kvn[lane * 4 + 2], x[3] * r * kvn[lane * 4 + 3]);
                *(uint2*)(CKVN + (size_t)t * 256 + lane * 4) = o;
            }
            if (lane < 32) {
                const float t1 = bf2f(pr[E_KR + lane]), t2 = bf2f(pr[E_KR + 32 + lane]);
                float c, s; rope_cs(t % S, lane, c, s);
                KPE[(size_t)t * 64 + lane] = (bf16)f2bf(t1 * c - t2 * s);
                KPE[(size_t)t * 64 + 32 + lane] = (bf16)f2bf(t1 * s + t2 * c);
            }
            if (lane < 8) {
                const float x = FL[t * 8 + lane] + fb[lane];
                LF[t * 8 + lane] = fminf(x, 0.f) - log1pf(__expf(-fabsf(x)));
            }
        }
        }
        SEAM(PH_L0_PREP);
    }
    if (IN(PH_L0_UP)) { for (int rep_ = 0; rep_ < REPS(PH_L0_UP); ++rep_) {
        if (gw < 16) {
            const int b = gw >> 3, h = gw & 7;
            double loc = 0.0;
            for (int i = 0; i < 64; ++i) loc += (double)LF[(size_t)(b * S + lane * 64 + i) * 8 + h];
            double inc = loc;
#pragma unroll
            for (int o = 1; o < 64; o <<= 1) { const double nbv = __shfl_up(inc, o); if (lane >= o) inc += nbv; }
            double run = inc - loc;
            for (int i = 0; i < 64; ++i) { run += (double)LF[(size_t)(b * S + lane * 64 + i) * 8 + h]; CUM[(size_t)gw * S + lane * 64 + i] = (float)run; }
        }
        const int n1 = (T / 128) * (1536 / 128);
        { g8::DenseOrder S_; S_.init(CQN, 512, (const bf16*)(ws + WS_WQU), T, 1536, 512, nb, bid); g8::EpiBf16 E_{QM, 1536, 1536, nullptr, 0}; g8::gemm8((LAS unsigned char*)lds, 512, S_, E_); }
        { g8::DenseOrder S_; S_.init(CKVN, 256, (const bf16*)(ws + WS_WKVU), T, 2048, 256, nb, bid); g8::EpiBf16 E_{KVM, 2048, 2048, nullptr, 0}; g8::gemm8((LAS unsigned char*)lds, 256, S_, E_); }
        }
        SEAM(PH_L0_UP);
    }
    if (IN(PH_L0_ATT)) { for (int rep_ = 0; rep_ < REPS(PH_L0_ATT); ++rep_) {
        volatile unsigned* qslot = (volatile unsigned*)(lds + FA_Q);
        for (;;) {
            if (tid == 0) *qslot = atomicAdd(&ctl[CW_Q + 0 + 8 * rep_], 1u);
            __syncthreads();
            const int item = __builtin_amdgcn_readfirstlane((int)*qslot);
            __syncthreads();
            if (item >= 256) break;
            const int qb = 15 - (item >> 4), bh = item & 15, b = bh >> 3, h = bh & 7;
            flash_unit<FM_MLA>(lds, QM + (size_t)b * S * 1536 + h * 192, 1536, KVM + (size_t)b * S * 2048 + h * 256, 2048, KVM + (size_t)b * S * 2048 + h * 256 + 128, 2048,
                               KPE + (size_t)b * S * 64, nullptr, nullptr, 0.f, qb * 256, AO + (size_t)b * S * 2048 + h * 128, 2048);
        }
        for (;;) {
            if (tid == 0) *qslot = atomicAdd(&ctl[CW_Q + 1 + 8 * rep_], 1u);
            __syncthreads();
            const int item = __builtin_amdgcn_readfirstlane((int)*qslot);
            __syncthreads();
            if (item >= 256) break;
            const int qb = 15 - (item >> 4), bh = item & 15, b = bh >> 3, h = bh & 7;
            flash_unit<FM_FOX>(lds, P + (size_t)b * S * LDP + E_FQ + h * 128, LDP, P + (size_t)b * S * LDP + E_FK + h * 128, LDP, P + (size_t)b * S * LDP + E_FV + h * 128, LDP,
                               nullptr, CUM + (size_t)bh * S, nullptr, 0.f, qb * 256, AO + (size_t)b * S * 2048 + 1024 + h * 128, 2048);
        }
        }
        SEAM(PH_L0_ATT);
    }
    if (IN(PH_L0_OUT)) { for (int rep_ = 0; rep_ < REPS(PH_L0_OUT); ++rep_) {
        const float* x = a.in[I_X];
        { g8::DenseOrder S_; S_.init(AO, DM, (const bf16*)(ws + WS_WOUT0), T, DM, DM, nb, bid); g8::EpiRes E_{PRE, x, DM, ALPHA}; g8::gemm8((LAS unsigned char*)lds, DM, S_, E_); }
        }
        SEAM(PH_L0_OUT);
    }
    if (IN(PH_L0_LN1)) { phase_ln1_route(a, (float*)lds + wid * 2048, 0, PRE, HFA, HB, gw, ngw, lane); SEAM(PH_L0_LN1); }
    if (IN(PH_L0_MOE1)) { for (int rep_ = 0; rep_ < REPS(PH_L0_MOE1); ++rep_) phase_moe(a, lds, 0, 1, HB, bid, nb); SEAM(PH_L0_MOE1); }
    if (IN(PH_L0_MOE2)) { for (int rep_ = 0; rep_ < REPS(PH_L0_MOE2); ++rep_) phase_moe(a, lds, 0, 2, HB, bid, nb); SEAM(PH_L0_MOE2); }
    if (IN(PH_L0_LN2)) { for (int rep_ = 0; rep_ < REPS(PH_L0_LN2); ++rep_) phase_ln2(a, 0, HFA, HFB, XB, gw, ngw, lane); SEAM(PH_L0_LN2); }

    if (IN(PH_L1_IN)) {
        { g8::DenseOrder S_; S_.init(XB, DM, (const bf16*)(ws + WS_WIN1), T, ODD_IN, DM, nb, bid); g8::EpiBf16 E_{P, LDP, ODD_IN, nullptr, 0}; g8::gemm8((LAS unsigned char*)lds, DM, S_, E_); }
        SEAM(PH_L1_IN);
    }
    if (IN(PH_L1_KM)) { for (int rep_ = 0; rep_ < REPS(PH_L1_KM); ++rep_) {
        for (int it = gw; it < 2 * 8 * 16; it += ngw) {
            const int b = it >> 7, h = (it >> 4) & 7, n = it & 15;
            float s0 = 0.f, s1 = 0.f;
            for (int j = 0; j < 256; ++j) { const unsigned w = *(const unsigned*)(P + ((size_t)b * S + n * 256 + j) * LDP + O_MK + h * 128 + lane * 2); s0 += bflo(w); s1 += bfhi(w); }
            KM[(size_t)it * 128 + lane * 2] = s0 * (1.f / 256.f); KM[(size_t)it * 128 + lane * 2 + 1] = s1 * (1.f / 256.f);
        }
        }
        SEAM(PH_L1_KM);
    }
    if (IN(PH_L1_ATT)) { for (int rep_ = 0; rep_ < REPS(PH_L1_ATT); ++rep_) {
        volatile unsigned* qslot = (volatile unsigned*)(lds + FA_Q);
        const float* sinks = a.in[I_OSINK];
        for (;;) {
            if (tid == 0) *qslot = atomicAdd(&ctl[CW_Q + 2 + 8 * rep_], 1u);
            __syncthreads();
            const int item = __builtin_amdgcn_readfirstlane((int)*qslot);
            __syncthreads();
            if (item >= 256) break;
            const int qb = 15 - (item >> 4), bh = item & 15, b = bh >> 3, h = bh & 7;
            flash_unit<FM_MOBA>(lds, P + (size_t)b * S * LDP + O_MQ + h * 128, LDP, P + (size_t)b * S * LDP + O_MK + h * 128, LDP, P + (size_t)b * S * LDP + O_MV + h * 128, LDP,
                                nullptr, nullptr, KM + (size_t)bh * 16 * 128, exp2f(-(float)(h + 1)), qb * 256, AO + (size_t)b * S * 2048 + 1024 + h * 128, 2048);
        }
        for (;;) {
            if (tid == 0) *qslot = atomicAdd(&ctl[CW_Q + 3 + 8 * rep_], 1u);
            __syncthreads();
            const int item = __builtin_amdgcn_readfirstlane((int)*qslot);
            __syncthreads();
            if (item >= 256) break;
            const int qb = item & 63, bk = item >> 6, b = bk >> 1, kvh = bk & 1;
            swa_unit(lds, P + (size_t)b * S * LDP, kvh, qb * 64, sinks, AO + (size_t)b * S * 2048);
        }
        }
        SEAM(PH_L1_ATT);
    }
    if (IN(PH_L1_OUT)) {
        { g8::DenseOrder S_; S_.init(AO, DM, (const bf16*)(ws + WS_WOUT1), T, DM, DM, nb, bid); g8::EpiRes E_{PRE, HFB, DM, ALPHA}; g8::gemm8((LAS unsigned char*)lds, DM, S_, E_); }
        SEAM(PH_L1_OUT);
    }
    if (IN(PH_L1_LN1)) { phase_ln1_route(a, (float*)lds + wid * 2048, 1, PRE, HFA, HB, gw, ngw, lane); SEAM(PH_L1_LN1); }
    if (IN(PH_L1_MOE1)) { phase_moe(a, lds, 1, 1, HB, bid, nb); SEAM(PH_L1_MOE1); }
    if (IN(PH_L1_MOE2)) { phase_moe(a, lds, 1, 2, HB, bid, nb); SEAM(PH_L1_MOE2); }
    if (IN(PH_L1_LN2)) { phase_ln2(a, 1, HFA, a.out, nullptr, gw, ngw, lane); }
#undef IN
#undef SEAM
}

extern "C" void kernel_launch(void* const* d_in, const int* in_sizes, int n_in, void* d_out, int out_size, void* d_ws, size_t ws_size, hipStream_t stream) {
    static int grid = 0;
    if (grid == 0) {
        if (n_in != 19 || out_size != T * DM || ws_size < WS_END) { fprintf(stderr, "kernel_launch: unexpected shapes (n_in %d out %d ws %zu)\n", n_in, out_size, ws_size); grid = -1; return; }
        int dev = 0, cus = 0;
        if (hipGetDevice(&dev) != hipSuccess || hipDeviceGetAttribute(&cus, hipDeviceAttributeMultiprocessorCount, dev) != hipSuccess || cus <= 0) cus = 256;
        (void)hipFuncSetAttribute((const void*)fwd, hipFuncAttributeMaxDynamicSharedMemorySize, LDS_BYTES);
        int per_cu = 0;
        if (hipOccupancyMaxActiveBlocksPerMultiprocessor(&per_cu, (const void*)fwd, NTHREADS, LDS_BYTES) != hipSuccess || per_cu < 1) fprintf(stderr, "kernel_launch: occupancy query says %d\n", per_cu);
        (void)hipGetLastError();
        grid = cus;
    }
    if (grid < 0) return;
    (void)in_sizes;
    (void)hipMemsetAsync((char*)d_ws + WS_CTL, 0, CTL_BYTES, stream);
    Args a{};
    for (int i = 0; i < 19; ++i) a.in[i] = (const float*)d_in[i];
    a.out = (float*)d_out; a.ws = (unsigned char*)d_ws;
#if ONE_LAUNCH
    a.ph_lo = 0; a.ph_hi = NPH;
    hipLaunchKernelGGL(fwd, dim3(grid), dim3(NTHREADS), LDS_BYTES, stream, a);
#else
    for (int p = 0; p < NPH; ++p) { a.ph_lo = p; a.ph_hi = p + 1; hipLaunchKernelGGL(fwd, dim3(grid), dim3(NTHREADS), LDS_BYTES, stream, a); }
#endif
}
```

```cpp
#include <hip/hip_runtime.h>
#include <stdint.h>
#include <stdio.h>

#ifndef PROBE_REP
#define PROBE_REP -1
#endif
#define REPS(k) ((PROBE_REP) == (k) ? 2 : 1)
#ifndef PROBE_PH
#define PROBE_PH -1
#endif
#ifndef ONE_LAUNCH
#define ONE_LAUNCH 1
#endif

#define DEVI __device__ __forceinline__
#define LAS __attribute__((address_space(3)))
typedef unsigned short bf16;
typedef short bf16x8 __attribute__((ext_vector_type(8)));
typedef float f32x4 __attribute__((ext_vector_type(4)));
typedef unsigned u32x4 __attribute__((ext_vector_type(4)));

constexpr int S = 4096, NBATCH = 2, T = NBATCH * S, DM = 2048;
constexpr int LDP = 4352;
constexpr int EVEN_IN = 3912, ODD_IN = 4352;
constexpr float LN_EPS = 1e-5f, RMS_EPS = 1e-6f;
constexpr float ALPHA = 1.4142135623730951f;
constexpr int NEXP = 32, FF = 512;
constexpr int E_CQ = 0, E_CKV = 512, E_KR = 768, E_FQ = 832, E_FK = 1856, E_FV = 2880, E_FL = 3904;
constexpr int O_SQ = 0, O_SK = 1024, O_SV = 1152, O_MQ = 1280, O_MK = 2304, O_MV = 3328;

constexpr size_t MiB = 1u << 20;
constexpr size_t WS_CTL = 0, CTL_BYTES = 1 * MiB;
constexpr int CW_CNT = 1024;
constexpr int CW_BAR = 4096;
constexpr int CW_Q = 1100;
constexpr size_t WS_LIST = 2 * MiB;
constexpr size_t WS_EW = 4 * MiB;
constexpr size_t WS_FL = 5 * MiB;
constexpr size_t WS_LF = 5 * MiB + 512 * 1024;
constexpr size_t WS_CUM = 6 * MiB;
constexpr size_t WS_KM = 6 * MiB + 512 * 1024;
constexpr size_t WS_KPE = 7 * MiB;
constexpr size_t WS_XB = 16 * MiB;
constexpr size_t WS_HB = 48 * MiB;
constexpr size_t WS_HFA = 80 * MiB;
constexpr size_t WS_HFB = 144 * MiB;
constexpr size_t WS_PRE = 208 * MiB;
constexpr size_t WS_P = 272 * MiB;
constexpr size_t WS_CQN = 340 * MiB;
constexpr size_t WS_CKVN = 348 * MiB;
constexpr size_t WS_QM = 352 * MiB;
constexpr size_t WS_KVM = 376 * MiB;
constexpr size_t WS_AO = 408 * MiB;
constexpr size_t WS_HDN = 440 * MiB;
constexpr size_t WS_Y = 464 * MiB;
constexpr size_t WS_WIN0 = 600 * MiB;
constexpr size_t WS_WQU = 616 * MiB;
constexpr size_t WS_WKVU = 618 * MiB;
constexpr size_t WS_WOUT0 = 620 * MiB;
constexpr size_t WS_WIN1 = 628 * MiB;
constexpr size_t WS_WOUT1 = 646 * MiB;
constexpr size_t WS_WGU = 656 * MiB;
constexpr size_t WS_WDN = 912 * MiB;
constexpr size_t WS_END = 1040 * MiB;

constexpr int LDS_BYTES = 147456;
constexpr int NTHREADS = 512, NWAVES = 8;

DEVI unsigned f2bf(float f) { unsigned u = __float_as_uint(f); return (u + 0x7fffu + ((u >> 16) & 1u)) >> 16; }
DEVI float bf2f(unsigned b) { return __uint_as_float(b << 16); }
DEVI float bflo(unsigned w) { return __uint_as_float(w << 16); }
DEVI float bfhi(unsigned w) { return __uint_as_float(w & 0xffff0000u); }
DEVI unsigned pk2(float lo, float hi) { return f2bf(lo) | (f2bf(hi) << 16); }
DEVI float wave_sum(float v) {
#pragma unroll
    for (int o = 1; o < 64; o <<= 1) v += __shfl_xor(v, o);
    return v;
}
DEVI float wave_max(float v) {
#pragma unroll
    for (int o = 1; o < 64; o <<= 1) v = fmaxf(v, __shfl_xor(v, o));
    return v;
}
DEVI void rope_cs(int t, int i, float& c, float& s) {
    const float inv_freq = exp2f(-(float)i * (13.287712379549449f / 32.0f));
    double rev = (double)t * (double)inv_freq * 0.15915494309189535;
    rev -= floor(rev);
    const float a = (float)(rev * 6.283185307179586);
    c = __cosf(a); s = __sinf(a);
}

#define XB_TMO      128
#define XB_XCNT(j)  (256  + 64 * (j))
#define XB_XSUB(j)  (1280 + 64 * (j))
#define XB_XGEN(j)  (2304 + 64 * (j))
#define XB_TOP      3328
#define XB_TOPGEN   3392
#define XCD_BAR_WORDS 3456
#define XB_SPIN_CAP (1u << 18)
DEVI unsigned xb_ld(unsigned* p)              { return __hip_atomic_load(p, __ATOMIC_RELAXED, __HIP_MEMORY_SCOPE_AGENT); }
DEVI unsigned xb_add(unsigned* p, unsigned v) { return __hip_atomic_fetch_add(p, v, __ATOMIC_RELAXED, __HIP_MEMORY_SCOPE_AGENT); }
DEVI unsigned xb_xcc_id() { return (unsigned)__builtin_amdgcn_s_getreg((3 << 11) | 20) & 0xFu; }
#define XB_SPIN(cond, bar) do { unsigned _sp = 0; while (cond) { __builtin_amdgcn_s_sleep(1); \
    if ((++_sp & 255u) == 0u) { if (xb_ld(&(bar)[XB_TMO])) break; if (_sp > XB_SPIN_CAP) { atomicAdd(&(bar)[XB_TMO], 1u); break; } } } } while (0)
struct XcdBarrier { unsigned* bar; unsigned x; volatile LAS unsigned* st; };
DEVI XcdBarrier xcd_barrier_post(unsigned* bar, volatile LAS unsigned* st) {
    XcdBarrier b; b.bar = bar; b.x = xb_xcc_id(); b.st = st;
    if (threadIdx.x == 0) (void)xb_add(&bar[XB_XCNT(b.x)], 1u);
    return b;
}
DEVI void xcd_barrier_complete(unsigned* bar, unsigned x, unsigned& nloc, unsigned& nx) {
    const unsigned G = gridDim.x * gridDim.y * gridDim.z;
    unsigned sum, cnt, mine, sp = 0u;
    for (;;) {
        sum = 0u; cnt = 0u; mine = 0u;
#pragma unroll
        for (unsigned j = 0; j < 16; ++j) { const unsigned c = xb_ld(&bar[XB_XCNT(j)]); sum += c; cnt += (c > 0u) ? 1u : 0u; mine = (j == x) ? c : mine; }
        if (sum == G) break;
        __builtin_amdgcn_s_sleep(1);
        if ((++sp & 255u) == 0u) { if (xb_ld(&bar[XB_TMO])) break; if (sp > XB_SPIN_CAP) { atomicAdd(&bar[XB_TMO], 1u); break; } }
    }
    nloc = mine > 0u ? mine : 1u; nx = cnt > 0u ? cnt : 1u;
}
DEVI void xcd_barrier(const XcdBarrier& b) {
    asm volatile("s_waitcnt vmcnt(0)" ::: "memory");
    __syncthreads();
    if (threadIdx.x == 0) {
        unsigned* bar = b.bar;
        __builtin_amdgcn_s_waitcnt(0);
        unsigned nloc = b.st[0], nx = b.st[1];
        if (nloc == 0u) { xcd_barrier_complete(bar, b.x, nloc, nx); b.st[0] = nloc; b.st[1] = nx; }
        const unsigned old = xb_add(&bar[XB_XSUB(b.x)], 1u);
        const unsigned gen = old / nloc;
        if (old + 1u == (gen + 1u) * nloc) {
            __builtin_amdgcn_fence(__ATOMIC_RELEASE, "agent");
            asm volatile("s_waitcnt vmcnt(0)" ::: "memory");
            const unsigned og = xb_add(&bar[XB_TOP], 1u);
            const unsigned tg = og / nx;
            if (og + 1u == (tg + 1u) * nx) xb_add(&bar[XB_TOPGEN], 1u);
            else XB_SPIN(xb_ld(&bar[XB_TOPGEN]) == tg, bar);
            __builtin_amdgcn_fence(__ATOMIC_ACQUIRE, "agent");
            xb_add(&bar[XB_XGEN(b.x)], 1u);
            asm volatile("s_waitcnt vmcnt(0)" ::: "memory");
        } else {
            XB_SPIN(xb_ld(&bar[XB_XGEN(b.x)]) == gen, bar);
            __builtin_amdgcn_fence(__ATOMIC_ACQUIRE, "agent");
            asm volatile("s_waitcnt vmcnt(0)" ::: "memory");
        }
    }
    __syncthreads();
}

template <class RowMap, class ColMap, class Epi>
DEVI void gemm_tile(char* lds, int K, const bf16* __restrict__ A, int lda, const float* __restrict__ W, int ldw,
                    RowMap rowmap, ColMap colmap, Epi epi) {
    bf16* sA = (bf16*)lds;
    bf16* sB = sA + 128 * 40;
    const int tid = threadIdx.x, lane = tid & 63, wid = tid >> 6, wm = wid >> 1, wn = wid & 1;
    const int ar = tid >> 2, ac = (tid & 3) * 8;
    const int src_row = rowmap(ar);
    const bf16* aptr = A + (size_t)(src_row < 0 ? 0 : src_row) * lda + ac;
    const int bk = tid >> 4, bn = (tid & 15) * 8;
    const int pcol = colmap(bn);
    const float* wptr = W + (size_t)bk * ldw + (pcol < 0 ? 0 : pcol);
    f32x4 acc[2][4];
#pragma unroll
    for (int a = 0; a < 2; ++a)
#pragma unroll
        for (int b = 0; b < 4; ++b) acc[a][b] = (f32x4){0.f, 0.f, 0.f, 0.f};
    u32x4 ra; f32x4 rb0, rb1;
    ra = (u32x4){0u, 0u, 0u, 0u}; rb0 = (f32x4){0.f, 0.f, 0.f, 0.f}; rb1 = rb0;
    if (src_row >= 0) ra = *(const u32x4*)(aptr);
    if (pcol >= 0) { rb0 = *(const f32x4*)(wptr); rb1 = *(const f32x4*)(wptr + 4); }
    for (int k0 = 0; k0 < K; k0 += 32) {
        *(u32x4*)(sA + ar * 40 + ac) = ra;
#pragma unroll
        for (int j = 0; j < 4; ++j) { sB[(bn + j) * 40 + bk] = (bf16)f2bf(rb0[j]); sB[(bn + 4 + j) * 40 + bk] = (bf16)f2bf(rb1[j]); }
        __syncthreads();
        if (k0 + 32 < K) {
            if (src_row >= 0) ra = *(const u32x4*)(aptr + k0 + 32);
            if (pcol >= 0) { rb0 = *(const f32x4*)(wptr + (size_t)(k0 + 32) * ldw); rb1 = *(const f32x4*)(wptr + (size_t)(k0 + 32) * ldw + 4); }
        }
        bf16x8 af[2], bfr[4];
#pragma unroll
        for (int mf = 0; mf < 2; ++mf) af[mf] = *(const bf16x8*)(sA + (wm * 32 + mf * 16 + (lane & 15)) * 40 + (lane >> 4) * 8);
#pragma unroll
        for (int nf = 0; nf < 4; ++nf) bfr[nf] = *(const bf16x8*)(sB + (wn * 64 + nf * 16 + (lane & 15)) * 40 + (lane >> 4) * 8);
#pragma unroll
        for (int mf = 0; mf < 2; ++mf)
#pragma unroll
            for (int nf = 0; nf < 4; ++nf) acc[mf][nf] = __builtin_amdgcn_mfma_f32_16x16x32_bf16(af[mf], bfr[nf], acc[mf][nf], 0, 0, 0);
        __syncthreads();
    }
    epi(acc, wm, wn, lane);
}
template <class F> DEVI void for_each_acc(const f32x4 (&acc)[2][4], int wm, int wn, int lane, F f) {
#pragma unroll
    for (int mf = 0; mf < 2; ++mf)
#pragma unroll
        for (int nf = 0; nf < 4; ++nf)
#pragma unroll
            for (int j = 0; j < 4; ++j) f(wm * 32 + mf * 16 + (lane >> 4) * 4 + j, wn * 64 + nf * 16 + (lane & 15), acc[mf][nf][j]);
}

template <class Store>
DEVI void gemm_dense(char* lds, int M, int N, int K, const bf16* A, int lda, const float* W, int ldw, Store store, int item0, int nitems_total, int bid, int nb) {
    const int ntn = (N + 127) / 128, ntm = M / 128, nt = ntm * ntn;
    (void)nitems_total;
    for (int it = bid; it < item0 + nt; it += nb) {
        if (it < item0) continue;
        const int t = it - item0, tm = t / ntn, tn = t % ntn;
        gemm_tile(lds, K, A, lda, W, ldw,
                  [&](int r) { return tm * 128 + r; },
                  [&](int c) { const int pc = tn * 128 + c; return pc < N ? pc : -1; },
                  [&](const f32x4 (&acc)[2][4], int wm, int wn, int lane) {
                      for_each_acc(acc, wm, wn, lane, [&](int r, int c, float v) { const int n = tn * 128 + c; if (n < N) store(tm * 128 + r, n, v); });
                  });
    }
}


namespace g8 {
constexpr int BM = 256, BK = 64, HALF = 128, HTB = HALF * BK * 2, STAGE_BYTES = 8 * HTB, NXCD = 8, WGM = 8;
DEVI int lds_byte(int r, int c) { const int st = (r >> 4) * 2 + (c >> 5), rr = r & 15, cc = c & 31, ob = rr * 64 + cc * 2; return st * 1024 + (ob ^ (((ob >> 9) & 1) << 5)); }
DEVI void stage_rc(int b, int& R, int& C) { const int st = b / 1024, sb = b % 1024, swz = sb ^ (((sb >> 9) & 1) << 5); R = (st >> 1) * 16 + swz / 64; C = (st & 1) * 32 + (swz % 64) / 2; }
struct U { int pm, pn; const char* A; const char* Bt; int x0, x1, x2, x3; };
struct DenseOrder {
    int nM, nN, nwg, G, c, lda, K; const char* A; const char* Bt;
    DEVI void init(const bf16* A_, int lda_, const bf16* Bt_, int M, int N, int K_, int G_, int c_) { nM = M / BM; nN = N / BM; nwg = nM * nN; G = G_; c = c_; lda = lda_; K = K_; A = (const char*)A_; Bt = (const char*)Bt_; }
    DEVI bool next(int i, U& u) const {
        const long L = (long)i * G + c; if (L >= nwg) return false;
        int wgid = (int)L; { const int q = nwg / NXCD, r = nwg % NXCD, xcd = wgid % NXCD, off = wgid / NXCD; wgid = (xcd < r ? xcd * (q + 1) : r * (q + 1) + (xcd - r) * q) + off; }
        const int nig = WGM * nN, gid = wgid / nig, fm = gid * WGM, gsz = (nM - fm) < WGM ? (nM - fm) : WGM;
        u.pm = fm + ((wgid % nig) % gsz); u.pn = (wgid % nig) / gsz; u.A = A; u.Bt = Bt + (size_t)u.pn * BM * K * 2; return true;
    }
    DEVI unsigned a_off(const U& u, int h, int R, int C) const { return (unsigned)((u.pm * BM + h * HALF + R) * lda + C) * 2u; }
};
template <class Sched, class Epi>
DEVI void gemm8(LAS unsigned char* lds, const int K, const Sched& S, const Epi& E) {
    const int tid = threadIdx.x, wid = __builtin_amdgcn_readfirstlane(tid >> 6), lane = tid & 63, wr = wid >> 2, wc = wid & 3, fr = lane & 15, fq = lane >> 4;
    const int nt = K / BK;
    int Rr[2], Cc[2]; unsigned vb[2];
#pragma unroll
    for (int i = 0; i < 2; ++i) { stage_rc(tid * 16 + i * 8192, Rr[i], Cc[i]); vb[i] = (unsigned)(Rr[i] * K + Cc[i]) * 2u; }
    const size_t kstep = (size_t)(BK * 2), hstepB = (size_t)HALF * K * 2;
    const unsigned ldsw = (unsigned)wid * 1024u;
    const int aoff = lds_byte(wr * 64 + fr, fq * 8), boff = lds_byte(wc * 32 + fr, fq * 8);
#define G8_SA(b, h) (((b) * 2 + (h)) * HTB)
#define G8_SB(b, h) ((4 + (b) * 2 + (h)) * HTB)
#define G8_STAGE(bufoff, gbase, v0, v1) do { \
        __builtin_amdgcn_global_load_lds((const unsigned*)((const char*)(gbase) + (v0)), (LAS unsigned*)(lds + (bufoff) + ldsw), 16, 0, 0); \
        __builtin_amdgcn_global_load_lds((const unsigned*)((const char*)(gbase) + (v1)), (LAS unsigned*)(lds + (bufoff) + ldsw + 8192), 16, 0, 0); } while (0)
#define G8_LDA(dst, b, h) do { _Pragma("unroll") for (int m = 0; m < 4; ++m) _Pragma("unroll") for (int k = 0; k < 2; ++k) dst[m][k] = *(const LAS bf16x8*)(lds + G8_SA(b, h) + aoff + m * 2048 + k * 1024); } while (0)
#define G8_LDB(dst, b, h) do { _Pragma("unroll") for (int n = 0; n < 2; ++n) _Pragma("unroll") for (int k = 0; k < 2; ++k) dst[n][k] = *(const LAS bf16x8*)(lds + G8_SB(b, h) + boff + n * 2048 + k * 1024); } while (0)
#define G8_MMA(ai, bj, At, Bt) do { __builtin_amdgcn_s_setprio(1); _Pragma("unroll") for (int m = 0; m < 4; ++m) _Pragma("unroll") for (int n = 0; n < 2; ++n) _Pragma("unroll") for (int k = 0; k < 2; ++k) \
        acc[ai][bj][m][n] = __builtin_amdgcn_mfma_f32_16x16x32_bf16(Bt[n][k], At[m][k], acc[ai][bj][m][n], 0, 0, 0); __builtin_amdgcn_s_setprio(0); } while (0)
#define G8_WAIT_V(n) asm volatile("s_waitcnt vmcnt(" #n ")" ::: "memory")
#define G8_WAIT_L(n) asm volatile("s_waitcnt lgkmcnt(" #n ")" ::: "memory")
#define G8_BAR __builtin_amdgcn_s_barrier()
#define G8_SCHED __builtin_amdgcn_sched_barrier(0)
    U cur, nxt; int ui = 0;
    if (!S.next(0, cur)) return;
    f32x4 acc[2][2][4][2];
#pragma unroll
    for (int a = 0; a < 2; ++a)
#pragma unroll
        for (int b = 0; b < 2; ++b)
#pragma unroll
            for (int m = 0; m < 4; ++m)
#pragma unroll
                for (int n = 0; n < 2; ++n) acc[a][b][m][n] = (f32x4){0.f, 0.f, 0.f, 0.f};
    bf16x8 At[4][2], B0[2][2], B1[2][2];
    unsigned ac00 = S.a_off(cur, 0, Rr[0], Cc[0]), ac01 = S.a_off(cur, 0, Rr[1], Cc[1]), ac10 = S.a_off(cur, 1, Rr[0], Cc[0]), ac11 = S.a_off(cur, 1, Rr[1], Cc[1]);
    const char* cA = cur.A; const char* cB = cur.Bt;
    G8_STAGE(G8_SB(0, 0), cB, vb[0], vb[1]); G8_STAGE(G8_SA(0, 0), cA, ac00, ac01); G8_STAGE(G8_SB(0, 1), cB + hstepB, vb[0], vb[1]); G8_STAGE(G8_SA(0, 1), cA, ac10, ac11);
    if (wr == 1) G8_BAR;
    G8_WAIT_V(4); G8_BAR;
    G8_STAGE(G8_SB(1, 0), cB + kstep, vb[0], vb[1]); G8_STAGE(G8_SA(1, 0), cA + kstep, ac00, ac01); G8_STAGE(G8_SB(1, 1), cB + hstepB + kstep, vb[0], vb[1]);
    G8_WAIT_V(6); G8_BAR;
    for (;;) {
        const bool has_next = S.next(ui + 1, nxt);
        const char* nA = has_next ? nxt.A : cA; const char* nB = has_next ? nxt.Bt : cB;
        unsigned an00 = ac00, an01 = ac01, an10 = ac10, an11 = ac11;
        if (has_next) { an00 = S.a_off(nxt, 0, Rr[0], Cc[0]); an01 = S.a_off(nxt, 0, Rr[1], Cc[1]); an10 = S.a_off(nxt, 1, Rr[0], Cc[0]); an11 = S.a_off(nxt, 1, Rr[1], Cc[1]); }
        for (int t = 0; t < nt; t += 2) {
            const bool last = (t == nt - 2);
            const char* a1 = cA + (size_t)(t + 1) * kstep;
            const char* a2 = last ? nA : cA + (size_t)(t + 2) * kstep; const char* b2 = last ? nB : cB + (size_t)(t + 2) * kstep;
            const char* a3 = a2 + kstep; const char* b3 = b2 + kstep;
            const unsigned s00 = last ? an00 : ac00, s01 = last ? an01 : ac01, s10 = last ? an10 : ac10, s11 = last ? an11 : ac11;
            G8_LDB(B0, 0, 0); G8_SCHED; G8_LDA(At, 0, 0); G8_STAGE(G8_SA(1, 1), a1, ac10, ac11);
            G8_WAIT_L(8); G8_BAR; G8_WAIT_L(0); G8_MMA(0, 0, At, B0); G8_BAR; G8_SCHED;
            G8_LDB(B1, 0, 1); G8_STAGE(G8_SB(0, 0), b2, vb[0], vb[1]);
            G8_BAR; G8_WAIT_L(0); G8_MMA(0, 1, At, B1); G8_BAR;
            G8_LDA(At, 0, 1); G8_STAGE(G8_SA(0, 0), a2, s00, s01);
            G8_BAR; G8_WAIT_L(0); G8_MMA(1, 0, At, B0); G8_BAR; G8_SCHED;
            G8_STAGE(G8_SB(0, 1), b2 + hstepB, vb[0], vb[1]);
            G8_WAIT_V(6); G8_BAR; G8_MMA(1, 1, At, B1); G8_BAR;
            G8_LDB(B0, 1, 0); G8_SCHED; G8_LDA(At, 1, 0); G8_STAGE(G8_SA(0, 1), a2, s10, s11);
            G8_WAIT_L(8); G8_BAR; G8_WAIT_L(0); G8_MMA(0, 0, At, B0); G8_BAR; G8_SCHED;
            G8_LDB(B1, 1, 1); G8_STAGE(G8_SB(1, 0), b3, vb[0], vb[1]);
            G8_BAR; G8_WAIT_L(0); G8_MMA(0, 1, At, B1); G8_BAR;
            G8_LDA(At, 1, 1); G8_STAGE(G8_SA(1, 0), a3, s00, s01);
            G8_BAR; G8_WAIT_L(0); G8_MMA(1, 0, At, B0); G8_BAR; G8_SCHED;
            G8_STAGE(G8_SB(1, 1), b3 + hstepB, vb[0], vb[1]);
            G8_WAIT_V(6); G8_BAR; G8_MMA(1, 1, At, B1); G8_BAR;
        }
        E(acc, cur, wr, wc, fr, fq);
        if (!has_next) break;
#pragma unroll
        for (int a = 0; a < 2; ++a)
#pragma unroll
            for (int b = 0; b < 2; ++b)
#pragma unroll
                for (int m = 0; m < 4; ++m)
#pragma unroll
                    for (int n = 0; n < 2; ++n) acc[a][b][m][n] = (f32x4){0.f, 0.f, 0.f, 0.f};
        cur = nxt; cA = nA; cB = nB; ac00 = an00; ac01 = an01; ac10 = an10; ac11 = an11; ++ui;
    }
    G8_WAIT_V(0);
    if (wr == 0) G8_BAR;
    G8_BAR;
#undef G8_SA
#undef G8_SB
#undef G8_STAGE
#undef G8_LDA
#undef G8_LDB
#undef G8_MMA
#undef G8_WAIT_V
#undef G8_WAIT_L
#undef G8_BAR
#undef G8_SCHED
}
struct EpiBf16 {
    bf16* O; int ld, ncols; float* FL; int fl0;
    DEVI void operator()(const f32x4 (&acc)[2][2][4][2], const U& u, int wr, int wc, int fr, int fq) const {
        const int row0 = u.pm * BM + wr * 64 + fr, col0 = u.pn * BM + wc * 32 + 4 * fq;
#pragma unroll
        for (int ai = 0; ai < 2; ++ai)
#pragma unroll
            for (int m = 0; m < 4; ++m) { const int row = row0 + ai * HALF + m * 16;
#pragma unroll
                for (int bj = 0; bj < 2; ++bj)
#pragma unroll
                    for (int n = 0; n < 2; ++n) { const int col = col0 + bj * HALF + n * 16; const f32x4 v = acc[ai][bj][m][n];
                        if (col < ncols) { uint2 w; w.x = pk2(v[0], v[1]); w.y = pk2(v[2], v[3]); *(uint2*)(O + (size_t)row * ld + col) = w;
                            if (FL && col >= fl0) *(f32x4*)(FL + (size_t)row * 8 + (col - fl0)) = v; } } }
    }
};
struct EpiRes {
    float* C; const float* res; int ld; float alpha;
    DEVI void operator()(const f32x4 (&acc)[2][2][4][2], const U& u, int wr, int wc, int fr, int fq) const {
        const int row0 = u.pm * BM + wr * 64 + fr, col0 = u.pn * BM + wc * 32 + 4 * fq;
#pragma unroll
        for (int ai = 0; ai < 2; ++ai)
#pragma unroll
            for (int m = 0; m < 4; ++m) { const size_t ro = (size_t)(row0 + ai * HALF + m * 16) * ld + col0;
#pragma unroll
                for (int bj = 0; bj < 2; ++bj)
#pragma unroll
                    for (int n = 0; n < 2; ++n) { const size_t o = ro + bj * HALF + n * 16; *(f32x4*)(C + o) = *(const f32x4*)(res + o) * alpha + acc[ai][bj][m][n]; } }
    }
};

struct MoeOrder {
    const LAS int* sh; const int* list; const char* A; const char* W; int lda, K, ntn, G, c, stage; size_t wstride;
    DEVI bool next(int i, U& u) const {
        const int L = i * G + c; if (L >= sh[33 + 32]) return false;
        int e = 0; while (sh[33 + e + 1] <= L) ++e;
        const int r = L - sh[33 + e]; u.pm = r / ntn; u.pn = r % ntn; u.x0 = e; u.x1 = sh[e + 1] - sh[e]; u.x2 = sh[e];
        u.A = A; u.Bt = W + (size_t)e * wstride + (size_t)u.pn * BM * K * 2; return true;
    }
    DEVI unsigned a_off(const U& u, int h, int R, int C) const {
        int i = u.pm * BM + h * HALF + R; if (i > u.x1 - 1) i = u.x1 - 1;
        const int row = stage == 1 ? (list[u.x0 * T + i] >> 1) : (u.x2 + i);
        return (unsigned)(row * lda + C) * 2u;
    }
};
struct EpiMoe1 {
    bf16* hdn;
    DEVI void operator()(const f32x4 (&acc)[2][2][4][2], const U& u, int wr, int wc, int fr, int fq) const {
        const int i0 = u.pm * BM + wr * 64 + fr, j0 = u.pn * HALF + wc * 32 + 4 * fq;
#pragma unroll
        for (int ai = 0; ai < 2; ++ai)
#pragma unroll
            for (int m = 0; m < 4; ++m) { const int i = i0 + ai * HALF + m * 16;
                if (i < u.x1) {
#pragma unroll
                    for (int n = 0; n < 2; ++n) { const f32x4 gv = acc[ai][0][m][n], uv = acc[ai][1][m][n]; float hv[4];
#pragma unroll
                        for (int q = 0; q < 4; ++q) hv[q] = gv[q] / (1.f + __expf(-gv[q])) * uv[q];
                        uint2 w; w.x = pk2(hv[0], hv[1]); w.y = pk2(hv[2], hv[3]);
                        *(uint2*)(hdn + (size_t)(u.x2 + i) * FF + j0 + n * 16) = w; } } }
    }
};
struct EpiMoe2 {
    float* Y; const int* list; const float* ew;
    DEVI void operator()(const f32x4 (&acc)[2][2][4][2], const U& u, int wr, int wc, int fr, int fq) const {
        const int i0 = u.pm * BM + wr * 64 + fr, col0 = u.pn * BM + wc * 32 + 4 * fq;
#pragma unroll
        for (int ai = 0; ai < 2; ++ai)
#pragma unroll
            for (int m = 0; m < 4; ++m) { const int i = i0 + ai * HALF + m * 16;
                if (i < u.x1) { const int ent = list[u.x0 * T + i]; const float wt = ew[ent]; float* yr = Y + (size_t)ent * DM + col0;
#pragma unroll
                    for (int bj = 0; bj < 2; ++bj)
#pragma unroll
                        for (int n = 0; n < 2; ++n) *(f32x4*)(yr + bj * HALF + n * 16) = acc[ai][bj][m][n] * wt; } }
    }
};
}

DEVI void transpose_item64(const float* W, int K, int Nsrc, int src_c0, bf16* WT, int dst_r0, int k0, LAS float* scr, int lane) {
    const int cq = 4 * (lane & 15), kq = lane >> 4;
    const bool ok = src_c0 >= 0 && (src_c0 + cq + 3) < Nsrc;
    const float* wp = W + (size_t)(k0 + kq) * Nsrc + (src_c0 < 0 ? 0 : src_c0) + cq;
    f32x4 v[16];
#pragma unroll
    for (int i = 0; i < 16; ++i) v[i] = ok ? *(const f32x4*)(wp + (size_t)(4 * i) * Nsrc) : (f32x4){0.f, 0.f, 0.f, 0.f};
#pragma unroll
    for (int i = 0; i < 16; ++i) { const int k = 4 * i + kq; *(LAS f32x4*)(scr + k * 68 + (cq ^ (((k >> 3) & 7) << 2))) = v[i]; }
    asm volatile("s_waitcnt lgkmcnt(0)" ::: "memory");
    const int c = lane & 7;
#pragma unroll
    for (int j = 0; j < 8; ++j) { const int n = (lane >> 3) + 8 * j; const LAS float* sp = scr + (8 * c) * 68 + (n ^ (c << 2));
        u32x4 o; o[0] = pk2(sp[0 * 68], sp[1 * 68]); o[1] = pk2(sp[2 * 68], sp[3 * 68]); o[2] = pk2(sp[4 * 68], sp[5 * 68]); o[3] = pk2(sp[6 * 68], sp[7 * 68]);
        *(u32x4*)(WT + (size_t)(dst_r0 + n) * K + k0 + 8 * c) = o; }
    asm volatile("s_waitcnt lgkmcnt(0)" ::: "memory");
}
template <class Map>
DEVI void cvt_matrix(const float* W, int K, int Nsrc, int Ndst, bf16* WT, Map smap, LAS float* scr, int gw, int ngw, int lane, int& base) {
    const int nblk = Ndst / 64, n = (K / 64) * nblk;
    int first = (gw - base % ngw + ngw) % ngw;
    for (int it = first; it < n; it += ngw) { const int kb = it / nblk, nb_ = it % nblk; transpose_item64(W, K, Nsrc, smap(nb_ * 64), WT, nb_ * 64, kb * 64, scr, lane); }
    base += n;
}

template <int DK1, int DK2, int DV, class Bias>
DEVI void attn_range(const float* qs, const bf16* K1, int ldk1, const bf16* K2, int ldk2, const bf16* V, int ldv,
                     int j0, int j1, float scale, Bias bias, float& m, float& l, float (&o)[2], int lane) {
    for (int jb = j0; jb < j1; jb += 64) {
        const int j = jb + lane; const bool valid = j < j1;
        float s = -__builtin_inff();
        if (valid) {
            float acc = 0.f;
            const bf16* kr = K1 + (size_t)j * ldk1;
#pragma unroll 4
            for (int d = 0; d < DK1; d += 8) {
                const u32x4 kv = *(const u32x4*)(kr + d); const f32x4 q0 = *(const f32x4*)(qs + d), q1 = *(const f32x4*)(qs + d + 4);
                acc += q0[0] * bflo(kv[0]) + q0[1] * bfhi(kv[0]) + q0[2] * bflo(kv[1]) + q0[3] * bfhi(kv[1])
                     + q1[0] * bflo(kv[2]) + q1[1] * bfhi(kv[2]) + q1[2] * bflo(kv[3]) + q1[3] * bfhi(kv[3]);
            }
            if (DK2 > 0) {
                const bf16* kr2 = K2 + (size_t)j * ldk2;
#pragma unroll 4
                for (int d = 0; d < DK2; d += 8) {
                    const u32x4 kv = *(const u32x4*)(kr2 + d); const f32x4 q0 = *(const f32x4*)(qs + DK1 + d), q1 = *(const f32x4*)(qs + DK1 + d + 4);
                    acc += q0[0] * bflo(kv[0]) + q0[1] * bfhi(kv[0]) + q0[2] * bflo(kv[1]) + q0[3] * bfhi(kv[1])
                         + q1[0] * bflo(kv[2]) + q1[1] * bfhi(kv[2]) + q1[2] * bflo(kv[3]) + q1[3] * bfhi(kv[3]);
                }
            }
            s = acc * scale + bias(j);
        }
        const float cm = wave_max(s);
        const float mn = fmaxf(m, cm);
        const float alpha = __expf(m - mn);
        const float p = __expf(s - mn);
        l = l * alpha + wave_sum(p);
        o[0] *= alpha; o[1] *= alpha;
        m = mn;
        const int cnt = (j1 - jb) < 64 ? (j1 - jb) : 64;
        for (int jj = 0; jj < cnt; ++jj) {
            const float pj = __shfl(p, jj);
            const bf16* vr = V + (size_t)(jb + jj) * ldv;
            if (DV == 128) { const unsigned vv = *(const unsigned*)(vr + lane * 2); o[0] += pj * bflo(vv); o[1] += pj * bfhi(vv); }
            else { o[0] += pj * bf2f(vr[lane]); }
        }
    }
}


typedef short s16x4 __attribute__((ext_vector_type(4)));
typedef float f32x16 __attribute__((ext_vector_type(16)));
constexpr int FA_V = 0, FA_K = 32768, FA_KR = 65536, FA_CUM = 81920, FA_WS = 82432, FA_Q = 131072 + 512, FA_KM = 84992, FA_END = 93184;
constexpr int SHM_K = 16384, SHM_V = 16384, SHM_KR = 8192;
#define KSWZ(row, colB) ((row) * 256 + ((colB) ^ (((row) & 7) << 4)))
DEVI int v_st(int k, int c) { const int kk = (k & ~0xC) | ((k & 4) << 1) | ((k & 8) >> 1); return ((kk >> 3) * 4 + (c >> 5)) * 512 + ((kk & 7) * 32 + (c & 31)) * 2; }
DEVI int v_rd_base(int lane) { return ((lane & 3) << 3) | (((lane >> 2) & 3) << 6) | (((lane >> 4) & 1) << 5) | (((lane >> 5) & 1) << 8); }
DEVI int crow(int r, int hi) { return (r & 3) + 8 * (r >> 2) + 4 * hi; }
DEVI unsigned cvtpk(float lo, float hi) { unsigned r; asm volatile("v_cvt_pk_bf16_f32 %0, %1, %2" : "=v"(r) : "v"(lo), "v"(hi)); return r; }
enum { FM_MLA = 0, FM_FOX = 1, FM_MOBA = 2 };

template <int MODE>
DEVI void flash_unit(char* lds, const bf16* Qp, int ldq, const bf16* Kp, int ldk, const bf16* Vp, int ldv, const bf16* KRp,
                     const float* cum, const float* km, float slope, int q0, bf16* Op, int ldo) {
    const int tid = threadIdx.x, wid = __builtin_amdgcn_readfirstlane(tid >> 6), lane = tid & 63, r32 = lane & 31, hi = lane >> 5;
    char* V_lds = lds + FA_V; char* K_lds = lds + FA_K; char* KR_lds = lds + FA_KR;
    float* cumt = (float*)(lds + FA_CUM);
    float* wsf = (float*)(lds + FA_WS) + wid * 64; float* li_l = wsf; float* al_l = wsf + 32;
    const int qrow = q0 + wid * 32 + r32;
    constexpr float LOG2E = 1.4426950408889634f;
    constexpr float SC = (MODE == FM_MLA ? 0.07216878364870322f : 0.08838834764831845f) * LOG2E;
    constexpr int NQ = MODE == FM_MLA ? 12 : 8;
    bf16x8 qr[NQ];
    const bf16* qp = Qp + (size_t)qrow * ldq;
#pragma unroll
    for (int d0 = 0; d0 < 8; ++d0) qr[d0] = *(const bf16x8*)(qp + d0 * 16 + hi * 8);
    if constexpr (MODE == FM_MLA) {
        const bf16x8 a0 = *(const bf16x8*)(qp + 128 + hi * 8), a1 = *(const bf16x8*)(qp + 144 + hi * 8);
        const bf16x8 b0 = *(const bf16x8*)(qp + 160 + hi * 8), b1 = *(const bf16x8*)(qp + 176 + hi * 8);
        bf16x8 ra0, ra1, rb0, rb1;
#pragma unroll
        for (int e = 0; e < 8; ++e) {
            float c, s_;
            rope_cs(qrow, hi * 8 + e, c, s_);
            { const float t1 = bf2f((unsigned short)a0[e]), t2 = bf2f((unsigned short)b0[e]); ra0[e] = (short)f2bf(t1 * c - t2 * s_); rb0[e] = (short)f2bf(t1 * s_ + t2 * c); }
            rope_cs(qrow, 16 + hi * 8 + e, c, s_);
            { const float t1 = bf2f((unsigned short)a1[e]), t2 = bf2f((unsigned short)b1[e]); ra1[e] = (short)f2bf(t1 * c - t2 * s_); rb1[e] = (short)f2bf(t1 * s_ + t2 * c); }
        }
        qr[8] = ra0; qr[9] = ra1; qr[10] = rb0; qr[11] = rb1;
    }
    const int j_hi = (q0 >> 6) + 4;
    unsigned sel = 0xffffffffu, umask = 0xffffffffu;
    if constexpr (MODE == FM_MOBA) {
        const int blk = q0 >> 8;
        float* kml = (float*)(lds + FA_KM);
        unsigned* um = (unsigned*)(lds + FA_Q) + 4;
        *(f32x4*)(kml + tid * 4) = *(const f32x4*)(km + tid * 4);
        if (tid == 0) *um = 0u;
        __syncthreads();
        float g[15];
#pragma unroll
        for (int n = 0; n < 15; ++n) g[n] = 0.f;
        for (int dd = 0; dd < 64; dd += 8) {
            const bf16x8 qv = *(const bf16x8*)(qp + hi * 64 + dd);
            float qf[8];
#pragma unroll
            for (int e = 0; e < 8; ++e) qf[e] = bf2f((unsigned short)qv[e]);
#pragma unroll
            for (int n = 0; n < 15; ++n)
                if (n < blk) {
                    const f32x4 k0 = *(const f32x4*)(kml + n * 128 + hi * 64 + dd), k1 = *(const f32x4*)(kml + n * 128 + hi * 64 + dd + 4);
                    g[n] += qf[0] * k0[0] + qf[1] * k0[1] + qf[2] * k0[2] + qf[3] * k0[3] + qf[4] * k1[0] + qf[5] * k1[1] + qf[6] * k1[2] + qf[7] * k1[3];
                }
        }
#pragma unroll
        for (int n = 0; n < 15; ++n) g[n] += __shfl_xor(g[n], 32);
        sel = 1u << blk;
#pragma unroll
        for (int r = 0; r < 3; ++r) {
            float best = -__builtin_inff(); int bi = -1;
#pragma unroll
            for (int n = 0; n < 15; ++n) if (n < blk && !((sel >> n) & 1u) && g[n] > best) { best = g[n]; bi = n; }
            if (bi >= 0) sel |= 1u << bi;
        }
        unsigned wm_ = 0u;
#pragma unroll
        for (int n = 0; n < 16; ++n) if (__any((sel >> n) & 1u)) wm_ |= 1u << n;
        if (lane == 0) atomicOr(um, wm_);
        __syncthreads();
        umask = *um;
    }
    auto nxt = [&](int j) { do { ++j; } while (j < j_hi && !((umask >> (j >> 2)) & 1u)); return j; };
    int jc = nxt(-1);
    const int sr = tid >> 4, sc = (tid & 15) * 8;
    const int kws = KSWZ(sr, sc * 2), vst0 = v_st(sr, sc), vst1 = v_st(32 + sr, sc);
    const int krk = tid >> 3, krc = tid & 7, krw = krk * 128 + ((krc ^ (krk & 7)) << 4);
    bf16x8 st_k0, st_k1, st_v0, st_v1, st_kr; float st_c = 0.f;
#define FA_GL(kb) do { const unsigned ko_ = (unsigned)(((kb) + sr) * ldk + sc) * 2u, vo_ = (unsigned)(((kb) + sr) * ldv + sc) * 2u; \
        st_k0 = *(const bf16x8*)((const char*)Kp + ko_); st_k1 = *(const bf16x8*)((const char*)Kp + ko_ + (unsigned)(64 * ldk)); \
        st_v0 = *(const bf16x8*)((const char*)Vp + vo_); st_v1 = *(const bf16x8*)((const char*)Vp + vo_ + (unsigned)(64 * ldv)); \
        if constexpr (MODE == FM_MLA) st_kr = *(const bf16x8*)((const char*)KRp + (unsigned)(((kb) + krk) * 64 + krc * 8) * 2u); \
        if constexpr (MODE == FM_FOX) { if (tid < 64) st_c = cum[(kb) + tid]; } } while (0)
#define FA_SW(bf) do { *(bf16x8*)(K_lds + (bf) * SHM_K + kws) = st_k0; *(bf16x8*)(K_lds + (bf) * SHM_K + kws + 32 * 256) = st_k1; \
        *(bf16x8*)(V_lds + (bf) * SHM_V + vst0) = st_v0; *(bf16x8*)(V_lds + (bf) * SHM_V + vst1) = st_v1; \
        if constexpr (MODE == FM_MLA) *(bf16x8*)(KR_lds + (bf) * SHM_KR + krw) = st_kr; \
        if constexpr (MODE == FM_FOX) { if (tid < 64) cumt[(bf) * 64 + tid] = st_c; } } while (0)
    FA_GL(jc * 64);
    asm volatile("s_waitcnt vmcnt(0)" ::: "memory");
    FA_SW(0);
    float m_reg = -1e30f, l_reg = 0.f;
    f32x16 o[4];
#pragma unroll
    for (int d = 0; d < 4; ++d)
#pragma unroll
        for (int r = 0; r < 16; ++r) o[d][r] = 0.f;
    float cqL = 0.f;
    if constexpr (MODE == FM_FOX) cqL = cum[qrow];
    const float slopeL = slope * LOG2E;
    const int vb0 = (int)(unsigned)(size_t)((LAS char*)V_lds) + v_rd_base(lane);
    int bf = 0;
    while (jc < j_hi) {
        const int kb = jc * 64;
        const int jn = nxt(jc);
        __syncthreads();
        if (jn < j_hi) FA_GL(jn * 64);
        f32x16 p0, p1;
#pragma unroll
        for (int r = 0; r < 16; ++r) { p0[r] = 0.f; p1[r] = 0.f; }
        {
            const char* kbase = K_lds + bf * SHM_K;
            const char* kbp[4];
#pragma unroll
            for (int dd = 0; dd < 4; ++dd) kbp[dd] = kbase + KSWZ(r32, (dd * 16 + hi * 8) * 2);
#pragma unroll
            for (int d0 = 0; d0 < 8; ++d0) {
                const char* ap = kbp[d0 & 3] + (d0 >> 2) * 128;
                const bf16x8 b0 = *(const bf16x8*)(ap), b1 = *(const bf16x8*)(ap + 32 * 256);
                p0 = __builtin_amdgcn_mfma_f32_32x32x16_bf16(b0, qr[d0], p0, 0, 0, 0);
                p1 = __builtin_amdgcn_mfma_f32_32x32x16_bf16(b1, qr[d0], p1, 0, 0, 0);
            }
            if constexpr (MODE == FM_MLA) {
                const char* krb = KR_lds + bf * SHM_KR + r32 * 128;
#pragma unroll
                for (int d = 0; d < 4; ++d) {
                    const int off = (((d * 2 + hi) ^ (r32 & 7)) << 4);
                    const bf16x8 b0 = *(const bf16x8*)(krb + off), b1 = *(const bf16x8*)(krb + 32 * 128 + off);
                    p0 = __builtin_amdgcn_mfma_f32_32x32x16_bf16(b0, qr[8 + d], p0, 0, 0, 0);
                    p1 = __builtin_amdgcn_mfma_f32_32x32x16_bf16(b1, qr[8 + d], p1, 0, 0, 0);
                }
            }
        }
        if (jn < j_hi) { asm volatile("s_waitcnt vmcnt(0)" ::: "memory"); FA_SW(bf ^ 1); }
        if constexpr (MODE == FM_FOX) {
#pragma unroll
            for (int g4 = 0; g4 < 4; ++g4) {
                const f32x4 c0 = *(const f32x4*)(cumt + bf * 64 + 8 * g4 + 4 * hi), c1 = *(const f32x4*)(cumt + bf * 64 + 32 + 8 * g4 + 4 * hi);
#pragma unroll
                for (int i = 0; i < 4; ++i) { p0[4 * g4 + i] = p0[4 * g4 + i] * SC + (cqL - c0[i]) * LOG2E; p1[4 * g4 + i] = p1[4 * g4 + i] * SC + (cqL - c1[i]) * LOG2E; }
            }
        } else if constexpr (MODE == FM_MOBA) {
            const float dq = (float)(qrow - kb - 4 * hi);
#pragma unroll
            for (int r = 0; r < 16; ++r) { const float c = (float)((r & 3) + 8 * (r >> 2));
                p0[r] = p0[r] * SC - slopeL * (dq - c); p1[r] = p1[r] * SC - slopeL * (dq - c - 32.f); }
        } else {
#pragma unroll
            for (int r = 0; r < 16; ++r) { p0[r] *= SC; p1[r] *= SC; }
        }
        const float NEG = -__builtin_inff();
        if (kb + 63 > q0 + wid * 32) {
            const int dqi = qrow - kb - 4 * hi;
#pragma unroll
            for (int r = 0; r < 16; ++r) { const int c = (r & 3) + 8 * (r >> 2); if (c > dqi) p0[r] = NEG; if (c + 32 > dqi) p1[r] = NEG; }
        }
        if constexpr (MODE == FM_MOBA) {
            if (!((sel >> (kb >> 8)) & 1u)) {
#pragma unroll
                for (int r = 0; r < 16; ++r) { p0[r] = NEG; p1[r] = NEG; }
            }
        }
        float pmax = p0[0];
#pragma unroll
        for (int r = 1; r < 16; ++r) pmax = fmaxf(pmax, p0[r]);
#pragma unroll
        for (int r = 0; r < 16; ++r) pmax = fmaxf(pmax, p1[r]);
        { auto rr = __builtin_amdgcn_permlane32_swap(__float_as_uint(pmax), __float_as_uint(pmax), false, false);
          pmax = fmaxf(__uint_as_float(rr[0]), __uint_as_float(rr[1])); }
        const float mn = fmaxf(m_reg, pmax);
        const float alpha = __builtin_amdgcn_exp2f(m_reg - mn);
        m_reg = mn;
        float ps = 0.f;
#pragma unroll
        for (int r = 0; r < 16; ++r) { p0[r] = __builtin_amdgcn_exp2f(p0[r] - mn); p1[r] = __builtin_amdgcn_exp2f(p1[r] - mn); ps += p0[r] + p1[r]; }
        { auto rr = __builtin_amdgcn_permlane32_swap(__float_as_uint(ps), __float_as_uint(ps), false, false);
          ps = __uint_as_float(rr[0]) + __uint_as_float(rr[1]); }
        l_reg = l_reg * alpha + ps;
        bf16x8 pa0, pa1, pa2, pa3;
#define PK4(P, B_, OUT) do { unsigned a0_ = cvtpk(P[B_ + 0], P[B_ + 1]), a1_ = cvtpk(P[B_ + 2], P[B_ + 3]); \
        unsigned b0_ = cvtpk(P[B_ + 4], P[B_ + 5]), b1_ = cvtpk(P[B_ + 6], P[B_ + 7]); \
        auto r0_ = __builtin_amdgcn_permlane32_swap(a0_, b0_, false, false); auto r1_ = __builtin_amdgcn_permlane32_swap(a1_, b1_, false, false); \
        u32x4 w_ = {r0_[0], r1_[0], r0_[1], r1_[1]}; OUT = *reinterpret_cast<bf16x8*>(&w_); } while (0)
        PK4(p0, 0, pa0); PK4(p0, 8, pa1); PK4(p1, 0, pa2); PK4(p1, 8, pa3);
#undef PK4
        if (__any(alpha < 1.f)) {
            if (hi == 0) al_l[r32] = alpha;
            asm volatile("s_waitcnt lgkmcnt(0)" ::: "memory");
#pragma unroll
            for (int d = 0; d < 4; ++d)
#pragma unroll
                for (int r = 0; r < 16; ++r) o[d][r] *= al_l[crow(r, hi)];
        }
        {
            const int vb = vb0 + bf * SHM_V;
#define TRRD(dst, off) asm volatile("ds_read_b64_tr_b16 %0, %1 offset:%2" : "=&v"(dst) : "v"(vb), "i"(off) : "memory")
#define PV_D0(d0) do { s16x4 l0, l1, l2, l3, h0, h1, h2, h3; constexpr int b_ = (d0) * 512; \
        TRRD(l0, b_); TRRD(h0, b_ + 2048); TRRD(l1, b_ + 4096); TRRD(h1, b_ + 6144); TRRD(l2, b_ + 8192); TRRD(h2, b_ + 10240); TRRD(l3, b_ + 12288); TRRD(h3, b_ + 14336); \
        asm volatile("s_waitcnt lgkmcnt(0)" ::: "memory"); __builtin_amdgcn_sched_barrier(0); \
        o[d0] = __builtin_amdgcn_mfma_f32_32x32x16_bf16(pa0, (bf16x8){l0[0], l0[1], l0[2], l0[3], h0[0], h0[1], h0[2], h0[3]}, o[d0], 0, 0, 0); \
        o[d0] = __builtin_amdgcn_mfma_f32_32x32x16_bf16(pa1, (bf16x8){l1[0], l1[1], l1[2], l1[3], h1[0], h1[1], h1[2], h1[3]}, o[d0], 0, 0, 0); \
        o[d0] = __builtin_amdgcn_mfma_f32_32x32x16_bf16(pa2, (bf16x8){l2[0], l2[1], l2[2], l2[3], h2[0], h2[1], h2[2], h2[3]}, o[d0], 0, 0, 0); \
        o[d0] = __builtin_amdgcn_mfma_f32_32x32x16_bf16(pa3, (bf16x8){l3[0], l3[1], l3[2], l3[3], h3[0], h3[1], h3[2], h3[3]}, o[d0], 0, 0, 0); } while (0)
            PV_D0(0); PV_D0(1); PV_D0(2); PV_D0(3);
#undef PV_D0
#undef TRRD
        }
        bf ^= 1; jc = jn;
    }
#undef FA_GL
#undef FA_SW
    if (hi == 0) li_l[r32] = l_reg;
    asm volatile("s_waitcnt lgkmcnt(0)" ::: "memory");
    int tz = lane; asm volatile("" : "+v"(tz));
    const int hz = tz >> 5, rz = tz & 31;
    bf16* Ow = Op + (size_t)(q0 + wid * 32) * ldo;
#pragma unroll
    for (int r = 0; r < 16; ++r) {
        const int orow = crow(r, hz);
        const float rl = 1.f / li_l[orow];
        const unsigned obase = (unsigned)(orow * ldo + rz);
#pragma unroll
        for (int d0 = 0; d0 < 4; ++d0) {
            const float v = o[d0][r] * rl;
            const float vn = __shfl_xor(v, 1);
            if ((rz & 1) == 0) *(unsigned*)(Ow + obase + d0 * 32) = cvtpk(v, vn);
        }
    }
    __syncthreads();
}


constexpr int SW_V = 0, SW_K = 49152, SW_WS = 98304;
DEVI void swa_unit(char* lds, const bf16* Pb  , int kvh, int q0, const float* sinks, bf16* Ob  ) {
    const int tid = threadIdx.x, wid = __builtin_amdgcn_readfirstlane(tid >> 6), lane = tid & 63, r32 = lane & 31, hi = lane >> 5;
    char* V_lds = lds + SW_V; char* K_lds = lds + SW_K;
    float* wsf = (float*)(lds + SW_WS) + wid * 64; float* li_l = wsf; float* al_l = wsf + 32;
    constexpr float LOG2E = 1.4426950408889634f, SC = 0.125f * LOG2E;
    const int qh = kvh * 8 + wid;
    const float slopeL = exp2f(-0.5f * (float)(qh + 1)) * LOG2E, sinkL = sinks[qh] * LOG2E;
    {
        const int key = tid >> 3, ch = tid & 7;
        const int kws = KSWZ(key, ch * 16), vws = v_st(key, ch * 8);
        bf16x8 sk[3], sv[3];
#pragma unroll
        for (int jt = 0; jt < 3; ++jt) {
            const int kb = q0 - 128 + jt * 64;
            if (kb >= 0) {
                const unsigned o_ = (unsigned)((kb + key) * LDP + ch * 8) * 2u;
                sk[jt] = *(const bf16x8*)((const char*)Pb + o_ + (unsigned)(O_SK + kvh * 64) * 2u);
                sv[jt] = *(const bf16x8*)((const char*)Pb + o_ + (unsigned)(O_SV + kvh * 64) * 2u);
            }
        }
#pragma unroll
        for (int jt = 0; jt < 3; ++jt) {
            const int kb = q0 - 128 + jt * 64;
            if (kb >= 0) { *(bf16x8*)(K_lds + jt * SHM_K + kws) = sk[jt]; *(bf16x8*)(V_lds + jt * SHM_V + vws) = sv[jt]; }
        }
    }
    __syncthreads();
    const int vb0 = (int)(unsigned)(size_t)((LAS char*)V_lds) + v_rd_base(lane);
    for (int rg = 0; rg < 2; ++rg) {
        const int qrow = q0 + rg * 32 + r32;
        bf16x8 qr[4];
        const bf16* qp = Pb + (size_t)qrow * LDP + O_SQ + qh * 64;
#pragma unroll
        for (int d0 = 0; d0 < 4; ++d0) qr[d0] = *(const bf16x8*)(qp + d0 * 16 + hi * 8);
        float m_reg = -1e30f, l_reg = 0.f;
        f32x16 o[2];
#pragma unroll
        for (int d = 0; d < 2; ++d)
#pragma unroll
            for (int r = 0; r < 16; ++r) o[d][r] = 0.f;
#pragma unroll 1
        for (int jt = 0; jt < 3; ++jt) {
            const int kb = q0 - 128 + jt * 64;
            if (kb < 0) continue;
            f32x16 p0, p1;
#pragma unroll
            for (int r = 0; r < 16; ++r) { p0[r] = 0.f; p1[r] = 0.f; }
            {
                const char* kbase = K_lds + jt * SHM_K;
#pragma unroll
                for (int d0 = 0; d0 < 4; ++d0) {
                    const char* ap = kbase + KSWZ(r32, (d0 * 16 + hi * 8) * 2);
                    const bf16x8 b0 = *(const bf16x8*)(ap), b1 = *(const bf16x8*)(ap + 32 * 256);
                    p0 = __builtin_amdgcn_mfma_f32_32x32x16_bf16(b0, qr[d0], p0, 0, 0, 0);
                    p1 = __builtin_amdgcn_mfma_f32_32x32x16_bf16(b1, qr[d0], p1, 0, 0, 0);
                }
            }
            const float NEG = -__builtin_inff();
            const int dqi = qrow - kb - 4 * hi;
#pragma unroll
            for (int r = 0; r < 16; ++r) {
                const int c = (r & 3) + 8 * (r >> 2);
                const int d0_ = dqi - c, d1_ = dqi - c - 32;
                p0[r] = ((unsigned)d0_ < 128u) ? p0[r] * SC - slopeL * (float)d0_ : NEG;
                p1[r] = ((unsigned)d1_ < 128u) ? p1[r] * SC - slopeL * (float)d1_ : NEG;
            }
            float pmax = p0[0];
#pragma unroll
            for (int r = 1; r < 16; ++r) pmax = fmaxf(pmax, p0[r]);
#pragma unroll
            for (int r = 0; r < 16; ++r) pmax = fmaxf(pmax, p1[r]);
            { auto rr = __builtin_amdgcn_permlane32_swap(__float_as_uint(pmax), __float_as_uint(pmax), false, false);
              pmax = fmaxf(__uint_as_float(rr[0]), __uint_as_float(rr[1])); }
            const float mn = fmaxf(m_reg, pmax);
            const float alpha = __builtin_amdgcn_exp2f(m_reg - mn);
            m_reg = mn;
            float ps = 0.f;
#pragma unroll
            for (int r = 0; r < 16; ++r) { p0[r] = __builtin_amdgcn_exp2f(p0[r] - mn); p1[r] = __builtin_amdgcn_exp2f(p1[r] - mn); ps += p0[r] + p1[r]; }
            { auto rr = __builtin_amdgcn_permlane32_swap(__float_as_uint(ps), __float_as_uint(ps), false, false);
              ps = __uint_as_float(rr[0]) + __uint_as_float(rr[1]); }
            l_reg = l_reg * alpha + ps;
            bf16x8 pa0, pa1, pa2, pa3;
#define PK4(P, B_, OUT) do { unsigned a0_ = cvtpk(P[B_ + 0], P[B_ + 1]), a1_ = cvtpk(P[B_ + 2], P[B_ + 3]); \
        unsigned b0_ = cvtpk(P[B_ + 4], P[B_ + 5]), b1_ = cvtpk(P[B_ + 6], P[B_ + 7]); \
        auto r0_ = __builtin_amdgcn_permlane32_swap(a0_, b0_, false, false); auto r1_ = __builtin_amdgcn_permlane32_swap(a1_, b1_, false, false); \
        u32x4 w_ = {r0_[0], r1_[0], r0_[1], r1_[1]}; OUT = *reinterpret_cast<bf16x8*>(&w_); } while (0)
            PK4(p0, 0, pa0); PK4(p0, 8, pa1); PK4(p1, 0, pa2); PK4(p1, 8, pa3);
#undef PK4
            if (__any(alpha < 1.f)) {
                if (hi == 0) al_l[r32] = alpha;
                asm volatile("s_waitcnt lgkmcnt(0)" ::: "memory");
#pragma unroll
                for (int d = 0; d < 2; ++d)
#pragma unroll
                    for (int r = 0; r < 16; ++r) o[d][r] *= al_l[crow(r, hi)];
            }
            {
                const int vb = vb0 + jt * SHM_V;
#define TRRD(dst, off) asm volatile("ds_read_b64_tr_b16 %0, %1 offset:%2" : "=&v"(dst) : "v"(vb), "i"(off) : "memory")
#define PV_D0(d0) do { s16x4 l0, l1, l2, l3, h0, h1, h2, h3; constexpr int b_ = (d0) * 512; \
        TRRD(l0, b_); TRRD(h0, b_ + 2048); TRRD(l1, b_ + 4096); TRRD(h1, b_ + 6144); TRRD(l2, b_ + 8192); TRRD(h2, b_ + 10240); TRRD(l3, b_ + 12288); TRRD(h3, b_ + 14336); \
        asm volatile("s_waitcnt lgkmcnt(0)" ::: "memory"); __builtin_amdgcn_sched_barrier(0); \
        o[d0] = __builtin_amdgcn_mfma_f32_32x32x16_bf16(pa0, (bf16x8){l0[0], l0[1], l0[2], l0[3], h0[0], h0[1], h0[2], h0[3]}, o[d0], 0, 0, 0); \
        o[d0] = __builtin_amdgcn_mfma_f32_32x32x16_bf16(pa1, (bf16x8){l1[0], l1[1], l1[2], l1[3], h1[0], h1[1], h1[2], h1[3]}, o[d0], 0, 0, 0); \
        o[d0] = __builtin_amdgcn_mfma_f32_32x32x16_bf16(pa2, (bf16x8){l2[0], l2[1], l2[2], l2[3], h2[0], h2[1], h2[2], h2[3]}, o[d0], 0, 0, 0); \
        o[d0] = __builtin_amdgcn_mfma_f32_32x32x16_bf16(pa3, (bf16x8){l3[0], l3[1], l3[2], l3[3], h3[0], h3[1], h3[2], h3[3]}, o[d0], 0, 0, 0); } while (0)
                PV_D0(0); PV_D0(1);
#undef PV_D0
#undef TRRD
            }
        }
        const float mf = fmaxf(m_reg, sinkL), al = __builtin_amdgcn_exp2f(m_reg - mf);
        const float lf = l_reg * al + __builtin_amdgcn_exp2f(sinkL - mf);
        if (hi == 0) li_l[r32] = al / lf;
        asm volatile("s_waitcnt lgkmcnt(0)" ::: "memory");
        int tz = lane; asm volatile("" : "+v"(tz));
        const int hz = tz >> 5, rz = tz & 31;
        bf16* Ow = Ob + (size_t)(q0 + rg * 32) * 2048 + qh * 64;
#pragma unroll
        for (int r = 0; r < 16; ++r) {
            const int orow = crow(r, hz);
            const float rl = li_l[orow];
            const unsigned obase = (unsigned)(orow * 2048 + rz);
#pragma unroll
            for (int d0 = 0; d0 < 2; ++d0) {
                const float v = o[d0][r] * rl;
                const float vn = __shfl_xor(v, 1);
                if ((rz & 1) == 0) *(unsigned*)(Ow + obase + d0 * 32) = cvtpk(v, vn);
            }
        }
        asm volatile("s_waitcnt lgkmcnt(0)" ::: "memory");
    }
    __syncthreads();
}

struct Args { const float* in[19]; float* out; unsigned char* ws; int ph_lo, ph_hi; };
enum { I_X = 0, I_WR, I_RB, I_EWIN, I_EQN, I_EWQ, I_EKVN, I_EWKV, I_EFB, I_EWOUT, I_OWIN, I_OSINK, I_OWOUT, I_LMG, I_LMB, I_LFG, I_LFB, I_WGU, I_WDN };
enum { PH_CVT = 0, PH_L0_IN, PH_L0_PREP, PH_L0_UP, PH_L0_ATT, PH_L0_OUT, PH_L0_LN1, PH_L0_MOE1, PH_L0_MOE2, PH_L0_LN2,
       PH_L1_IN, PH_L1_KM, PH_L1_ATT, PH_L1_OUT, PH_L1_LN1, PH_L1_MOE1, PH_L1_MOE2, PH_L1_LN2, NPH };

DEVI void ln_row(const float* hrow, float a, const float* y0, const float* y1, const float* g, const float* bta, int lane, f32x4 (&v)[8]) {
    float s = 0.f;
#pragma unroll
    for (int j = 0; j < 8; ++j) {
        f32x4 x = *(const f32x4*)(hrow + 4 * lane + 256 * j) * a;
        if (y0) x += *(const f32x4*)(y0 + 4 * lane + 256 * j);
        if (y1) x += *(const f32x4*)(y1 + 4 * lane + 256 * j);
        v[j] = x; s += (x[0] + x[1]) + (x[2] + x[3]);
    }
    const float mean = wave_sum(s) * (1.f / DM);
    float s2 = 0.f;
#pragma unroll
    for (int j = 0; j < 8; ++j) { v[j] = v[j] - mean; s2 += (v[j][0] * v[j][0] + v[j][1] * v[j][1]) + (v[j][2] * v[j][2] + v[j][3] * v[j][3]); }
    const float rstd = 1.f / sqrtf(wave_sum(s2) * (1.f / DM) + LN_EPS);
#pragma unroll
    for (int j = 0; j < 8; ++j) v[j] = v[j] * rstd * *(const f32x4*)(g + 4 * lane + 256 * j) + *(const f32x4*)(bta + 4 * lane + 256 * j);
}

DEVI void route_select(unsigned* ctl, int* list, float* ew, const float* rb, int layer, int t, float lg, int lane) {
    const float affl = 1.f / (1.f + __expf(-lg));
    const float sell = affl + rb[lane & 31];
    int best = 0; float bests = -__builtin_inff();
#pragma unroll
    for (int gI = 0; gI < 8; ++gI) {
        float m1 = -__builtin_inff(), m2 = -__builtin_inff();
#pragma unroll
        for (int q = 0; q < 4; ++q) { const float x = __shfl(sell, gI * 4 + q); if (x > m1) { m2 = m1; m1 = x; } else if (x > m2) m2 = x; }
        const float sc = m1 + m2;
        if (sc > bests) { bests = sc; best = gI; }
    }
    int e1 = 0, e2 = 0; float s1 = -__builtin_inff(), s2 = -__builtin_inff(), a1 = 0.f, a2 = 0.f;
#pragma unroll
    for (int q = 0; q < 4; ++q) {
        const float af = __shfl(affl, best * 4 + q), x = __shfl(sell, best * 4 + q);
        if (x > s1) { s2 = s1; e2 = e1; a2 = a1; s1 = x; e1 = best * 4 + q; a1 = af; } else if (x > s2) { s2 = x; e2 = best * 4 + q; a2 = af; }
    }
    if (lane == 0) {
        const float inv = 1.f / (a1 + a2);
        ew[t * 2 + 0] = a1 * inv; ew[t * 2 + 1] = a2 * inv;
        const unsigned p1 = atomicAdd(&ctl[CW_CNT + layer * NEXP + e1], 1u); list[e1 * T + p1] = t * 2 + 0;
        const unsigned p2 = atomicAdd(&ctl[CW_CNT + layer * NEXP + e2], 1u); list[e2 * T + p2] = t * 2 + 1;
    }
}
DEVI void phase_ln1_route(const Args& a, float* xrow, int layer, const float* pre, float* hf, bf16* hb, int gw, int ngw, int lane) {
    unsigned* ctl = (unsigned*)(a.ws + WS_CTL);
    int* list = (int*)(a.ws + WS_LIST) + layer * NEXP * T;
    float* ew = (float*)(a.ws + WS_EW);
    const float* g = a.in[I_LMG] + layer * DM; const float* bta = a.in[I_LMB] + layer * DM;
    const float* wr = a.in[I_WR]; const float* rb = a.in[I_RB];
    for (int t0 = gw; t0 < T; t0 += 2 * ngw) {
        const int t1 = t0 + ngw; const bool has1 = t1 < T;
#pragma unroll
        for (int k = 0; k < 2; ++k) {
            const int t = k == 0 ? t0 : t1;
            if (k == 1 && !has1) break;
            f32x4 v[8];
            ln_row(pre + (size_t)t * DM, 1.f, nullptr, nullptr, g, bta, lane, v);
#pragma unroll
            for (int j = 0; j < 8; ++j) {
                *(f32x4*)(hf + (size_t)t * DM + 4 * lane + 256 * j) = v[j];
                uint2 w; w.x = pk2(v[j][0], v[j][1]); w.y = pk2(v[j][2], v[j][3]);
                *(uint2*)(hb + (size_t)t * DM + 4 * lane + 256 * j) = w;
                *(f32x4*)(xrow + k * 2048 + 4 * lane + 256 * j) = v[j];
            }
        }
        __builtin_amdgcn_s_waitcnt(0); __builtin_amdgcn_wave_barrier();
        f32x4 accA = {0.f, 0.f, 0.f, 0.f}, accB = {0.f, 0.f, 0.f, 0.f};
        {
            const int e4 = lane & 7, isub = lane >> 3;
            const float* wp = wr + (size_t)isub * NEXP + 4 * e4;
            const float* xa = xrow + isub; const float* xb = xrow + 2048 + isub;
#pragma unroll 16
            for (int ii = 0; ii < 256; ++ii) {
                const f32x4 w4 = *(const f32x4*)(wp + (size_t)ii * 8 * NEXP);
                accA += w4 * xa[ii * 8]; accB += w4 * xb[ii * 8];
            }
        }
#pragma unroll
        for (int q = 0; q < 4; ++q) {
            accA[q] += __shfl_xor(accA[q], 8); accA[q] += __shfl_xor(accA[q], 16); accA[q] += __shfl_xor(accA[q], 32);
            accB[q] += __shfl_xor(accB[q], 8); accB[q] += __shfl_xor(accB[q], 16); accB[q] += __shfl_xor(accB[q], 32);
        }
        const int src = (lane & 31) >> 2, cq = lane & 3;
        float lA, lB;
        { const float v0 = __shfl(accA[0], src), v1 = __shfl(accA[1], src), v2 = __shfl(accA[2], src), v3 = __shfl(accA[3], src); lA = cq == 0 ? v0 : cq == 1 ? v1 : cq == 2 ? v2 : v3; }
        { const float v0 = __shfl(accB[0], src), v1 = __shfl(accB[1], src), v2 = __shfl(accB[2], src), v3 = __shfl(accB[3], src); lB = cq == 0 ? v0 : cq == 1 ? v1 : cq == 2 ? v2 : v3; }
        route_select(ctl, list, ew, rb, layer, t0, lA, lane);
        if (has1) route_select(ctl, list, ew, rb, layer, t1, lB, lane);
        __builtin_amdgcn_wave_barrier();
    }
}

DEVI void phase_moe(const Args& a, char* lds, int layer, int stage, const bf16* hb, int bid, int nb) {
    unsigned* ctl = (unsigned*)(a.ws + WS_CTL);
    const int* list = (const int*)(a.ws + WS_LIST) + layer * NEXP * T;
    const float* ew = (const float*)(a.ws + WS_EW);
    bf16* hdn = (bf16*)(a.ws + WS_HDN);
    float* Y = (float*)(a.ws + WS_Y);
    int* sh = (int*)(lds + 131072 + 1024);
    const int ntn = stage == 1 ? 4 : 8;
    if (threadIdx.x == 0) {
        int so = 0, to = 0;
        for (int e = 0; e < NEXP; ++e) { const int c = (int)ctl[CW_CNT + layer * NEXP + e]; sh[e] = so; sh[33 + e] = to; so += c; to += ((c + 255) / 256) * ntn; }
        sh[32] = so; sh[33 + 32] = to;
    }
    __syncthreads();
    g8::MoeOrder S_;
    S_.sh = (const LAS int*)sh; S_.list = list; S_.G = nb; S_.c = bid; S_.stage = stage; S_.ntn = ntn;
    if (stage == 1) {
        S_.A = (const char*)hb; S_.lda = DM; S_.K = DM; S_.W = (const char*)(a.ws + WS_WGU) + (size_t)layer * NEXP * 1024 * DM * 2; S_.wstride = (size_t)1024 * DM * 2;
        g8::EpiMoe1 E_{hdn};
        g8::gemm8((LAS unsigned char*)lds, DM, S_, E_);
    } else {
        S_.A = (const char*)hdn; S_.lda = FF; S_.K = FF; S_.W = (const char*)(a.ws + WS_WDN) + (size_t)layer * NEXP * DM * FF * 2; S_.wstride = (size_t)DM * FF * 2;
        g8::EpiMoe2 E_{Y, list, ew};
        g8::gemm8((LAS unsigned char*)lds, FF, S_, E_);
    }
    __syncthreads();
}

DEVI void phase_ln2(const Args& a, int layer, const float* hf, float* of, bf16* ob, int gw, int ngw, int lane) {
    const float* Y = (const float*)(a.ws + WS_Y);
    const float* g = a.in[I_LFG] + layer * DM; const float* bta = a.in[I_LFB] + layer * DM;
    for (int t = gw; t < T; t += ngw) {
        f32x4 v[8];
        ln_row(hf + (size_t)t * DM, ALPHA, Y + (size_t)(2 * t) * DM, Y + (size_t)(2 * t + 1) * DM, g, bta, lane, v);
#pragma unroll
        for (int j = 0; j < 8; ++j) {
            *(f32x4*)(of + (size_t)t * DM + 4 * lane + 256 * j) = v[j];
            if (ob) { uint2 w; w.x = pk2(v[j][0], v[j][1]); w.y = pk2(v[j][2], v[j][3]); *(uint2*)(ob + (size_t)t * DM + 4 * lane + 256 * j) = w; }
        }
    }
}

__global__ void __launch_bounds__(NTHREADS, 2) fwd(Args a) {
    extern __shared__ __attribute__((aligned(16))) char lds[];
    const int tid = threadIdx.x, lane = tid & 63, wid = tid >> 6;
    const int bid = blockIdx.x, nb = gridDim.x;
    const int gw = bid * NWAVES + wid, ngw = nb * NWAVES;
    unsigned char* ws = a.ws;
    unsigned* ctl = (unsigned*)(ws + WS_CTL);
    float* FL = (float*)(ws + WS_FL); float* LF = (float*)(ws + WS_LF); float* CUM = (float*)(ws + WS_CUM); float* KM = (float*)(ws + WS_KM);
    bf16* KPE = (bf16*)(ws + WS_KPE); bf16* XB = (bf16*)(ws + WS_XB); bf16* HB = (bf16*)(ws + WS_HB);
    float* HFA = (float*)(ws + WS_HFA); float* HFB = (float*)(ws + WS_HFB); float* PRE = (float*)(ws + WS_PRE);
    bf16* P = (bf16*)(ws + WS_P); bf16* CQN = (bf16*)(ws + WS_CQN); bf16* CKVN = (bf16*)(ws + WS_CKVN);
    bf16* QM = (bf16*)(ws + WS_QM); bf16* KVM = (bf16*)(ws + WS_KVM); bf16* AO = (bf16*)(ws + WS_AO);

    volatile LAS unsigned* xbw = (volatile LAS unsigned*)((LAS char*)lds + LDS_BYTES - 16);
    if (tid < 4) xbw[tid] = 0u;
    __syncthreads();
    XcdBarrier bar; bar.bar = ctl + CW_BAR; bar.x = 0; bar.st = xbw;
#if ONE_LAUNCH
    bar = xcd_barrier_post(ctl + CW_BAR, xbw);
#define SEAM(k) do { if ((k) + 1 < a.ph_hi) xcd_barrier(bar); } while (0)
#else
#define SEAM(k) do { } while (0)
#endif
#define IN(k) (a.ph_lo <= (k) && (k) < a.ph_hi)

    if (IN(PH_CVT)) { for (int rep_ = 0; rep_ < REPS(PH_CVT); ++rep_) {
        const float* x = a.in[I_X];
        for (size_t i = (size_t)bid * NTHREADS + tid; i < (size_t)T * DM / 8; i += (size_t)nb * NTHREADS) {
            const f32x4 v0 = *(const f32x4*)(x + i * 8), v1 = *(const f32x4*)(x + i * 8 + 4);
            u32x4 w; w[0] = pk2(v0[0], v0[1]); w[1] = pk2(v0[2], v0[3]); w[2] = pk2(v1[0], v1[1]); w[3] = pk2(v1[2], v1[3]);
            *(u32x4*)(XB + i * 8) = w;
        }
        {
            LAS float* scr = (LAS float*)((LAS char*)lds + wid * 17408);
            int base = 0;
            auto ident = [](int n0) { return n0; };
            cvt_matrix(a.in[I_EWIN], DM, EVEN_IN, 4096, (bf16*)(ws + WS_WIN0), [](int n0) { return n0 < EVEN_IN ? n0 : -1; }, scr, gw, ngw, lane, base);
            cvt_matrix(a.in[I_EWQ], 512, 1536, 1536, (bf16*)(ws + WS_WQU), ident, scr, gw, ngw, lane, base);
            cvt_matrix(a.in[I_EWKV], 256, 2048, 2048, (bf16*)(ws + WS_WKVU), ident, scr, gw, ngw, lane, base);
            cvt_matrix(a.in[I_EWOUT], DM, DM, DM, (bf16*)(ws + WS_WOUT0), ident, scr, gw, ngw, lane, base);
            cvt_matrix(a.in[I_OWIN], DM, ODD_IN, ODD_IN, (bf16*)(ws + WS_WIN1), ident, scr, gw, ngw, lane, base);
            cvt_matrix(a.in[I_OWOUT], DM, DM, DM, (bf16*)(ws + WS_WOUT1), ident, scr, gw, ngw, lane, base);
            for (int le = 0; le < 2 * NEXP; ++le)
                cvt_matrix(a.in[I_WGU] + (size_t)le * DM * 1024, DM, 1024, 1024, (bf16*)(ws + WS_WGU) + (size_t)le * 1024 * DM,
                           [](int n0) { return ((n0 >> 7) & 1) * 512 + (n0 >> 8) * 128 + (n0 & 127); }, scr, gw, ngw, lane, base);
            for (int le = 0; le < 2 * NEXP; ++le)
                cvt_matrix(a.in[I_WDN] + (size_t)le * FF * DM, FF, DM, DM, (bf16*)(ws + WS_WDN) + (size_t)le * DM * FF, ident, scr, gw, ngw, lane, base);
        }
        }
        SEAM(PH_CVT);
    }
    if (IN(PH_L0_IN)) { for (int rep_ = 0; rep_ < REPS(PH_L0_IN); ++rep_) {
        { g8::DenseOrder S_; S_.init(XB, DM, (const bf16*)(ws + WS_WIN0), T, 4096, DM, nb, bid); g8::EpiBf16 E_{P, LDP, EVEN_IN, FL, E_FL}; g8::gemm8((LAS unsigned char*)lds, DM, S_, E_); }
        }
        SEAM(PH_L0_IN);
    }
    if (IN(PH_L0_PREP)) { for (int rep_ = 0; rep_ < REPS(PH_L0_PREP); ++rep_) {
        const float* qn = a.in[I_EQN]; const float* kvn = a.in[I_EKVN]; const float* fb = a.in[I_EFB];
        for (int t = gw; t < T; t += ngw) {
            const bf16* pr = P + (size_t)t * LDP;
            {
                const u32x4 w = *(const u32x4*)(pr + E_CQ + lane * 8);
                float x[8] = {bflo(w[0]), bfhi(w[0]), bflo(w[1]), bfhi(w[1]), bflo(w[2]), bfhi(w[2]), bflo(w[3]), bfhi(w[3])};
                float ss = 0.f;
#pragma unroll
                for (int i = 0; i < 8; ++i) ss += x[i] * x[i];
                const float r = 1.f / sqrtf(wave_sum(ss) * (1.f / 512.f) + RMS_EPS);
                u32x4 o;
#pragma unroll
                for (int i = 0; i < 4; ++i) o[i] = pk2(x[2 * i] * r * qn[lane * 8 + 2 * i], x[2 * i + 1] * r * qn[lane * 8 + 2 * i + 1]);
                *(u32x4*)(CQN + (size_t)t * 512 + lane * 8) = o;
            }
            {
                const uint2 w = *(const uint2*)(pr + E_CKV + lane * 4);
                float x[4] = {bflo(w.x), bfhi(w.x), bflo(w.y), bfhi(w.y)};
                float ss = x[0] * x[0] + x[1] * x[1] + x[2] * x[2] + x[3] * x[3];
                const float r = 1.f / sqrtf(wave_sum(ss) * (1.f / 256.f) + RMS_EPS);
                uint2 o; o.x = pk2(x[0] * r * kvn[lane * 4], x[1] * r * kvn[lane * 4 + 1]); o.y = pk2(x[2] * r * kvn[lane * 4 + 2], x[3] * r * kvn[lane * 4 + 3]);
                *(uint2*)(CKVN + (size_t)t * 256 + lane * 4) = o;
            }
            if (lane < 32) {
                const float t1 = bf2f(pr[E_KR + lane]), t2 = bf2f(pr[E_KR + 32 + lane]);
                float c, s; rope_cs(t % S, lane, c, s);
                KPE[(size_t)t * 64 + lane] = (bf16)f2bf(t1 * c - t2 * s);
                KPE[(size_t)t * 64 + 32 + lane] = (bf16)f2bf(t1 * s + t2 * c);
            }
            if (lane < 8) {
                const float x = FL[t * 8 + lane] + fb[lane];
                LF[t * 8 + lane] = fminf(x, 0.f) - log1pf(__expf(-fabsf(x)));
            }
        }
        }
        SEAM(PH_L0_PREP);
    }
    if (IN(PH_L0_UP)) { for (int rep_ = 0; rep_ < REPS(PH_L0_UP); ++rep_) {
        if (gw < 16) {
            const int b = gw >> 3, h = gw & 7;
            double loc = 0.0;
            for (int i = 0; i < 64; ++i) loc += (double)LF[(size_t)(b * S + lane * 64 + i) * 8 + h];
            double inc = loc;
#pragma unroll
            for (int o = 1; o < 64; o <<= 1) { const double nbv = __shfl_up(inc, o); if (lane >= o) inc += nbv; }
            double run = inc - loc;
            for (int i = 0; i < 64; ++i) { run += (double)LF[(size_t)(b * S + lane * 64 + i) * 8 + h]; CUM[(size_t)gw * S + lane * 64 + i] = (float)run; }
        }
        const int n1 = (T / 128) * (1536 / 128);
        { g8::DenseOrder S_; S_.init(CQN, 512, (const bf16*)(ws + WS_WQU), T, 1536, 512, nb, bid); g8::EpiBf16 E_{QM, 1536, 1536, nullptr, 0}; g8::gemm8((LAS unsigned char*)lds, 512, S_, E_); }
        { g8::DenseOrder S_; S_.init(CKVN, 256, (const bf16*)(ws + WS_WKVU), T, 2048, 256, nb, bid); g8::EpiBf16 E_{KVM, 2048, 2048, nullptr, 0}; g8::gemm8((LAS unsigned char*)lds, 256, S_, E_); }
        }
        SEAM(PH_L0_UP);
    }
    if (IN(PH_L0_ATT)) { for (int rep_ = 0; rep_ < REPS(PH_L0_ATT); ++rep_) {
        volatile unsigned* qslot = (volatile unsigned*)(lds + FA_Q);
        for (;;) {
            if (tid == 0) *qslot = atomicAdd(&ctl[CW_Q + 0 + 8 * rep_], 1u);
            __syncthreads();
            const int item = __builtin_amdgcn_readfirstlane((int)*qslot);
            __syncthreads();
            if (item >= 256) break;
            const int qb = 15 - (item >> 4), bh = item & 15, b = bh >> 3, h = bh & 7;
            flash_unit<FM_MLA>(lds, QM + (size_t)b * S * 1536 + h * 192, 1536, KVM + (size_t)b * S * 2048 + h * 256, 2048, KVM + (size_t)b * S * 2048 + h * 256 + 128, 2048,
                               KPE + (size_t)b * S * 64, nullptr, nullptr, 0.f, qb * 256, AO + (size_t)b * S * 2048 + h * 128, 2048);
        }
        for (;;) {
            if (tid == 0) *qslot = atomicAdd(&ctl[CW_Q + 1 + 8 * rep_], 1u);
            __syncthreads();
            const int item = __builtin_amdgcn_readfirstlane((int)*qslot);
            __syncthreads();
            if (item >= 256) break;
            const int qb = 15 - (item >> 4), bh = item & 15, b = bh >> 3, h = bh & 7;
            flash_unit<FM_FOX>(lds, P + (size_t)b * S * LDP + E_FQ + h * 128, LDP, P + (size_t)b * S * LDP + E_FK + h * 128, LDP, P + (size_t)b * S * LDP + E_FV + h * 128, LDP,
                               nullptr, CUM + (size_t)bh * S, nullptr, 0.f, qb * 256, AO + (size_t)b * S * 2048 + 1024 + h * 128, 2048);
        }
        }
        SEAM(PH_L0_ATT);
    }
    if (IN(PH_L0_OUT)) { for (int rep_ = 0; rep_ < REPS(PH_L0_OUT); ++rep_) {
        const float* x = a.in[I_X];
        { g8::DenseOrder S_; S_.init(AO, DM, (const bf16*)(ws + WS_WOUT0), T, DM, DM, nb, bid); g8::EpiRes E_{PRE, x, DM, ALPHA}; g8::gemm8((LAS unsigned char*)lds, DM, S_, E_); }
        }
        SEAM(PH_L0_OUT);
    }
    if (IN(PH_L0_LN1)) { phase_ln1_route(a, (float*)lds + wid * 4096, 0, PRE, HFA, HB, gw, ngw, lane); SEAM(PH_L0_LN1); }
    if (IN(PH_L0_MOE1)) { for (int rep_ = 0; rep_ < REPS(PH_L0_MOE1); ++rep_) phase_moe(a, lds, 0, 1, HB, bid, nb); SEAM(PH_L0_MOE1); }
    if (IN(PH_L0_MOE2)) { for (int rep_ = 0; rep_ < REPS(PH_L0_MOE2); ++rep_) phase_moe(a, lds, 0, 2, HB, bid, nb); SEAM(PH_L0_MOE2); }
    if (IN(PH_L0_LN2)) { for (int rep_ = 0; rep_ < REPS(PH_L0_LN2); ++rep_) phase_ln2(a, 0, HFA, HFB, XB, gw, ngw, lane); SEAM(PH_L0_LN2); }

    if (IN(PH_L1_IN)) {
        { g8::DenseOrder S_; S_.init(XB, DM, (const bf16*)(ws + WS_WIN1), T, ODD_IN, DM, nb, bid); g8::EpiBf16 E_{P, LDP, ODD_IN, nullptr, 0}; g8::gemm8((LAS unsigned char*)lds, DM, S_, E_); }
        SEAM(PH_L1_IN);
    }
    if (IN(PH_L1_KM)) { for (int rep_ = 0; rep_ < REPS(PH_L1_KM); ++rep_) {
        for (int it = gw; it < 2 * 8 * 16; it += ngw) {
            const int b = it >> 7, h = (it >> 4) & 7, n = it & 15;
            float s0 = 0.f, s1 = 0.f;
            for (int j = 0; j < 256; ++j) { const unsigned w = *(const unsigned*)(P + ((size_t)b * S + n * 256 + j) * LDP + O_MK + h * 128 + lane * 2); s0 += bflo(w); s1 += bfhi(w); }
            KM[(size_t)it * 128 + lane * 2] = s0 * (1.f / 256.f); KM[(size_t)it * 128 + lane * 2 + 1] = s1 * (1.f / 256.f);
        }
        }
        SEAM(PH_L1_KM);
    }
    if (IN(PH_L1_ATT)) { for (int rep_ = 0; rep_ < REPS(PH_L1_ATT); ++rep_) {
        volatile unsigned* qslot = (volatile unsigned*)(lds + FA_Q);
        const float* sinks = a.in[I_OSINK];
        for (;;) {
            if (tid == 0) *qslot = atomicAdd(&ctl[CW_Q + 2 + 8 * rep_], 1u);
            __syncthreads();
            const int item = __builtin_amdgcn_readfirstlane((int)*qslot);
            __syncthreads();
            if (item >= 256) break;
            const int qb = 15 - (item >> 4), bh = item & 15, b = bh >> 3, h = bh & 7;
            flash_unit<FM_MOBA>(lds, P + (size_t)b * S * LDP + O_MQ + h * 128, LDP, P + (size_t)b * S * LDP + O_MK + h * 128, LDP, P + (size_t)b * S * LDP + O_MV + h * 128, LDP,
                                nullptr, nullptr, KM + (size_t)bh * 16 * 128, exp2f(-(float)(h + 1)), qb * 256, AO + (size_t)b * S * 2048 + 1024 + h * 128, 2048);
        }
        for (;;) {
            if (tid == 0) *qslot = atomicAdd(&ctl[CW_Q + 3 + 8 * rep_], 1u);
            __syncthreads();
            const int item = __builtin_amdgcn_readfirstlane((int)*qslot);
            __syncthreads();
            if (item >= 256) break;
            const int qb = item & 63, bk = item >> 6, b = bk >> 1, kvh = bk & 1;
            swa_unit(lds, P + (size_t)b * S * LDP, kvh, qb * 64, sinks, AO + (size_t)b * S * 2048);
        }
        }
        SEAM(PH_L1_ATT);
    }
    if (IN(PH_L1_OUT)) {
        { g8::DenseOrder S_; S_.init(AO, DM, (const bf16*)(ws + WS_WOUT1), T, DM, DM, nb, bid); g8::EpiRes E_{PRE, HFB, DM, ALPHA}; g8::gemm8((LAS unsigned char*)lds, DM, S_, E_); }
        SEAM(PH_L1_OUT);
    }
    if (IN(PH_L1_LN1)) { phase_ln1_route(a, (float*)lds + wid * 4096, 1, PRE, HFA, HB, gw, ngw, lane); SEAM(PH_L1_LN1); }
    if (IN(PH_L1_MOE1)) { phase_moe(a, lds, 1, 1, HB, bid, nb); SEAM(PH_L1_MOE1); }
    if (IN(PH_L1_MOE2)) { phase_moe(a, lds, 1, 2, HB, bid, nb); SEAM(PH_L1_MOE2); }
    if (IN(PH_L1_LN2)) { phase_ln2(a, 1, HFA, a.out, nullptr, gw, ngw, lane); }
#undef IN
#undef SEAM
}

extern "C" void kernel_launch(void* const* d_in, const int* in_sizes, int n_in, void* d_out, int out_size, void* d_ws, size_t ws_size, hipStream_t stream) {
    static int grid = 0;
    if (grid == 0) {
        if (n_in != 19 || out_size != T * DM || ws_size < WS_END) { fprintf(stderr, "kernel_launch: unexpected shapes (n_in %d out %d ws %zu)\n", n_in, out_size, ws_size); grid = -1; return; }
        int dev = 0, cus = 0;
        if (hipGetDevice(&dev) != hipSuccess || hipDeviceGetAttribute(&cus, hipDeviceAttributeMultiprocessorCount, dev) != hipSuccess || cus <= 0) cus = 256;
        (void)hipFuncSetAttribute((const void*)fwd, hipFuncAttributeMaxDynamicSharedMemorySize, LDS_BYTES);
        int per_cu = 0;
        if (hipOccupancyMaxActiveBlocksPerMultiprocessor(&per_cu, (const void*)fwd, NTHREADS, LDS_BYTES) != hipSuccess || per_cu < 1) fprintf(stderr, "kernel_launch: occupancy query says %d\n", per_cu);
        (void)hipGetLastError();
        grid = cus;
    }
    if (grid < 0) return;
    (void)in_sizes;
    (void)hipMemsetAsync((char*)d_ws + WS_CTL, 0, CTL_BYTES, stream);
    Args a{};
    for (int i = 0; i < 19; ++i) a.in[i] = (const float*)d_in[i];
    a.out = (float*)d_out; a.ws = (unsigned char*)d_ws;
#if ONE_LAUNCH
    a.ph_lo = 0; a.ph_hi = NPH;
    hipLaunchKernelGGL(fwd, dim3(grid), dim3(NTHREADS), LDS_BYTES, stream, a);
#if PROBE_PH >= 0
    (void)hipMemsetAsync((char*)d_ws + WS_CTL + CW_Q * 4, 0, 256, stream);
    (void)hipMemsetAsync((char*)d_ws + WS_CTL + CW_BAR * 4, 0, XCD_BAR_WORDS * 4, stream);
    a.ph_lo = PROBE_PH; a.ph_hi = PROBE_PH + 1;
    hipLaunchKernelGGL(fwd, dim3(grid), dim3(NTHREADS), LDS_BYTES, stream, a);
#endif
#else
    for (int p = 0; p < NPH; ++p) { a.ph_lo = p; a.ph_hi = p + 1; hipLaunchKernelGGL(fwd, dim3(grid), dim3(NTHREADS), LDS_BYTES, stream, a); }
#endif
}
```

```cpp
#include <hip/hip_runtime.h>
#include <stdint.h>
#include <stdio.h>

#ifndef PROBE_REP
#define PROBE_REP -1
#endif
#define REPS(k) ((PROBE_REP) == (k) ? 2 : 1)
#ifndef PROBE_PH
#define PROBE_PH -1
#endif
#ifndef ONE_LAUNCH
#define ONE_LAUNCH 1
#endif

#define DEVI __device__ __forceinline__
#define LAS __attribute__((address_space(3)))
typedef unsigned short bf16;
typedef short bf16x8 __attribute__((ext_vector_type(8)));
typedef float f32x4 __attribute__((ext_vector_type(4)));
typedef unsigned u32x4 __attribute__((ext_vector_type(4)));

constexpr int S = 4096, NBATCH = 2, T = NBATCH * S, DM = 2048;
constexpr int LDP = 4352;
constexpr int EVEN_IN = 3912, ODD_IN = 4352;
constexpr float LN_EPS = 1e-5f, RMS_EPS = 1e-6f;
constexpr float ALPHA = 1.4142135623730951f;
constexpr int NEXP = 32, FF = 512;
constexpr int E_CQ = 0, E_CKV = 512, E_KR = 768, E_FQ = 832, E_FK = 1856, E_FV = 2880, E_FL = 3904;
constexpr int O_SQ = 0, O_SK = 1024, O_SV = 1152, O_MQ = 1280, O_MK = 2304, O_MV = 3328;

constexpr size_t MiB = 1u << 20;
constexpr size_t WS_CTL = 0, CTL_BYTES = 1 * MiB;
constexpr int CW_CNT = 1024;
constexpr int CW_BAR = 4096;
constexpr int CW_NRM = 1200;
constexpr int CW_Q = 1100;
constexpr size_t WS_LIST = 2 * MiB;
constexpr size_t WS_EW = 4 * MiB;
constexpr size_t WS_FL = 5 * MiB;
constexpr size_t WS_LF = 5 * MiB + 512 * 1024;
constexpr size_t WS_CUM = 6 * MiB;
constexpr size_t WS_KM = 512 * 1024;
constexpr size_t WS_KPE = 7 * MiB;
constexpr size_t WS_XB = 16 * MiB;
constexpr size_t WS_HB = 48 * MiB;
constexpr size_t WS_HFA = 80 * MiB;
constexpr size_t WS_HFB = 144 * MiB;
constexpr size_t WS_PRE = 208 * MiB;
constexpr size_t WS_P = 272 * MiB;
constexpr size_t WS_CQN = 340 * MiB;
constexpr size_t WS_CKVN = 348 * MiB;
constexpr size_t WS_QM = 352 * MiB;
constexpr size_t WS_KVM = 376 * MiB;
constexpr size_t WS_AO = 408 * MiB;
constexpr size_t WS_HDN = 440 * MiB;
constexpr size_t WS_Y = 464 * MiB;
constexpr size_t WS_WIN0 = 600 * MiB;
constexpr size_t WS_WQU = 616 * MiB;
constexpr size_t WS_WKVU = 618 * MiB;
constexpr size_t WS_WOUT0 = 620 * MiB;
constexpr size_t WS_WIN1 = 628 * MiB;
constexpr size_t WS_WOUT1 = 646 * MiB;
constexpr size_t WS_WGU = 656 * MiB;
constexpr size_t WS_WDN = 912 * MiB;
constexpr size_t WS_END = 1040 * MiB;

constexpr int LDS_BYTES = 147456;
constexpr int NTHREADS = 512, NWAVES = 8;

DEVI unsigned f2bf(float f) { unsigned u = __float_as_uint(f); return (u + 0x7fffu + ((u >> 16) & 1u)) >> 16; }
DEVI float bf2f(unsigned b) { return __uint_as_float(b << 16); }
DEVI float bflo(unsigned w) { return __uint_as_float(w << 16); }
DEVI float bfhi(unsigned w) { return __uint_as_float(w & 0xffff0000u); }
DEVI unsigned pk2(float lo, float hi) { return f2bf(lo) | (f2bf(hi) << 16); }
DEVI float wave_sum(float v) {
#pragma unroll
    for (int o = 1; o < 64; o <<= 1) v += __shfl_xor(v, o);
    return v;
}
DEVI float wave_max(float v) {
#pragma unroll
    for (int o = 1; o < 64; o <<= 1) v = fmaxf(v, __shfl_xor(v, o));
    return v;
}
DEVI void rope_cs(int t, int i, float& c, float& s) {
    const float inv_freq = exp2f(-(float)i * (13.287712379549449f / 32.0f));
    double rev = (double)t * (double)inv_freq * 0.15915494309189535;
    rev -= floor(rev);
    const float a = (float)(rev * 6.283185307179586);
    c = __cosf(a); s = __sinf(a);
}

#define XB_TMO      128
#define XB_XCNT(j)  (256  + 64 * (j))
#define XB_XSUB(j)  (1280 + 64 * (j))
#define XB_XGEN(j)  (2304 + 64 * (j))
#define XB_TOP      3328
#define XB_TOPGEN   3392
#define XCD_BAR_WORDS 3456
#define XB_SPIN_CAP (1u << 18)
DEVI unsigned xb_ld(unsigned* p)              { return __hip_atomic_load(p, __ATOMIC_RELAXED, __HIP_MEMORY_SCOPE_AGENT); }
DEVI unsigned xb_add(unsigned* p, unsigned v) { return __hip_atomic_fetch_add(p, v, __ATOMIC_RELAXED, __HIP_MEMORY_SCOPE_AGENT); }
DEVI unsigned xb_xcc_id() { return (unsigned)__builtin_amdgcn_s_getreg((3 << 11) | 20) & 0xFu; }
#define XB_SPIN(cond, bar) do { unsigned _sp = 0; while (cond) { __builtin_amdgcn_s_sleep(1); \
    if ((++_sp & 255u) == 0u) { if (xb_ld(&(bar)[XB_TMO])) break; if (_sp > XB_SPIN_CAP) { atomicAdd(&(bar)[XB_TMO], 1u); break; } } } } while (0)
struct XcdBarrier { unsigned* bar; unsigned x; volatile LAS unsigned* st; };
DEVI XcdBarrier xcd_barrier_post(unsigned* bar, volatile LAS unsigned* st) {
    XcdBarrier b; b.bar = bar; b.x = xb_xcc_id(); b.st = st;
    if (threadIdx.x == 0) (void)xb_add(&bar[XB_XCNT(b.x)], 1u);
    return b;
}
DEVI void xcd_barrier_complete(unsigned* bar, unsigned x, unsigned& nloc, unsigned& nx) {
    const unsigned G = gridDim.x * gridDim.y * gridDim.z;
    unsigned sum, cnt, mine, sp = 0u;
    for (;;) {
        sum = 0u; cnt = 0u; mine = 0u;
#pragma unroll
        for (unsigned j = 0; j < 16; ++j) { const unsigned c = xb_ld(&bar[XB_XCNT(j)]); sum += c; cnt += (c > 0u) ? 1u : 0u; mine = (j == x) ? c : mine; }
        if (sum == G) break;
        __builtin_amdgcn_s_sleep(1);
        if ((++sp & 255u) == 0u) { if (xb_ld(&bar[XB_TMO])) break; if (sp > XB_SPIN_CAP) { atomicAdd(&bar[XB_TMO], 1u); break; } }
    }
    nloc = mine > 0u ? mine : 1u; nx = cnt > 0u ? cnt : 1u;
}
DEVI void xcd_barrier(const XcdBarrier& b) {
    asm volatile("s_waitcnt vmcnt(0)" ::: "memory");
    __syncthreads();
    if (threadIdx.x == 0) {
        unsigned* bar = b.bar;
        __builtin_amdgcn_s_waitcnt(0);
        unsigned nloc = b.st[0], nx = b.st[1];
        if (nloc == 0u) { xcd_barrier_complete(bar, b.x, nloc, nx); b.st[0] = nloc; b.st[1] = nx; }
        const unsigned old = xb_add(&bar[XB_XSUB(b.x)], 1u);
        const unsigned gen = old / nloc;
        if (old + 1u == (gen + 1u) * nloc) {
            __builtin_amdgcn_fence(__ATOMIC_RELEASE, "agent");
            asm volatile("s_waitcnt vmcnt(0)" ::: "memory");
            const unsigned og = xb_add(&bar[XB_TOP], 1u);
            const unsigned tg = og / nx;
            if (og + 1u == (tg + 1u) * nx) xb_add(&bar[XB_TOPGEN], 1u);
            else XB_SPIN(xb_ld(&bar[XB_TOPGEN]) == tg, bar);
            __builtin_amdgcn_fence(__ATOMIC_ACQUIRE, "agent");
            xb_add(&bar[XB_XGEN(b.x)], 1u);
            asm volatile("s_waitcnt vmcnt(0)" ::: "memory");
        } else {
            XB_SPIN(xb_ld(&bar[XB_XGEN(b.x)]) == gen, bar);
            __builtin_amdgcn_fence(__ATOMIC_ACQUIRE, "agent");
            asm volatile("s_waitcnt vmcnt(0)" ::: "memory");
        }
    }
    __syncthreads();
}

template <class RowMap, class ColMap, class Epi>
DEVI void gemm_tile(char* lds, int K, const bf16* __restrict__ A, int lda, const float* __restrict__ W, int ldw,
                    RowMap rowmap, ColMap colmap, Epi epi) {
    bf16* sA = (bf16*)lds;
    bf16* sB = sA + 128 * 40;
    const int tid = threadIdx.x, lane = tid & 63, wid = tid >> 6, wm = wid >> 1, wn = wid & 1;
    const int ar = tid >> 2, ac = (tid & 3) * 8;
    const int src_row = rowmap(ar);
    const bf16* aptr = A + (size_t)(src_row < 0 ? 0 : src_row) * lda + ac;
    const int bk = tid >> 4, bn = (tid & 15) * 8;
    const int pcol = colmap(bn);
    const float* wptr = W + (size_t)bk * ldw + (pcol < 0 ? 0 : pcol);
    f32x4 acc[2][4];
#pragma unroll
    for (int a = 0; a < 2; ++a)
#pragma unroll
        for (int b = 0; b < 4; ++b) acc[a][b] = (f32x4){0.f, 0.f, 0.f, 0.f};
    u32x4 ra; f32x4 rb0, rb1;
    ra = (u32x4){0u, 0u, 0u, 0u}; rb0 = (f32x4){0.f, 0.f, 0.f, 0.f}; rb1 = rb0;
    if (src_row >= 0) ra = *(const u32x4*)(aptr);
    if (pcol >= 0) { rb0 = *(const f32x4*)(wptr); rb1 = *(const f32x4*)(wptr + 4); }
    for (int k0 = 0; k0 < K; k0 += 32) {
        *(u32x4*)(sA + ar * 40 + ac) = ra;
#pragma unroll
        for (int j = 0; j < 4; ++j) { sB[(bn + j) * 40 + bk] = (bf16)f2bf(rb0[j]); sB[(bn + 4 + j) * 40 + bk] = (bf16)f2bf(rb1[j]); }
        __syncthreads();
        if (k0 + 32 < K) {
            if (src_row >= 0) ra = *(const u32x4*)(aptr + k0 + 32);
            if (pcol >= 0) { rb0 = *(const f32x4*)(wptr + (size_t)(k0 + 32) * ldw); rb1 = *(const f32x4*)(wptr + (size_t)(k0 + 32) * ldw + 4); }
        }
        bf16x8 af[2], bfr[4];
#pragma unroll
        for (int mf = 0; mf < 2; ++mf) af[mf] = *(const bf16x8*)(sA + (wm * 32 + mf * 16 + (lane & 15)) * 40 + (lane >> 4) * 8);
#pragma unroll
        for (int nf = 0; nf < 4; ++nf) bfr[nf] = *(const bf16x8*)(sB + (wn * 64 + nf * 16 + (lane & 15)) * 40 + (lane >> 4) * 8);
#pragma unroll
        for (int mf = 0; mf < 2; ++mf)
#pragma unroll
            for (int nf = 0; nf < 4; ++nf) acc[mf][nf] = __builtin_amdgcn_mfma_f32_16x16x32_bf16(af[mf], bfr[nf], acc[mf][nf], 0, 0, 0);
        __syncthreads();
    }
    epi(acc, wm, wn, lane);
}
template <class F> DEVI void for_each_acc(const f32x4 (&acc)[2][4], int wm, int wn, int lane, F f) {
#pragma unroll
    for (int mf = 0; mf < 2; ++mf)
#pragma unroll
        for (int nf = 0; nf < 4; ++nf)
#pragma unroll
            for (int j = 0; j < 4; ++j) f(wm * 32 + mf * 16 + (lane >> 4) * 4 + j, wn * 64 + nf * 16 + (lane & 15), acc[mf][nf][j]);
}

template <class Store>
DEVI void gemm_dense(char* lds, int M, int N, int K, const bf16* A, int lda, const float* W, int ldw, Store store, int item0, int nitems_total, int bid, int nb) {
    const int ntn = (N + 127) / 128, ntm = M / 128, nt = ntm * ntn;
    (void)nitems_total;
    for (int it = bid; it < item0 + nt; it += nb) {
        if (it < item0) continue;
        const int t = it - item0, tm = t / ntn, tn = t % ntn;
        gemm_tile(lds, K, A, lda, W, ldw,
                  [&](int r) { return tm * 128 + r; },
                  [&](int c) { const int pc = tn * 128 + c; return pc < N ? pc : -1; },
                  [&](const f32x4 (&acc)[2][4], int wm, int wn, int lane) {
                      for_each_acc(acc, wm, wn, lane, [&](int r, int c, float v) { const int n = tn * 128 + c; if (n < N) store(tm * 128 + r, n, v); });
                  });
    }
}


namespace g8 {
constexpr int BM = 256, BK = 64, HALF = 128, HTB = HALF * BK * 2, STAGE_BYTES = 8 * HTB, NXCD = 8, WGM = 8;
DEVI int lds_byte(int r, int c) { const int st = (r >> 4) * 2 + (c >> 5), rr = r & 15, cc = c & 31, ob = rr * 64 + cc * 2; return st * 1024 + (ob ^ (((ob >> 9) & 1) << 5)); }
DEVI void stage_rc(int b, int& R, int& C) { const int st = b / 1024, sb = b % 1024, swz = sb ^ (((sb >> 9) & 1) << 5); R = (st >> 1) * 16 + swz / 64; C = (st & 1) * 32 + (swz % 64) / 2; }
struct U { int pm, pn; const char* A; const char* Bt; int x0, x1, x2, x3; };
struct DenseOrder {
    int nM, nN, nwg, G, c, lda, K; const char* A; const char* Bt;
    DEVI void init(const bf16* A_, int lda_, const bf16* Bt_, int M, int N, int K_, int G_, int c_) { nM = M / BM; nN = N / BM; nwg = nM * nN; G = G_; c = c_; lda = lda_; K = K_; A = (const char*)A_; Bt = (const char*)Bt_; }
    DEVI bool next(int i, U& u) const {
        const long L = (long)i * G + c; if (L >= nwg) return false;
        int wgid = (int)L; { const int q = nwg / NXCD, r = nwg % NXCD, xcd = wgid % NXCD, off = wgid / NXCD; wgid = (xcd < r ? xcd * (q + 1) : r * (q + 1) + (xcd - r) * q) + off; }
        const int nig = WGM * nN, gid = wgid / nig, fm = gid * WGM, gsz = (nM - fm) < WGM ? (nM - fm) : WGM;
        u.pm = fm + ((wgid % nig) % gsz); u.pn = (wgid % nig) / gsz; u.A = A; u.Bt = Bt + (size_t)u.pn * BM * K * 2; return true;
    }
    DEVI unsigned a_off(const U& u, int h, int R, int C) const { return (unsigned)((u.pm * BM + h * HALF + R) * lda + C) * 2u; }
};
template <class Sched, class Epi>
DEVI void gemm8(LAS unsigned char* lds, const int K, const Sched& S, const Epi& E) {
    const int tid = threadIdx.x, wid = __builtin_amdgcn_readfirstlane(tid >> 6), lane = tid & 63, wr = wid >> 2, wc = wid & 3, fr = lane & 15, fq = lane >> 4;
    const int nt = K / BK;
    int Rr[2], Cc[2]; unsigned vb[2];
#pragma unroll
    for (int i = 0; i < 2; ++i) { stage_rc(tid * 16 + i * 8192, Rr[i], Cc[i]); vb[i] = (unsigned)(Rr[i] * K + Cc[i]) * 2u; }
    const size_t kstep = (size_t)(BK * 2), hstepB = (size_t)HALF * K * 2;
    const unsigned ldsw = (unsigned)wid * 1024u;
    const int aoff = lds_byte(wr * 64 + fr, fq * 8), boff = lds_byte(wc * 32 + fr, fq * 8);
#define G8_SA(b, h) (((b) * 2 + (h)) * HTB)
#define G8_SB(b, h) ((4 + (b) * 2 + (h)) * HTB)
#define G8_STAGE(bufoff, gbase, v0, v1) do { \
        __builtin_amdgcn_global_load_lds((const unsigned*)((const char*)(gbase) + (v0)), (LAS unsigned*)(lds + (bufoff) + ldsw), 16, 0, 0); \
        __builtin_amdgcn_global_load_lds((const unsigned*)((const char*)(gbase) + (v1)), (LAS unsigned*)(lds + (bufoff) + ldsw + 8192), 16, 0, 0); } while (0)
#define G8_LDA(dst, b, h) do { _Pragma("unroll") for (int m = 0; m < 4; ++m) _Pragma("unroll") for (int k = 0; k < 2; ++k) dst[m][k] = *(const LAS bf16x8*)(lds + G8_SA(b, h) + aoff + m * 2048 + k * 1024); } while (0)
#define G8_LDB(dst, b, h) do { _Pragma("unroll") for (int n = 0; n < 2; ++n) _Pragma("unroll") for (int k = 0; k < 2; ++k) dst[n][k] = *(const LAS bf16x8*)(lds + G8_SB(b, h) + boff + n * 2048 + k * 1024); } while (0)
#define G8_MMA(ai, bj, At, Bt) do { __builtin_amdgcn_s_setprio(1); _Pragma("unroll") for (int m = 0; m < 4; ++m) _Pragma("unroll") for (int n = 0; n < 2; ++n) _Pragma("unroll") for (int k = 0; k < 2; ++k) \
        acc[ai][bj][m][n] = __builtin_amdgcn_mfma_f32_16x16x32_bf16(Bt[n][k], At[m][k], acc[ai][bj][m][n], 0, 0, 0); __builtin_amdgcn_s_setprio(0); } while (0)
#define G8_WAIT_V(n) asm volatile("s_waitcnt vmcnt(" #n ")" ::: "memory")
#define G8_WAIT_L(n) asm volatile("s_waitcnt lgkmcnt(" #n ")" ::: "memory")
#define G8_BAR __builtin_amdgcn_s_barrier()
#define G8_SCHED __builtin_amdgcn_sched_barrier(0)
    U cur, nxt; int ui = 0;
    if (!S.next(0, cur)) return;
    f32x4 acc[2][2][4][2];
#pragma unroll
    for (int a = 0; a < 2; ++a)
#pragma unroll
        for (int b = 0; b < 2; ++b)
#pragma unroll
            for (int m = 0; m < 4; ++m)
#pragma unroll
                for (int n = 0; n < 2; ++n) acc[a][b][m][n] = (f32x4){0.f, 0.f, 0.f, 0.f};
    bf16x8 At[4][2], B0[2][2], B1[2][2];
    unsigned ac00 = S.a_off(cur, 0, Rr[0], Cc[0]), ac01 = S.a_off(cur, 0, Rr[1], Cc[1]), ac10 = S.a_off(cur, 1, Rr[0], Cc[0]), ac11 = S.a_off(cur, 1, Rr[1], Cc[1]);
    const char* cA = cur.A; const char* cB = cur.Bt;
    G8_STAGE(G8_SB(0, 0), cB, vb[0], vb[1]); G8_STAGE(G8_SA(0, 0), cA, ac00, ac01); G8_STAGE(G8_SB(0, 1), cB + hstepB, vb[0], vb[1]); G8_STAGE(G8_SA(0, 1), cA, ac10, ac11);
    if (wr == 1) G8_BAR;
    G8_WAIT_V(4); G8_BAR;
    G8_STAGE(G8_SB(1, 0), cB + kstep, vb[0], vb[1]); G8_STAGE(G8_SA(1, 0), cA + kstep, ac00, ac01); G8_STAGE(G8_SB(1, 1), cB + hstepB + kstep, vb[0], vb[1]);
    G8_WAIT_V(6); G8_BAR;
    for (;;) {
        const bool has_next = S.next(ui + 1, nxt);
        const char* nA = has_next ? nxt.A : cA; const char* nB = has_next ? nxt.Bt : cB;
        unsigned an00 = ac00, an01 = ac01, an10 = ac10, an11 = ac11;
        if (has_next) { an00 = S.a_off(nxt, 0, Rr[0], Cc[0]); an01 = S.a_off(nxt, 0, Rr[1], Cc[1]); an10 = S.a_off(nxt, 1, Rr[0], Cc[0]); an11 = S.a_off(nxt, 1, Rr[1], Cc[1]); }
        for (int t = 0; t < nt; t += 2) {
            const bool last = (t == nt - 2);
            const char* a1 = cA + (size_t)(t + 1) * kstep;
            const char* a2 = last ? nA : cA + (size_t)(t + 2) * kstep; const char* b2 = last ? nB : cB + (size_t)(t + 2) * kstep;
            const char* a3 = a2 + kstep; const char* b3 = b2 + kstep;
            const unsigned s00 = last ? an00 : ac00, s01 = last ? an01 : ac01, s10 = last ? an10 : ac10, s11 = last ? an11 : ac11;
            G8_LDB(B0, 0, 0); G8_SCHED; G8_LDA(At, 0, 0); G8_STAGE(G8_SA(1, 1), a1, ac10, ac11);
            G8_WAIT_L(8); G8_BAR; G8_WAIT_L(0); G8_MMA(0, 0, At, B0); G8_BAR; G8_SCHED;
            G8_LDB(B1, 0, 1); G8_STAGE(G8_SB(0, 0), b2, vb[0], vb[1]);
            G8_BAR; G8_WAIT_L(0); G8_MMA(0, 1, At, B1); G8_BAR;
            G8_LDA(At, 0, 1); G8_STAGE(G8_SA(0, 0), a2, s00, s01);
            G8_BAR; G8_WAIT_L(0); G8_MMA(1, 0, At, B0); G8_BAR; G8_SCHED;
            G8_STAGE(G8_SB(0, 1), b2 + hstepB, vb[0], vb[1]);
            G8_WAIT_V(6); G8_BAR; G8_MMA(1, 1, At, B1); G8_BAR;
            G8_LDB(B0, 1, 0); G8_SCHED; G8_LDA(At, 1, 0); G8_STAGE(G8_SA(0, 1), a2, s10, s11);
            G8_WAIT_L(8); G8_BAR; G8_WAIT_L(0); G8_MMA(0, 0, At, B0); G8_BAR; G8_SCHED;
            G8_LDB(B1, 1, 1); G8_STAGE(G8_SB(1, 0), b3, vb[0], vb[1]);
            G8_BAR; G8_WAIT_L(0); G8_MMA(0, 1, At, B1); G8_BAR;
            G8_LDA(At, 1, 1); G8_STAGE(G8_SA(1, 0), a3, s00, s01);
            G8_BAR; G8_WAIT_L(0); G8_MMA(1, 0, At, B0); G8_BAR; G8_SCHED;
            G8_STAGE(G8_SB(1, 1), b3 + hstepB, vb[0], vb[1]);
            G8_WAIT_V(6); G8_BAR; G8_MMA(1, 1, At, B1); G8_BAR;
        }
        E(acc, cur, wr, wc, fr, fq);
        if (!has_next) break;
#pragma unroll
        for (int a = 0; a < 2; ++a)
#pragma unroll
            for (int b = 0; b < 2; ++b)
#pragma unroll
                for (int m = 0; m < 4; ++m)
#pragma unroll
                    for (int n = 0; n < 2; ++n) acc[a][b][m][n] = (f32x4){0.f, 0.f, 0.f, 0.f};
        cur = nxt; cA = nA; cB = nB; ac00 = an00; ac01 = an01; ac10 = an10; ac11 = an11; ++ui;
    }
    G8_WAIT_V(0);
    if (wr == 0) G8_BAR;
    G8_BAR;
#undef G8_SA
#undef G8_SB
#undef G8_STAGE
#undef G8_LDA
#undef G8_LDB
#undef G8_MMA
#undef G8_WAIT_V
#undef G8_WAIT_L
#undef G8_BAR
#undef G8_SCHED
}
struct EpiBf16 {
    bf16* O; int ld, ncols; float* FL; int fl0; float* KMs; int km0;
    DEVI void operator()(const f32x4 (&acc)[2][2][4][2], const U& u, int wr, int wc, int fr, int fq) const {
        const int row0 = u.pm * BM + wr * 64 + fr, col0 = u.pn * BM + wc * 32 + 4 * fq;
        if (KMs && u.pn * BM >= km0 && u.pn * BM < km0 + 1024) {
#pragma unroll
            for (int bj = 0; bj < 2; ++bj)
#pragma unroll
                for (int n = 0; n < 2; ++n) {
                    f32x4 sv = acc[0][bj][0][n];
#pragma unroll
                    for (int m = 1; m < 4; ++m) sv += acc[0][bj][m][n];
#pragma unroll
                    for (int m = 0; m < 4; ++m) sv += acc[1][bj][m][n];
#pragma unroll
                    for (int q = 0; q < 4; ++q) { float x = sv[q]; x += __shfl_xor(x, 1); x += __shfl_xor(x, 2); x += __shfl_xor(x, 4); x += __shfl_xor(x, 8); sv[q] = x; }
                    if (fr == 0) { const int cc = col0 + bj * HALF + n * 16 - km0; float* dst = KMs + ((size_t)((u.pm >> 4) * 8 + (cc >> 7)) * 16 + (u.pm & 15)) * 128 + (cc & 127);
#pragma unroll
                        for (int q = 0; q < 4; ++q) atomicAdd(dst + q, sv[q]); }
                }
        }
#pragma unroll
        for (int ai = 0; ai < 2; ++ai)
#pragma unroll
            for (int m = 0; m < 4; ++m) { const int row = row0 + ai * HALF + m * 16;
#pragma unroll
                for (int bj = 0; bj < 2; ++bj)
#pragma unroll
                    for (int n = 0; n < 2; ++n) { const int col = col0 + bj * HALF + n * 16; const f32x4 v = acc[ai][bj][m][n];
                        if (col < ncols) { uint2 w; w.x = pk2(v[0], v[1]); w.y = pk2(v[2], v[3]); *(uint2*)(O + (size_t)row * ld + col) = w;
                            if (FL && col >= fl0) *(f32x4*)(FL + (size_t)row * 8 + (col - fl0)) = v; } } }
    }
};
struct EpiRes {
    float* C; const float* res; int ld; float alpha;
    DEVI void operator()(const f32x4 (&acc)[2][2][4][2], const U& u, int wr, int wc, int fr, int fq) const {
        const int row0 = u.pm * BM + wr * 64 + fr, col0 = u.pn * BM + wc * 32 + 4 * fq;
#pragma unroll
        for (int ai = 0; ai < 2; ++ai)
#pragma unroll
            for (int m = 0; m < 4; ++m) { const size_t ro = (size_t)(row0 + ai * HALF + m * 16) * ld + col0;
#pragma unroll
                for (int bj = 0; bj < 2; ++bj)
#pragma unroll
                    for (int n = 0; n < 2; ++n) { const size_t o = ro + bj * HALF + n * 16; *(f32x4*)(C + o) = *(const f32x4*)(res + o) * alpha + acc[ai][bj][m][n]; } }
    }
};

struct MoeOrder {
    const LAS int* sh; const int* list; const char* A; const char* W; int lda, K, ntn, G, c, stage; size_t wstride;
    DEVI bool next(int i, U& u) const {
        const int L = i * G + c; if (L >= sh[33 + 32]) return false;
        int e = 0; while (sh[33 + e + 1] <= L) ++e;
        const int r = L - sh[33 + e]; u.pm = r / ntn; u.pn = r % ntn; u.x0 = e; u.x1 = sh[e + 1] - sh[e]; u.x2 = sh[e];
        u.A = A; u.Bt = W + (size_t)e * wstride + (size_t)u.pn * BM * K * 2; return true;
    }
    DEVI unsigned a_off(const U& u, int h, int R, int C) const {
        int i = u.pm * BM + h * HALF + R; if (i > u.x1 - 1) i = u.x1 - 1;
        const int row = stage == 1 ? (list[u.x0 * T + i] >> 1) : (u.x2 + i);
        return (unsigned)(row * lda + C) * 2u;
    }
};
struct EpiMoe1 {
    bf16* hdn;
    DEVI void operator()(const f32x4 (&acc)[2][2][4][2], const U& u, int wr, int wc, int fr, int fq) const {
        const int i0 = u.pm * BM + wr * 64 + fr, j0 = u.pn * HALF + wc * 32 + 4 * fq;
#pragma unroll
        for (int ai = 0; ai < 2; ++ai)
#pragma unroll
            for (int m = 0; m < 4; ++m) { const int i = i0 + ai * HALF + m * 16;
                if (i < u.x1) {
#pragma unroll
                    for (int n = 0; n < 2; ++n) { const f32x4 gv = acc[ai][0][m][n], uv = acc[ai][1][m][n]; float hv[4];
#pragma unroll
                        for (int q = 0; q < 4; ++q) hv[q] = gv[q] / (1.f + __expf(-gv[q])) * uv[q];
                        uint2 w; w.x = pk2(hv[0], hv[1]); w.y = pk2(hv[2], hv[3]);
                        *(uint2*)(hdn + (size_t)(u.x2 + i) * FF + j0 + n * 16) = w; } } }
    }
};
struct EpiMoe2 {
    bf16* Y; const int* list; const float* ew;
    DEVI void operator()(const f32x4 (&acc)[2][2][4][2], const U& u, int wr, int wc, int fr, int fq) const {
        const int i0 = u.pm * BM + wr * 64 + fr, col0 = u.pn * BM + wc * 32 + 4 * fq;
#pragma unroll
        for (int ai = 0; ai < 2; ++ai)
#pragma unroll
            for (int m = 0; m < 4; ++m) { const int i = i0 + ai * HALF + m * 16;
                if (i < u.x1) { const int ent = list[u.x0 * T + i]; const float wt = ew[ent]; bf16* yr = Y + (size_t)ent * DM + col0;
#pragma unroll
                    for (int bj = 0; bj < 2; ++bj)
#pragma unroll
                        for (int n = 0; n < 2; ++n) { const f32x4 v = acc[ai][bj][m][n] * wt; uint2 w; w.x = pk2(v[0], v[1]); w.y = pk2(v[2], v[3]); *(uint2*)(yr + bj * HALF + n * 16) = w; } } }
    }
};
}

DEVI void transpose_item64(const float* W, int K, int Nsrc, int src_c0, bf16* WT, int dst_r0, int k0, LAS float* scr, int lane) {
    const int cq = 4 * (lane & 15), kq = lane >> 4;
    const bool ok = src_c0 >= 0 && (src_c0 + cq + 3) < Nsrc;
    const float* wp = W + (size_t)(k0 + kq) * Nsrc + (src_c0 < 0 ? 0 : src_c0) + cq;
    f32x4 v[16];
#pragma unroll
    for (int i = 0; i < 16; ++i) v[i] = ok ? *(const f32x4*)(wp + (size_t)(4 * i) * Nsrc) : (f32x4){0.f, 0.f, 0.f, 0.f};
#pragma unroll
    for (int i = 0; i < 16; ++i) { const int k = 4 * i + kq; *(LAS f32x4*)(scr + k * 68 + (cq ^ (((k >> 3) & 7) << 2))) = v[i]; }
    asm volatile("s_waitcnt lgkmcnt(0)" ::: "memory");
    const int c = lane & 7;
#pragma unroll
    for (int j = 0; j < 8; ++j) { const int n = (lane >> 3) + 8 * j; const LAS float* sp = scr + (8 * c) * 68 + (n ^ (c << 2));
        u32x4 o; o[0] = pk2(sp[0 * 68], sp[1 * 68]); o[1] = pk2(sp[2 * 68], sp[3 * 68]); o[2] = pk2(sp[4 * 68], sp[5 * 68]); o[3] = pk2(sp[6 * 68], sp[7 * 68]);
        *(u32x4*)(WT + (size_t)(dst_r0 + n) * K + k0 + 8 * c) = o; }
    asm volatile("s_waitcnt lgkmcnt(0)" ::: "memory");
}
template <class Map>
DEVI void cvt_matrix(const float* W, int K, int Nsrc, int Ndst, bf16* WT, Map smap, LAS float* scr, int gw, int ngw, int lane, int& base) {
    const int nblk = Ndst / 64, n = (K / 64) * nblk;
    int first = (gw - base % ngw + ngw) % ngw;
    for (int it = first; it < n; it += ngw) { const int kb = it / nblk, nb_ = it % nblk; transpose_item64(W, K, Nsrc, smap(nb_ * 64), WT, nb_ * 64, kb * 64, scr, lane); }
    base += n;
}

template <int DK1, int DK2, int DV, class Bias>
DEVI void attn_range(const float* qs, const bf16* K1, int ldk1, const bf16* K2, int ldk2, const bf16* V, int ldv,
                     int j0, int j1, float scale, Bias bias, float& m, float& l, float (&o)[2], int lane) {
    for (int jb = j0; jb < j1; jb += 64) {
        const int j = jb + lane; const bool valid = j < j1;
        float s = -__builtin_inff();
        if (valid) {
            float acc = 0.f;
            const bf16* kr = K1 + (size_t)j * ldk1;
#pragma unroll 4
            for (int d = 0; d < DK1; d += 8) {
                const u32x4 kv = *(const u32x4*)(kr + d); const f32x4 q0 = *(const f32x4*)(qs + d), q1 = *(const f32x4*)(qs + d + 4);
                acc += q0[0] * bflo(kv[0]) + q0[1] * bfhi(kv[0]) + q0[2] * bflo(kv[1]) + q0[3] * bfhi(kv[1])
                     + q1[0] * bflo(kv[2]) + q1[1] * bfhi(kv[2]) + q1[2] * bflo(kv[3]) + q1[3] * bfhi(kv[3]);
            }
            if (DK2 > 0) {
                const bf16* kr2 = K2 + (size_t)j * ldk2;
#pragma unroll 4
                for (int d = 0; d < DK2; d += 8) {
                    const u32x4 kv = *(const u32x4*)(kr2 + d); const f32x4 q0 = *(const f32x4*)(qs + DK1 + d), q1 = *(const f32x4*)(qs + DK1 + d + 4);
                    acc += q0[0] * bflo(kv[0]) + q0[1] * bfhi(kv[0]) + q0[2] * bflo(kv[1]) + q0[3] * bfhi(kv[1])
                         + q1[0] * bflo(kv[2]) + q1[1] * bfhi(kv[2]) + q1[2] * bflo(kv[3]) + q1[3] * bfhi(kv[3]);
                }
            }
            s = acc * scale + bias(j);
        }
        const float cm = wave_max(s);
        const float mn = fmaxf(m, cm);
        const float alpha = __expf(m - mn);
        const float p = __expf(s - mn);
        l = l * alpha + wave_sum(p);
        o[0] *= alpha; o[1] *= alpha;
        m = mn;
        const int cnt = (j1 - jb) < 64 ? (j1 - jb) : 64;
        for (int jj = 0; jj < cnt; ++jj) {
            const float pj = __shfl(p, jj);
            const bf16* vr = V + (size_t)(jb + jj) * ldv;
            if (DV == 128) { const unsigned vv = *(const unsigned*)(vr + lane * 2); o[0] += pj * bflo(vv); o[1] += pj * bfhi(vv); }
            else { o[0] += pj * bf2f(vr[lane]); }
        }
    }
}


typedef short s16x4 __attribute__((ext_vector_type(4)));
typedef float f32x16 __attribute__((ext_vector_type(16)));
constexpr int FA_V = 0, FA_K = 32768, FA_KR = 65536, FA_CUM = 81920, FA_WS = 82432, FA_Q = 131072 + 512, FA_KM = 84992, FA_END = 93184;
constexpr int SHM_K = 16384, SHM_V = 16384, SHM_KR = 8192;
#define KSWZ(row, colB) ((row) * 256 + ((colB) ^ (((row) & 7) << 4)))
DEVI int v_st(int k, int c) { const int kk = (k & ~0xC) | ((k & 4) << 1) | ((k & 8) >> 1); return ((kk >> 3) * 4 + (c >> 5)) * 512 + ((kk & 7) * 32 + (c & 31)) * 2; }
DEVI int v_rd_base(int lane) { return ((lane & 3) << 3) | (((lane >> 2) & 3) << 6) | (((lane >> 4) & 1) << 5) | (((lane >> 5) & 1) << 8); }
DEVI int crow(int r, int hi) { return (r & 3) + 8 * (r >> 2) + 4 * hi; }
DEVI unsigned cvtpk(float lo, float hi) { unsigned r; asm volatile("v_cvt_pk_bf16_f32 %0, %1, %2" : "=v"(r) : "v"(lo), "v"(hi)); return r; }
enum { FM_MLA = 0, FM_FOX = 1, FM_MOBA = 2 };

template <int MODE>
DEVI void flash_unit(char* lds, const bf16* Qp, int ldq, const bf16* Kp, int ldk, const bf16* Vp, int ldv, const bf16* KRp,
                     const float* cum, const float* km, float slope, float sbound, int q0, bf16* Op, int ldo) {
    const int tid = threadIdx.x, wid = __builtin_amdgcn_readfirstlane(tid >> 6), lane = tid & 63, r32 = lane & 31, hi = lane >> 5;
    const int kh = wid >> 2, rgp = wid & 3;
    char* V_lds = lds + FA_V; char* K_lds = lds + FA_K; char* KR_lds = lds + FA_KR;
    float* cumt = (float*)(lds + FA_CUM);
    float* wsf = (float*)(lds + FA_WS) + wid * 64; float* li_l = wsf; float* al_l = wsf + 32;
    const int qrow = q0 + rgp * 32 + r32;
    constexpr float LOG2E = 1.4426950408889634f;
    constexpr float SC = (MODE == FM_MLA ? 0.07216878364870322f : 0.08838834764831845f) * LOG2E;
    constexpr int NQ = MODE == FM_MLA ? 12 : 8;
    bf16x8 qr[NQ];
    const bf16* qp = Qp + (size_t)qrow * ldq;
#pragma unroll
    for (int d0 = 0; d0 < 8; ++d0) qr[d0] = *(const bf16x8*)(qp + d0 * 16 + hi * 8);
    if constexpr (MODE == FM_MLA) {
        const bf16x8 a0 = *(const bf16x8*)(qp + 128 + hi * 8), a1 = *(const bf16x8*)(qp + 144 + hi * 8);
        const bf16x8 b0 = *(const bf16x8*)(qp + 160 + hi * 8), b1 = *(const bf16x8*)(qp + 176 + hi * 8);
        bf16x8 ra0, ra1, rb0, rb1;
#pragma unroll
        for (int e = 0; e < 8; ++e) {
            float c, s_;
            rope_cs(qrow, hi * 8 + e, c, s_);
            { const float t1 = bf2f((unsigned short)a0[e]), t2 = bf2f((unsigned short)b0[e]); ra0[e] = (short)f2bf(t1 * c - t2 * s_); rb0[e] = (short)f2bf(t1 * s_ + t2 * c); }
            rope_cs(qrow, 16 + hi * 8 + e, c, s_);
            { const float t1 = bf2f((unsigned short)a1[e]), t2 = bf2f((unsigned short)b1[e]); ra1[e] = (short)f2bf(t1 * c - t2 * s_); rb1[e] = (short)f2bf(t1 * s_ + t2 * c); }
        }
        qr[8] = ra0; qr[9] = ra1; qr[10] = rb0; qr[11] = rb1;
    }
    const int j_hi = (q0 >> 6) + 2;
    unsigned sel = 0xffffffffu, umask = 0xffffffffu;
    if constexpr (MODE == FM_MOBA) {
        const int blk = q0 >> 8;
        float* kml = (float*)(lds + FA_KM);
        unsigned* um = (unsigned*)(lds + FA_Q) + 4;
        *(f32x4*)(kml + tid * 4) = *(const f32x4*)(km + tid * 4) * (1.f / 256.f);
        if (tid == 0) *um = 0u;
        __syncthreads();
        float g[15];
#pragma unroll
        for (int n = 0; n < 15; ++n) g[n] = 0.f;
        for (int dd = 0; dd < 64; dd += 8) {
            const bf16x8 qv = *(const bf16x8*)(qp + hi * 64 + dd);
            float qf[8];
#pragma unroll
            for (int e = 0; e < 8; ++e) qf[e] = bf2f((unsigned short)qv[e]);
#pragma unroll
            for (int n = 0; n < 15; ++n)
                if (n < blk) {
                    const f32x4 k0 = *(const f32x4*)(kml + n * 128 + hi * 64 + dd), k1 = *(const f32x4*)(kml + n * 128 + hi * 64 + dd + 4);
                    g[n] += qf[0] * k0[0] + qf[1] * k0[1] + qf[2] * k0[2] + qf[3] * k0[3] + qf[4] * k1[0] + qf[5] * k1[1] + qf[6] * k1[2] + qf[7] * k1[3];
                }
        }
#pragma unroll
        for (int n = 0; n < 15; ++n) g[n] += __shfl_xor(g[n], 32);
        sel = 1u << blk;
#pragma unroll
        for (int r = 0; r < 3; ++r) {
            float best = -__builtin_inff(); int bi = -1;
#pragma unroll
            for (int n = 0; n < 15; ++n) if (n < blk && !((sel >> n) & 1u) && g[n] > best) { best = g[n]; bi = n; }
            if (bi >= 0) sel |= 1u << bi;
        }
        unsigned wm_ = 0u;
#pragma unroll
        for (int n = 0; n < 16; ++n) if (__any((sel >> n) & 1u)) wm_ |= 1u << n;
        if (lane == 0) atomicOr(um, wm_);
        __syncthreads();
        umask = *um;
    }
    auto nxt = [&](int j) { do { ++j; } while (j < j_hi && !((umask >> (j >> 2)) & 1u)); return j; };
    int j_lo = 0;
    if constexpr (MODE == FM_FOX) {
        const float lim = cum[q0] + 2.f * sbound + 40.f;
        const float cj = (lane < j_hi) ? cum[64 * lane + 63] : -__builtin_inff();
        const unsigned long long keep = __ballot(cj <= lim);
        j_lo = keep ? (int)__builtin_ctzll(keep) : j_hi - 1;
        if (j_lo > j_hi - 2) j_lo = j_hi - 2;
        j_lo = __builtin_amdgcn_readfirstlane(j_lo);
    }
    int jc = nxt(j_lo - 1);
    const int sr = tid >> 4, sc = (tid & 15) * 8;
    const int kws = KSWZ(sr, sc * 2), vst0 = v_st(sr, sc), vst1 = v_st(32 + sr, sc);
    const int krk = tid >> 3, krc = tid & 7, krw = krk * 128 + ((krc ^ (krk & 7)) << 4);
    bf16x8 st_k0, st_k1, st_v0, st_v1, st_kr; float st_c = 0.f;
#define FA_GL(kb) do { const unsigned ko_ = (unsigned)(((kb) + sr) * ldk + sc) * 2u, vo_ = (unsigned)(((kb) + sr) * ldv + sc) * 2u; \
        st_k0 = *(const bf16x8*)((const char*)Kp + ko_); st_k1 = *(const bf16x8*)((const char*)Kp + ko_ + (unsigned)(64 * ldk)); \
        st_v0 = *(const bf16x8*)((const char*)Vp + vo_); st_v1 = *(const bf16x8*)((const char*)Vp + vo_ + (unsigned)(64 * ldv)); \
        if constexpr (MODE == FM_MLA) st_kr = *(const bf16x8*)((const char*)KRp + (unsigned)(((kb) + krk) * 64 + krc * 8) * 2u); \
        if constexpr (MODE == FM_FOX) { if (tid < 64) st_c = cum[(kb) + tid]; } } while (0)
#define FA_SW(bf) do { *(bf16x8*)(K_lds + (bf) * SHM_K + kws) = st_k0; *(bf16x8*)(K_lds + (bf) * SHM_K + kws + 32 * 256) = st_k1; \
        *(bf16x8*)(V_lds + (bf) * SHM_V + vst0) = st_v0; *(bf16x8*)(V_lds + (bf) * SHM_V + vst1) = st_v1; \
        if constexpr (MODE == FM_MLA) *(bf16x8*)(KR_lds + (bf) * SHM_KR + krw) = st_kr; \
        if constexpr (MODE == FM_FOX) { if (tid < 64) cumt[(bf) * 64 + tid] = st_c; } } while (0)
    FA_GL(jc * 64);
    asm volatile("s_waitcnt vmcnt(0)" ::: "memory");
    FA_SW(0);
    float m_reg = -1e30f, l_reg = 0.f;
    f32x16 o[4];
#pragma unroll
    for (int d = 0; d < 4; ++d)
#pragma unroll
        for (int r = 0; r < 16; ++r) o[d][r] = 0.f;
    float cqL = 0.f;
    if constexpr (MODE == FM_FOX) cqL = cum[qrow];
    const float slopeL = slope * LOG2E;
    const int vb0 = (int)(unsigned)(size_t)((LAS char*)V_lds) + v_rd_base(lane) + kh * 8192;
    int bf = 0;
    while (jc < j_hi) {
        const int kb = jc * 64;
        const int jn = nxt(jc);
        __syncthreads();
        if (jn < j_hi) FA_GL(jn * 64);
        f32x16 p0;
#pragma unroll
        for (int r = 0; r < 16; ++r) p0[r] = 0.f;
        {
            const char* kbase = K_lds + bf * SHM_K + kh * (32 * 256);
            const char* kbp[4];
#pragma unroll
            for (int dd = 0; dd < 4; ++dd) kbp[dd] = kbase + KSWZ(r32, (dd * 16 + hi * 8) * 2);
#pragma unroll
            for (int d0 = 0; d0 < 8; ++d0) {
                const bf16x8 b0 = *(const bf16x8*)(kbp[d0 & 3] + (d0 >> 2) * 128);
                p0 = __builtin_amdgcn_mfma_f32_32x32x16_bf16(b0, qr[d0], p0, 0, 0, 0);
            }
            if constexpr (MODE == FM_MLA) {
                const char* krb = KR_lds + bf * SHM_KR + (kh * 32 + r32) * 128;
#pragma unroll
                for (int d = 0; d < 4; ++d) {
                    const bf16x8 b0 = *(const bf16x8*)(krb + (((d * 2 + hi) ^ (r32 & 7)) << 4));
                    p0 = __builtin_amdgcn_mfma_f32_32x32x16_bf16(b0, qr[8 + d], p0, 0, 0, 0);
                }
            }
        }
        if (jn < j_hi) { asm volatile("s_waitcnt vmcnt(0)" ::: "memory"); FA_SW(bf ^ 1); }
        const int kbh = kb + kh * 32;
        if constexpr (MODE == FM_FOX) {
#pragma unroll
            for (int g4 = 0; g4 < 4; ++g4) {
                const f32x4 c0 = *(const f32x4*)(cumt + bf * 64 + kh * 32 + 8 * g4 + 4 * hi);
#pragma unroll
                for (int i = 0; i < 4; ++i) p0[4 * g4 + i] = p0[4 * g4 + i] * SC + (cqL - c0[i]) * LOG2E;
            }
        } else if constexpr (MODE == FM_MOBA) {
            const float dq = (float)(qrow - kbh - 4 * hi);
#pragma unroll
            for (int r = 0; r < 16; ++r) { const float c = (float)((r & 3) + 8 * (r >> 2)); p0[r] = p0[r] * SC - slopeL * (dq - c); }
        } else {
#pragma unroll
            for (int r = 0; r < 16; ++r) p0[r] *= SC;
        }
        const float NEG = -__builtin_inff();
        if (kbh + 31 > q0 + rgp * 32) {
            const int dqi = qrow - kbh - 4 * hi;
#pragma unroll
            for (int r = 0; r < 16; ++r) { const int c = (r & 3) + 8 * (r >> 2); if (c > dqi) p0[r] = NEG; }
        }
        if constexpr (MODE == FM_MOBA) {
            if (!((sel >> (kb >> 8)) & 1u)) {
#pragma unroll
                for (int r = 0; r < 16; ++r) p0[r] = NEG;
            }
        }
        float pmax = p0[0];
#pragma unroll
        for (int r = 1; r < 16; ++r) pmax = fmaxf(pmax, p0[r]);
        { auto rr = __builtin_amdgcn_permlane32_swap(__float_as_uint(pmax), __float_as_uint(pmax), false, false);
          pmax = fmaxf(__uint_as_float(rr[0]), __uint_as_float(rr[1])); }
        const float mn = fmaxf(m_reg, pmax);
        const float alpha = __builtin_amdgcn_exp2f(m_reg - mn);
        m_reg = mn;
        float ps = 0.f;
#pragma unroll
        for (int r = 0; r < 16; ++r) { p0[r] = __builtin_amdgcn_exp2f(p0[r] - mn); ps += p0[r]; }
        { auto rr = __builtin_amdgcn_permlane32_swap(__float_as_uint(ps), __float_as_uint(ps), false, false);
          ps = __uint_as_float(rr[0]) + __uint_as_float(rr[1]); }
        l_reg = l_reg * alpha + ps;
        bf16x8 pa0, pa1;
#define PK4(P, B_, OUT) do { unsigned a0_ = cvtpk(P[B_ + 0], P[B_ + 1]), a1_ = cvtpk(P[B_ + 2], P[B_ + 3]); \
        unsigned b0_ = cvtpk(P[B_ + 4], P[B_ + 5]), b1_ = cvtpk(P[B_ + 6], P[B_ + 7]); \
        auto r0_ = __builtin_amdgcn_permlane32_swap(a0_, b0_, false, false); auto r1_ = __builtin_amdgcn_permlane32_swap(a1_, b1_, false, false); \
        u32x4 w_ = {r0_[0], r1_[0], r0_[1], r1_[1]}; OUT = *reinterpret_cast<bf16x8*>(&w_); } while (0)
        PK4(p0, 0, pa0); PK4(p0, 8, pa1);
#undef PK4
        if (__any(alpha < 1.f)) {
            if (hi == 0) al_l[r32] = alpha;
            asm volatile("s_waitcnt lgkmcnt(0)" ::: "memory");
#pragma unroll
            for (int d = 0; d < 4; ++d)
#pragma unroll
                for (int r = 0; r < 16; ++r) o[d][r] *= al_l[crow(r, hi)];
        }
        {
            const int vb = vb0 + bf * SHM_V;
#define TRRD(dst, off) asm volatile("ds_read_b64_tr_b16 %0, %1 offset:%2" : "=&v"(dst) : "v"(vb), "i"(off) : "memory")
#define PV_D0(d0) do { s16x4 l0, l1, h0, h1; constexpr int b_ = (d0) * 512; \
        TRRD(l0, b_); TRRD(h0, b_ + 2048); TRRD(l1, b_ + 4096); TRRD(h1, b_ + 6144); \
        asm volatile("s_waitcnt lgkmcnt(0)" ::: "memory"); __builtin_amdgcn_sched_barrier(0); \
        o[d0] = __builtin_amdgcn_mfma_f32_32x32x16_bf16(pa0, (bf16x8){l0[0], l0[1], l0[2], l0[3], h0[0], h0[1], h0[2], h0[3]}, o[d0], 0, 0, 0); \
        o[d0] = __builtin_amdgcn_mfma_f32_32x32x16_bf16(pa1, (bf16x8){l1[0], l1[1], l1[2], l1[3], h1[0], h1[1], h1[2], h1[3]}, o[d0], 0, 0, 0); } while (0)
            PV_D0(0); PV_D0(1); PV_D0(2); PV_D0(3);
#undef PV_D0
#undef TRRD
        }
        bf ^= 1; jc = jn;
    }
#undef FA_GL
#undef FA_SW
    __syncthreads();
    float* xo = (float*)(lds + FA_V) + (size_t)rgp * 66 * 64 + lane;
    if (kh == 1) {
#pragma unroll
        for (int d = 0; d < 4; ++d)
#pragma unroll
            for (int r = 0; r < 16; ++r) xo[(d * 16 + r) * 64] = o[d][r];
        xo[64 * 64] = m_reg; xo[65 * 64] = l_reg;
    }
    __syncthreads();
    if (kh == 0) {
        const float mB = xo[64 * 64], lB = xo[65 * 64];
        const float mm = fmaxf(m_reg, mB);
        const float aA = __builtin_amdgcn_exp2f(m_reg - mm), aB = __builtin_amdgcn_exp2f(mB - mm);
        const float inv = 1.f / (l_reg * aA + lB * aB);
        if (hi == 0) { li_l[r32] = aA * inv; al_l[r32] = aB * inv; }
        asm volatile("s_waitcnt lgkmcnt(0)" ::: "memory");
        int tz = lane; asm volatile("" : "+v"(tz));
        const int hz = tz >> 5, rz = tz & 31;
        bf16* Ow = Op + (size_t)(q0 + rgp * 32) * ldo;
#pragma unroll
        for (int r = 0; r < 16; ++r) {
            const int orow = crow(r, hz);
            const float fa = li_l[orow], fb = al_l[orow];
            const unsigned obase = (unsigned)(orow * ldo + rz);
#pragma unroll
            for (int d0 = 0; d0 < 4; ++d0) {
                const float v = o[d0][r] * fa + xo[(d0 * 16 + r) * 64] * fb;
                const float vn = __shfl_xor(v, 1);
                if ((rz & 1) == 0) *(unsigned*)(Ow + obase + d0 * 32) = cvtpk(v, vn);
            }
        }
    }
    __syncthreads();
}

constexpr int SW_V = 0, SW_K = 49152, SW_WS = 98304;
DEVI void swa_unit(char* lds, const bf16* Pb  , int kvh, int q0, const float* sinks, bf16* Ob  ) {
    const int tid = threadIdx.x, wid = __builtin_amdgcn_readfirstlane(tid >> 6), lane = tid & 63, r32 = lane & 31, hi = lane >> 5;
    char* V_lds = lds + SW_V; char* K_lds = lds + SW_K;
    float* wsf = (float*)(lds + SW_WS) + wid * 64; float* li_l = wsf; float* al_l = wsf + 32;
    constexpr float LOG2E = 1.4426950408889634f, SC = 0.125f * LOG2E;
    const int qh = kvh * 8 + wid;
    const float slopeL = exp2f(-0.5f * (float)(qh + 1)) * LOG2E, sinkL = sinks[qh] * LOG2E;
    {
        const int key = tid >> 3, ch = tid & 7;
        const int kws = KSWZ(key, ch * 16), vws = v_st(key, ch * 8);
        bf16x8 sk[3], sv[3];
#pragma unroll
        for (int jt = 0; jt < 3; ++jt) {
            const int kb = q0 - 128 + jt * 64;
            if (kb >= 0) {
                const unsigned o_ = (unsigned)((kb + key) * LDP + ch * 8) * 2u;
                sk[jt] = *(const bf16x8*)((const char*)Pb + o_ + (unsigned)(O_SK + kvh * 64) * 2u);
                sv[jt] = *(const bf16x8*)((const char*)Pb + o_ + (unsigned)(O_SV + kvh * 64) * 2u);
            }
        }
#pragma unroll
        for (int jt = 0; jt < 3; ++jt) {
            const int kb = q0 - 128 + jt * 64;
            if (kb >= 0) { *(bf16x8*)(K_lds + jt * SHM_K + kws) = sk[jt]; *(bf16x8*)(V_lds + jt * SHM_V + vws) = sv[jt]; }
        }
    }
    __syncthreads();
    const int vb0 = (int)(unsigned)(size_t)((LAS char*)V_lds) + v_rd_base(lane);
    for (int rg = 0; rg < 2; ++rg) {
        const int qrow = q0 + rg * 32 + r32;
        bf16x8 qr[4];
        const bf16* qp = Pb + (size_t)qrow * LDP + O_SQ + qh * 64;
#pragma unroll
        for (int d0 = 0; d0 < 4; ++d0) qr[d0] = *(const bf16x8*)(qp + d0 * 16 + hi * 8);
        float m_reg = -1e30f, l_reg = 0.f;
        f32x16 o[2];
#pragma unroll
        for (int d = 0; d < 2; ++d)
#pragma unroll
            for (int r = 0; r < 16; ++r) o[d][r] = 0.f;
#pragma unroll 1
        for (int jt = 0; jt < 3; ++jt) {
            const int kb = q0 - 128 + jt * 64;
            if (kb < 0) continue;
            f32x16 p0, p1;
#pragma unroll
            for (int r = 0; r < 16; ++r) { p0[r] = 0.f; p1[r] = 0.f; }
            {
                const char* kbase = K_lds + jt * SHM_K;
#pragma unroll
                for (int d0 = 0; d0 < 4; ++d0) {
                    const char* ap = kbase + KSWZ(r32, (d0 * 16 + hi * 8) * 2);
                    const bf16x8 b0 = *(const bf16x8*)(ap), b1 = *(const bf16x8*)(ap + 32 * 256);
                    p0 = __builtin_amdgcn_mfma_f32_32x32x16_bf16(b0, qr[d0], p0, 0, 0, 0);
                    p1 = __builtin_amdgcn_mfma_f32_32x32x16_bf16(b1, qr[d0], p1, 0, 0, 0);
                }
            }
            const float NEG = -__builtin_inff();
            const int dqi = qrow - kb - 4 * hi;
#pragma unroll
            for (int r = 0; r < 16; ++r) {
                const int c = (r & 3) + 8 * (r >> 2);
                const int d0_ = dqi - c, d1_ = dqi - c - 32;
                p0[r] = ((unsigned)d0_ < 128u) ? p0[r] * SC - slopeL * (float)d0_ : NEG;
                p1[r] = ((unsigned)d1_ < 128u) ? p1[r] * SC - slopeL * (float)d1_ : NEG;
            }
            float pmax = p0[0];
#pragma unroll
            for (int r = 1; r < 16; ++r) pmax = fmaxf(pmax, p0[r]);
#pragma unroll
            for (int r = 0; r < 16; ++r) pmax = fmaxf(pmax, p1[r]);
            { auto rr = __builtin_amdgcn_permlane32_swap(__float_as_uint(pmax), __float_as_uint(pmax), false, false);
              pmax = fmaxf(__uint_as_float(rr[0]), __uint_as_float(rr[1])); }
            const float mn = fmaxf(m_reg, pmax);
            const float alpha = __builtin_amdgcn_exp2f(m_reg - mn);
            m_reg = mn;
            float ps = 0.f;
#pragma unroll
            for (int r = 0; r < 16; ++r) { p0[r] = __builtin_amdgcn_exp2f(p0[r] - mn); p1[r] = __builtin_amdgcn_exp2f(p1[r] - mn); ps += p0[r] + p1[r]; }
            { auto rr = __builtin_amdgcn_permlane32_swap(__float_as_uint(ps), __float_as_uint(ps), false, false);
              ps = __uint_as_float(rr[0]) + __uint_as_float(rr[1]); }
            l_reg = l_reg * alpha + ps;
            bf16x8 pa0, pa1, pa2, pa3;
#define PK4(P, B_, OUT) do { unsigned a0_ = cvtpk(P[B_ + 0], P[B_ + 1]), a1_ = cvtpk(P[B_ + 2], P[B_ + 3]); \
        unsigned b0_ = cvtpk(P[B_ + 4], P[B_ + 5]), b1_ = cvtpk(P[B_ + 6], P[B_ + 7]); \
        auto r0_ = __builtin_amdgcn_permlane32_swap(a0_, b0_, false, false); auto r1_ = __builtin_amdgcn_permlane32_swap(a1_, b1_, false, false); \
        u32x4 w_ = {r0_[0], r1_[0], r0_[1], r1_[1]}; OUT = *reinterpret_cast<bf16x8*>(&w_); } while (0)
            PK4(p0, 0, pa0); PK4(p0, 8, pa1); PK4(p1, 0, pa2); PK4(p1, 8, pa3);
#undef PK4
            if (__any(alpha < 1.f)) {
                if (hi == 0) al_l[r32] = alpha;
                asm volatile("s_waitcnt lgkmcnt(0)" ::: "memory");
#pragma unroll
                for (int d = 0; d < 2; ++d)
#pragma unroll
                    for (int r = 0; r < 16; ++r) o[d][r] *= al_l[crow(r, hi)];
            }
            {
                const int vb = vb0 + jt * SHM_V;
#define TRRD(dst, off) asm volatile("ds_read_b64_tr_b16 %0, %1 offset:%2" : "=&v"(dst) : "v"(vb), "i"(off) : "memory")
#define PV_D0(d0) do { s16x4 l0, l1, l2, l3, h0, h1, h2, h3; constexpr int b_ = (d0) * 512; \
        TRRD(l0, b_); TRRD(h0, b_ + 2048); TRRD(l1, b_ + 4096); TRRD(h1, b_ + 6144); TRRD(l2, b_ + 8192); TRRD(h2, b_ + 10240); TRRD(l3, b_ + 12288); TRRD(h3, b_ + 14336); \
        asm volatile("s_waitcnt lgkmcnt(0)" ::: "memory"); __builtin_amdgcn_sched_barrier(0); \
        o[d0] = __builtin_amdgcn_mfma_f32_32x32x16_bf16(pa0, (bf16x8){l0[0], l0[1], l0[2], l0[3], h0[0], h0[1], h0[2], h0[3]}, o[d0], 0, 0, 0); \
        o[d0] = __builtin_amdgcn_mfma_f32_32x32x16_bf16(pa1, (bf16x8){l1[0], l1[1], l1[2], l1[3], h1[0], h1[1], h1[2], h1[3]}, o[d0], 0, 0, 0); \
        o[d0] = __builtin_amdgcn_mfma_f32_32x32x16_bf16(pa2, (bf16x8){l2[0], l2[1], l2[2], l2[3], h2[0], h2[1], h2[2], h2[3]}, o[d0], 0, 0, 0); \
        o[d0] = __builtin_amdgcn_mfma_f32_32x32x16_bf16(pa3, (bf16x8){l3[0], l3[1], l3[2], l3[3], h3[0], h3[1], h3[2], h3[3]}, o[d0], 0, 0, 0); } while (0)
                PV_D0(0); PV_D0(1);
#undef PV_D0
#undef TRRD
            }
        }
        const float mf = fmaxf(m_reg, sinkL), al = __builtin_amdgcn_exp2f(m_reg - mf);
        const float lf = l_reg * al + __builtin_amdgcn_exp2f(sinkL - mf);
        if (hi == 0) li_l[r32] = al / lf;
        asm volatile("s_waitcnt lgkmcnt(0)" ::: "memory");
        int tz = lane; asm volatile("" : "+v"(tz));
        const int hz = tz >> 5, rz = tz & 31;
        bf16* Ow = Ob + (size_t)(q0 + rg * 32) * 2048 + qh * 64;
#pragma unroll
        for (int r = 0; r < 16; ++r) {
            const int orow = crow(r, hz);
            const float rl = li_l[orow];
            const unsigned obase = (unsigned)(orow * 2048 + rz);
#pragma unroll
            for (int d0 = 0; d0 < 2; ++d0) {
                const float v = o[d0][r] * rl;
                const float vn = __shfl_xor(v, 1);
                if ((rz & 1) == 0) *(unsigned*)(Ow + obase + d0 * 32) = cvtpk(v, vn);
            }
        }
        asm volatile("s_waitcnt lgkmcnt(0)" ::: "memory");
    }
    __syncthreads();
}

struct Args { const float* in[19]; float* out; unsigned char* ws; int ph_lo, ph_hi; };
enum { I_X = 0, I_WR, I_RB, I_EWIN, I_EQN, I_EWQ, I_EKVN, I_EWKV, I_EFB, I_EWOUT, I_OWIN, I_OSINK, I_OWOUT, I_LMG, I_LMB, I_LFG, I_LFB, I_WGU, I_WDN };
enum { PH_CVT = 0, PH_L0_IN, PH_L0_PREP, PH_L0_UP, PH_L0_ATT, PH_L0_OUT, PH_L0_LN1, PH_L0_MOE1, PH_L0_MOE2, PH_L0_LN2,
       PH_L1_IN, PH_L1_KM, PH_L1_ATT, PH_L1_OUT, PH_L1_LN1, PH_L1_MOE1, PH_L1_MOE2, PH_L1_LN2, NPH };

DEVI void ln_row(const float* hrow, float a, const bf16* y0, const bf16* y1, const float* g, const float* bta, int lane, f32x4 (&v)[8]) {
    float s = 0.f;
#pragma unroll
    for (int j = 0; j < 8; ++j) {
        f32x4 x = *(const f32x4*)(hrow + 4 * lane + 256 * j) * a;
        if (y0) { const uint2 w = *(const uint2*)(y0 + 4 * lane + 256 * j); x += (f32x4){bflo(w.x), bfhi(w.x), bflo(w.y), bfhi(w.y)}; }
        if (y1) { const uint2 w = *(const uint2*)(y1 + 4 * lane + 256 * j); x += (f32x4){bflo(w.x), bfhi(w.x), bflo(w.y), bfhi(w.y)}; }
        v[j] = x; s += (x[0] + x[1]) + (x[2] + x[3]);
    }
    const float mean = wave_sum(s) * (1.f / DM);
    float s2 = 0.f;
#pragma unroll
    for (int j = 0; j < 8; ++j) { v[j] = v[j] - mean; s2 += (v[j][0] * v[j][0] + v[j][1] * v[j][1]) + (v[j][2] * v[j][2] + v[j][3] * v[j][3]); }
    const float rstd = 1.f / sqrtf(wave_sum(s2) * (1.f / DM) + LN_EPS);
#pragma unroll
    for (int j = 0; j < 8; ++j) v[j] = v[j] * rstd * *(const f32x4*)(g + 4 * lane + 256 * j) + *(const f32x4*)(bta + 4 * lane + 256 * j);
}

DEVI void route_select(unsigned* ctl, int* list, float* ew, const float* rb, int layer, int t, float lg, int lane) {
    const float affl = 1.f / (1.f + __expf(-lg));
    const float sell = affl + rb[lane & 31];
    int best = 0; float bests = -__builtin_inff();
#pragma unroll
    for (int gI = 0; gI < 8; ++gI) {
        float m1 = -__builtin_inff(), m2 = -__builtin_inff();
#pragma unroll
        for (int q = 0; q < 4; ++q) { const float x = __shfl(sell, gI * 4 + q); if (x > m1) { m2 = m1; m1 = x; } else if (x > m2) m2 = x; }
        const float sc = m1 + m2;
        if (sc > bests) { bests = sc; best = gI; }
    }
    int e1 = 0, e2 = 0; float s1 = -__builtin_inff(), s2 = -__builtin_inff(), a1 = 0.f, a2 = 0.f;
#pragma unroll
    for (int q = 0; q < 4; ++q) {
        const float af = __shfl(affl, best * 4 + q), x = __shfl(sell, best * 4 + q);
        if (x > s1) { s2 = s1; e2 = e1; a2 = a1; s1 = x; e1 = best * 4 + q; a1 = af; } else if (x > s2) { s2 = x; e2 = best * 4 + q; a2 = af; }
    }
    if (lane == 0) {
        const float inv = 1.f / (a1 + a2);
        ew[t * 2 + 0] = a1 * inv; ew[t * 2 + 1] = a2 * inv;
        const unsigned p1 = atomicAdd(&ctl[CW_CNT + layer * NEXP + e1], 1u); list[e1 * T + p1] = t * 2 + 0;
        const unsigned p2 = atomicAdd(&ctl[CW_CNT + layer * NEXP + e2], 1u); list[e2 * T + p2] = t * 2 + 1;
    }
}
DEVI void phase_ln1_route(const Args& a, float* xrow, int layer, const float* pre, float* hf, bf16* hb, int gw, int ngw, int lane) {
    unsigned* ctl = (unsigned*)(a.ws + WS_CTL);
    int* list = (int*)(a.ws + WS_LIST) + layer * NEXP * T;
    float* ew = (float*)(a.ws + WS_EW);
    const float* g = a.in[I_LMG] + layer * DM; const float* bta = a.in[I_LMB] + layer * DM;
    const float* wr = a.in[I_WR]; const float* rb = a.in[I_RB];
    for (int t0 = gw; t0 < T; t0 += 2 * ngw) {
        const int t1 = t0 + ngw; const bool has1 = t1 < T;
#pragma unroll
        for (int k = 0; k < 2; ++k) {
            const int t = k == 0 ? t0 : t1;
            if (k == 1 && !has1) break;
            f32x4 v[8];
            ln_row(pre + (size_t)t * DM, 1.f, nullptr, nullptr, g, bta, lane, v);
#pragma unroll
            for (int j = 0; j < 8; ++j) {
                *(f32x4*)(hf + (size_t)t * DM + 4 * lane + 256 * j) = v[j];
                uint2 w; w.x = pk2(v[j][0], v[j][1]); w.y = pk2(v[j][2], v[j][3]);
                *(uint2*)(hb + (size_t)t * DM + 4 * lane + 256 * j) = w;
                *(f32x4*)(xrow + k * 2048 + 4 * lane + 256 * j) = v[j];
            }
        }
        __builtin_amdgcn_s_waitcnt(0); __builtin_amdgcn_wave_barrier();
        f32x4 accA = {0.f, 0.f, 0.f, 0.f}, accB = {0.f, 0.f, 0.f, 0.f};
        {
            const int e4 = lane & 7, isub = lane >> 3;
            const float* wp = wr + (size_t)isub * NEXP + 4 * e4;
            const float* xa = xrow + isub; const float* xb = xrow + 2048 + isub;
#pragma unroll 16
            for (int ii = 0; ii < 256; ++ii) {
                const f32x4 w4 = *(const f32x4*)(wp + (size_t)ii * 8 * NEXP);
                accA += w4 * xa[ii * 8]; accB += w4 * xb[ii * 8];
            }
        }
#pragma unroll
        for (int q = 0; q < 4; ++q) {
            accA[q] += __shfl_xor(accA[q], 8); accA[q] += __shfl_xor(accA[q], 16); accA[q] += __shfl_xor(accA[q], 32);
            accB[q] += __shfl_xor(accB[q], 8); accB[q] += __shfl_xor(accB[q], 16); accB[q] += __shfl_xor(accB[q], 32);
        }
        const int src = (lane & 31) >> 2, cq = lane & 3;
        float lA, lB;
        { const float v0 = __shfl(accA[0], src), v1 = __shfl(accA[1], src), v2 = __shfl(accA[2], src), v3 = __shfl(accA[3], src); lA = cq == 0 ? v0 : cq == 1 ? v1 : cq == 2 ? v2 : v3; }
        { const float v0 = __shfl(accB[0], src), v1 = __shfl(accB[1], src), v2 = __shfl(accB[2], src), v3 = __shfl(accB[3], src); lB = cq == 0 ? v0 : cq == 1 ? v1 : cq == 2 ? v2 : v3; }
        route_select(ctl, list, ew, rb, layer, t0, lA, lane);
        if (has1) route_select(ctl, list, ew, rb, layer, t1, lB, lane);
        __builtin_amdgcn_wave_barrier();
    }
}

DEVI void phase_moe(const Args& a, char* lds, int layer, int stage, const bf16* hb, int bid, int nb) {
    unsigned* ctl = (unsigned*)(a.ws + WS_CTL);
    const int* list = (const int*)(a.ws + WS_LIST) + layer * NEXP * T;
    const float* ew = (const float*)(a.ws + WS_EW);
    bf16* hdn = (bf16*)(a.ws + WS_HDN);
    bf16* Y = (bf16*)(a.ws + WS_Y);
    int* sh = (int*)(lds + 131072 + 1024);
    const int ntn = stage == 1 ? 4 : 8;
    if (threadIdx.x == 0) {
        int so = 0, to = 0;
        for (int e = 0; e < NEXP; ++e) { const int c = (int)ctl[CW_CNT + layer * NEXP + e]; sh[e] = so; sh[33 + e] = to; so += c; to += ((c + 255) / 256) * ntn; }
        sh[32] = so; sh[33 + 32] = to;
    }
    __syncthreads();
    g8::MoeOrder S_;
    S_.sh = (const LAS int*)sh; S_.list = list; S_.G = nb; S_.c = bid; S_.stage = stage; S_.ntn = ntn;
    if (stage == 1) {
        S_.A = (const char*)hb; S_.lda = DM; S_.K = DM; S_.W = (const char*)(a.ws + WS_WGU) + (size_t)layer * NEXP * 1024 * DM * 2; S_.wstride = (size_t)1024 * DM * 2;
        g8::EpiMoe1 E_{hdn};
        g8::gemm8((LAS unsigned char*)lds, DM, S_, E_);
    } else {
        S_.A = (const char*)hdn; S_.lda = FF; S_.K = FF; S_.W = (const char*)(a.ws + WS_WDN) + (size_t)layer * NEXP * DM * FF * 2; S_.wstride = (size_t)DM * FF * 2;
        g8::EpiMoe2 E_{Y, list, ew};
        g8::gemm8((LAS unsigned char*)lds, FF, S_, E_);
    }
    __syncthreads();
}

DEVI void phase_ln2(const Args& a, int layer, const float* hf, float* of, bf16* ob, int gw, int ngw, int lane) {
    const bf16* Y = (const bf16*)(a.ws + WS_Y);
    const float* g = a.in[I_LFG] + layer * DM; const float* bta = a.in[I_LFB] + layer * DM;
    for (int t = gw; t < T; t += ngw) {
        f32x4 v[8];
        ln_row(hf + (size_t)t * DM, ALPHA, Y + (size_t)(2 * t) * DM, Y + (size_t)(2 * t + 1) * DM, g, bta, lane, v);
#pragma unroll
        for (int j = 0; j < 8; ++j) {
            *(f32x4*)(of + (size_t)t * DM + 4 * lane + 256 * j) = v[j];
            if (ob) { uint2 w; w.x = pk2(v[j][0], v[j][1]); w.y = pk2(v[j][2], v[j][3]); *(uint2*)(ob + (size_t)t * DM + 4 * lane + 256 * j) = w; }
        }
    }
}

__global__ void __launch_bounds__(NTHREADS, 2) fwd(Args a) {
    extern __shared__ __attribute__((aligned(16))) char lds[];
    const int tid = threadIdx.x, lane = tid & 63, wid = tid >> 6;
    const int bid = blockIdx.x, nb = gridDim.x;
    const int gw = bid * NWAVES + wid, ngw = nb * NWAVES;
    unsigned char* ws = a.ws;
    unsigned* ctl = (unsigned*)(ws + WS_CTL);
    float* FL = (float*)(ws + WS_FL); float* LF = (float*)(ws + WS_LF); float* CUM = (float*)(ws + WS_CUM); float* KM = (float*)(ws + WS_KM);
    bf16* KPE = (bf16*)(ws + WS_KPE); bf16* XB = (bf16*)(ws + WS_XB); bf16* HB = (bf16*)(ws + WS_HB);
    float* HFA = (float*)(ws + WS_HFA); float* HFB = (float*)(ws + WS_HFB); float* PRE = (float*)(ws + WS_PRE);
    bf16* P = (bf16*)(ws + WS_P); bf16* CQN = (bf16*)(ws + WS_CQN); bf16* CKVN = (bf16*)(ws + WS_CKVN);
    bf16* QM = (bf16*)(ws + WS_QM); bf16* KVM = (bf16*)(ws + WS_KVM); bf16* AO = (bf16*)(ws + WS_AO);

    volatile LAS unsigned* xbw = (volatile LAS unsigned*)((LAS char*)lds + LDS_BYTES - 16);
    if (tid < 4) xbw[tid] = 0u;
    __syncthreads();
    XcdBarrier bar; bar.bar = ctl + CW_BAR; bar.x = 0; bar.st = xbw;
#if ONE_LAUNCH
    bar = xcd_barrier_post(ctl + CW_BAR, xbw);
#define SEAM(k) do { if ((k) + 1 < a.ph_hi) xcd_barrier(bar); } while (0)
#else
#define SEAM(k) do { } while (0)
#endif
#define IN(k) (a.ph_lo <= (k) && (k) < a.ph_hi)

    if (IN(PH_CVT)) { for (int rep_ = 0; rep_ < REPS(PH_CVT); ++rep_) {
        const float* x = a.in[I_X];
        for (size_t i = (size_t)bid * NTHREADS + tid; i < (size_t)T * DM / 8; i += (size_t)nb * NTHREADS) {
            const f32x4 v0 = *(const f32x4*)(x + i * 8), v1 = *(const f32x4*)(x + i * 8 + 4);
            u32x4 w; w[0] = pk2(v0[0], v0[1]); w[1] = pk2(v0[2], v0[3]); w[2] = pk2(v1[0], v1[1]); w[3] = pk2(v1[2], v1[3]);
            *(u32x4*)(XB + i * 8) = w;
        }
        {
            LAS float* scr = (LAS float*)((LAS char*)lds + wid * 17408);
            int base = 0;
            auto ident = [](int n0) { return n0; };
            cvt_matrix(a.in[I_EWIN], DM, EVEN_IN, 4096, (bf16*)(ws + WS_WIN0), [](int n0) { return n0 < EVEN_IN ? n0 : -1; }, scr, gw, ngw, lane, base);
            cvt_matrix(a.in[I_EWQ], 512, 1536, 1536, (bf16*)(ws + WS_WQU), ident, scr, gw, ngw, lane, base);
            cvt_matrix(a.in[I_EWKV], 256, 2048, 2048, (bf16*)(ws + WS_WKVU), ident, scr, gw, ngw, lane, base);
            cvt_matrix(a.in[I_EWOUT], DM, DM, DM, (bf16*)(ws + WS_WOUT0), ident, scr, gw, ngw, lane, base);
            cvt_matrix(a.in[I_OWIN], DM, ODD_IN, ODD_IN, (bf16*)(ws + WS_WIN1), ident, scr, gw, ngw, lane, base);
            cvt_matrix(a.in[I_OWOUT], DM, DM, DM, (bf16*)(ws + WS_WOUT1), ident, scr, gw, ngw, lane, base);
            for (int le = 0; le < 2 * NEXP; ++le)
                cvt_matrix(a.in[I_WGU] + (size_t)le * DM * 1024, DM, 1024, 1024, (bf16*)(ws + WS_WGU) + (size_t)le * 1024 * DM,
                           [](int n0) { return ((n0 >> 7) & 1) * 512 + (n0 >> 8) * 128 + (n0 & 127); }, scr, gw, ngw, lane, base);
            for (int le = 0; le < 2 * NEXP; ++le)
                cvt_matrix(a.in[I_WDN] + (size_t)le * FF * DM, FF, DM, DM, (bf16*)(ws + WS_WDN) + (size_t)le * DM * FF, ident, scr, gw, ngw, lane, base);
        }
        }
        SEAM(PH_CVT);
    }
    if (IN(PH_L0_IN)) { for (int rep_ = 0; rep_ < REPS(PH_L0_IN); ++rep_) {
        { g8::DenseOrder S_; S_.init(XB, DM, (const bf16*)(ws + WS_WIN0), T, 4096, DM, nb, bid); g8::EpiBf16 E_{P, LDP, EVEN_IN, FL, E_FL, nullptr, 0}; g8::gemm8((LAS unsigned char*)lds, DM, S_, E_); }
        }
        SEAM(PH_L0_IN);
    }
    if (IN(PH_L0_PREP)) { for (int rep_ = 0; rep_ < REPS(PH_L0_PREP); ++rep_) {
        const float* qn = a.in[I_EQN]; const float* kvn = a.in[I_EKVN]; const float* fb = a.in[I_EFB];
        float nq0 = 0.f, nk0 = 0.f, nq1 = 0.f, nk1 = 0.f;
        for (int t = gw; t < T; t += ngw) {
            const bf16* pr = P + (size_t)t * LDP;
            {
                const u32x4 w = *(const u32x4*)(pr + E_CQ + lane * 8);
                float x[8] = {bflo(w[0]), bfhi(w[0]), bflo(w[1]), bfhi(w[1]), bflo(w[2]), bfhi(w[2]), bflo(w[3]), bfhi(w[3])};
                float ss = 0.f;
#pragma unroll
                for (int i = 0; i < 8; ++i) ss += x[i] * x[i];
                const float r = 1.f / sqrtf(wave_sum(ss) * (1.f / 512.f) + RMS_EPS);
                u32x4 o;
#pragma unroll
                for (int i = 0; i < 4; ++i) o[i] = pk2(x[2 * i] * r * qn[lane * 8 + 2 * i], x[2 * i + 1] * r * qn[lane * 8 + 2 * i + 1]);
                *(u32x4*)(CQN + (size_t)t * 512 + lane * 8) = o;
            }
            {
                const uint2 w = *(const uint2*)(pr + E_CKV + lane * 4);
                float x[4] = {bflo(w.x), bfhi(w.x), bflo(w.y), bfhi(w.y)};
                float ss = x[0] * x[0] + x[1] * x[1] + x[2] * x[2] + x[3] * x[3];
                const float r = 1.f / sqrtf(wave_sum(ss) * (1.f / 256.f) + RMS_EPS);
                uint2 o; o.x = pk2(x[0] * r * kvn[lane * 4], x[1] * r * kvn[lane * 4 + 1]); o.y = pk2(x[2] * r * kvn[lane * 4 + 2], x[3] * r * kvn[lane * 4 + 3]);
                *(uint2*)(CKVN + (size_t)t * 256 + lane * 4) = o;
            }
            if (lane < 32) {
                const float t1 = bf2f(pr[E_KR + lane]), t2 = bf2f(pr[E_KR + 32 + lane]);
                float c, s; rope_cs(t % S, lane, c, s);
                KPE[(size_t)t * 64 + lane] = (bf16)f2bf(t1 * c - t2 * s);
                KPE[(size_t)t * 64 + 32 + lane] = (bf16)f2bf(t1 * s + t2 * c);
            }
            if (lane < 8) {
                const float x = FL[t * 8 + lane] + fb[lane];
                LF[t * 8 + lane] = fminf(x, 0.f) - log1pf(__expf(-fabsf(x)));
            }
            {
                float sq = 0.f, sk = 0.f;
#pragma unroll
                for (int hh = 0; hh < 2; ++hh) {
                    const u32x4 wq = *(const u32x4*)(pr + E_FQ + lane * 16 + hh * 8), wk = *(const u32x4*)(pr + E_FK + lane * 16 + hh * 8);
#pragma unroll
                    for (int i = 0; i < 4; ++i) { sq += bflo(wq[i]) * bflo(wq[i]) + bfhi(wq[i]) * bfhi(wq[i]); sk += bflo(wk[i]) * bflo(wk[i]) + bfhi(wk[i]) * bfhi(wk[i]); }
                }
                sq += __shfl_xor(sq, 1); sq += __shfl_xor(sq, 2); sq += __shfl_xor(sq, 4);
                sk += __shfl_xor(sk, 1); sk += __shfl_xor(sk, 2); sk += __shfl_xor(sk, 4);
                if (t < S) { nq0 = fmaxf(nq0, sq); nk0 = fmaxf(nk0, sk); } else { nq1 = fmaxf(nq1, sq); nk1 = fmaxf(nk1, sk); }
            }
        }
        if ((lane & 7) == 0) {
            const int h = lane >> 3;
            atomicMax(&ctl[CW_NRM + 0 * 16 + h], __float_as_uint(nq0)); atomicMax(&ctl[CW_NRM + 0 * 16 + 8 + h], __float_as_uint(nk0));
            atomicMax(&ctl[CW_NRM + 1 * 16 + h], __float_as_uint(nq1)); atomicMax(&ctl[CW_NRM + 1 * 16 + 8 + h], __float_as_uint(nk1));
        }
        }
        SEAM(PH_L0_PREP);
    }
    if (IN(PH_L0_UP)) { for (int rep_ = 0; rep_ < REPS(PH_L0_UP); ++rep_) {
        if (bid >= nb - 16) {
            const int sq = bid - (nb - 16), b = sq >> 3, h = sq & 7;
            double* sd = (double*)(lds + 4096);
            double v8[8], run = 0.0;
#pragma unroll
            for (int i = 0; i < 8; ++i) { run += (double)LF[(size_t)(b * S + tid * 8 + i) * 8 + h]; v8[i] = run; }
            double inc = run;
#pragma unroll
            for (int o = 1; o < 64; o <<= 1) { const double nbv = __shfl_up(inc, o); if (lane >= o) inc += nbv; }
            if (lane == 63) sd[wid] = inc;
            __syncthreads();
            double off = inc - run;
            for (int w = 0; w < wid; ++w) off += sd[w];
#pragma unroll
            for (int i = 0; i < 8; ++i) CUM[(size_t)sq * S + tid * 8 + i] = (float)(off + v8[i]);
            __syncthreads();
        }
        const int n1 = (T / 128) * (1536 / 128);
        { g8::DenseOrder S_; S_.init(CQN, 512, (const bf16*)(ws + WS_WQU), T, 1536, 512, nb, bid); g8::EpiBf16 E_{QM, 1536, 1536, nullptr, 0, nullptr, 0}; g8::gemm8((LAS unsigned char*)lds, 512, S_, E_); }
        { g8::DenseOrder S_; S_.init(CKVN, 256, (const bf16*)(ws + WS_WKVU), T, 2048, 256, nb, bid); g8::EpiBf16 E_{KVM, 2048, 2048, nullptr, 0, nullptr, 0}; g8::gemm8((LAS unsigned char*)lds, 256, S_, E_); }
        }
        SEAM(PH_L0_UP);
    }
    if (IN(PH_L0_ATT)) { for (int rep_ = 0; rep_ < REPS(PH_L0_ATT); ++rep_) {
        volatile unsigned* qslot = (volatile unsigned*)(lds + FA_Q);
        for (;;) {
            if (tid == 0) *qslot = atomicAdd(&ctl[CW_Q + 0 + 8 * rep_], 1u);
            __syncthreads();
            const int item = __builtin_amdgcn_readfirstlane((int)*qslot);
            __syncthreads();
            if (item >= 512) break;
            const int qb = 31 - (item >> 4), bh = item & 15, b = bh >> 3, h = bh & 7;
            flash_unit<FM_MLA>(lds, QM + (size_t)b * S * 1536 + h * 192, 1536, KVM + (size_t)b * S * 2048 + h * 256, 2048, KVM + (size_t)b * S * 2048 + h * 256 + 128, 2048,
                               KPE + (size_t)b * S * 64, nullptr, nullptr, 0.f, 0.f, qb * 128, AO + (size_t)b * S * 2048 + h * 128, 2048);
        }
        for (;;) {
            if (tid == 0) *qslot = atomicAdd(&ctl[CW_Q + 1 + 8 * rep_], 1u);
            __syncthreads();
            const int item = __builtin_amdgcn_readfirstlane((int)*qslot);
            __syncthreads();
            if (item >= 512) break;
            const int qb = 31 - (item >> 4), bh = item & 15, b = bh >> 3, h = bh & 7;
            const float sb_ = 0.08838834764831845f * sqrtf(__uint_as_float(ctl[CW_NRM + b * 16 + h]) * __uint_as_float(ctl[CW_NRM + b * 16 + 8 + h])) * 1.01f + 0.01f;
            flash_unit<FM_FOX>(lds, P + (size_t)b * S * LDP + E_FQ + h * 128, LDP, P + (size_t)b * S * LDP + E_FK + h * 128, LDP, P + (size_t)b * S * LDP + E_FV + h * 128, LDP,
                               nullptr, CUM + (size_t)bh * S, nullptr, 0.f, sb_, qb * 128, AO + (size_t)b * S * 2048 + 1024 + h * 128, 2048);
        }
        }
        SEAM(PH_L0_ATT);
    }
    if (IN(PH_L0_OUT)) { for (int rep_ = 0; rep_ < REPS(PH_L0_OUT); ++rep_) {
        const float* x = a.in[I_X];
        { g8::DenseOrder S_; S_.init(AO, DM, (const bf16*)(ws + WS_WOUT0), T, DM, DM, nb, bid); g8::EpiRes E_{PRE, x, DM, ALPHA}; g8::gemm8((LAS unsigned char*)lds, DM, S_, E_); }
        }
        SEAM(PH_L0_OUT);
    }
    if (IN(PH_L0_LN1)) { phase_ln1_route(a, (float*)lds + wid * 4096, 0, PRE, HFA, HB, gw, ngw, lane); SEAM(PH_L0_LN1); }
    if (IN(PH_L0_MOE1)) { for (int rep_ = 0; rep_ < REPS(PH_L0_MOE1); ++rep_) phase_moe(a, lds, 0, 1, HB, bid, nb); SEAM(PH_L0_MOE1); }
    if (IN(PH_L0_MOE2)) { for (int rep_ = 0; rep_ < REPS(PH_L0_MOE2); ++rep_) phase_moe(a, lds, 0, 2, HB, bid, nb); SEAM(PH_L0_MOE2); }
    if (IN(PH_L0_LN2)) { for (int rep_ = 0; rep_ < REPS(PH_L0_LN2); ++rep_) phase_ln2(a, 0, HFA, HFB, XB, gw, ngw, lane); SEAM(PH_L0_LN2); }

    if (IN(PH_L1_IN)) {
        { g8::DenseOrder S_; S_.init(XB, DM, (const bf16*)(ws + WS_WIN1), T, ODD_IN, DM, nb, bid); g8::EpiBf16 E_{P, LDP, ODD_IN, nullptr, 0, KM, O_MK}; g8::gemm8((LAS unsigned char*)lds, DM, S_, E_); }
        SEAM(PH_L1_IN);
    }
    if (IN(PH_L1_ATT)) { for (int rep_ = 0; rep_ < REPS(PH_L1_ATT); ++rep_) {
        volatile unsigned* qslot = (volatile unsigned*)(lds + FA_Q);
        const float* sinks = a.in[I_OSINK];
        for (;;) {
            if (tid == 0) *qslot = atomicAdd(&ctl[CW_Q + 2 + 8 * rep_], 1u);
            __syncthreads();
            const int item = __builtin_amdgcn_readfirstlane((int)*qslot);
            __syncthreads();
            if (item >= 512) break;
            const int qb = 31 - (item >> 4), bh = item & 15, b = bh >> 3, h = bh & 7;
            flash_unit<FM_MOBA>(lds, P + (size_t)b * S * LDP + O_MQ + h * 128, LDP, P + (size_t)b * S * LDP + O_MK + h * 128, LDP, P + (size_t)b * S * LDP + O_MV + h * 128, LDP,
                                nullptr, nullptr, KM + (size_t)bh * 16 * 128, exp2f(-(float)(h + 1)), 0.f, qb * 128, AO + (size_t)b * S * 2048 + 1024 + h * 128, 2048);
        }
        for (;;) {
            if (tid == 0) *qslot = atomicAdd(&ctl[CW_Q + 3 + 8 * rep_], 1u);
            __syncthreads();
            const int item = __builtin_amdgcn_readfirstlane((int)*qslot);
            __syncthreads();
            if (item >= 256) break;
            const int qb = item & 63, bk = item >> 6, b = bk >> 1, kvh = bk & 1;
            swa_unit(lds, P + (size_t)b * S * LDP, kvh, qb * 64, sinks, AO + (size_t)b * S * 2048);
        }
        }
        SEAM(PH_L1_ATT);
    }
    if (IN(PH_L1_OUT)) {
        { g8::DenseOrder S_; S_.init(AO, DM, (const bf16*)(ws + WS_WOUT1), T, DM, DM, nb, bid); g8::EpiRes E_{PRE, HFB, DM, ALPHA}; g8::gemm8((LAS unsigned char*)lds, DM, S_, E_); }
        SEAM(PH_L1_OUT);
    }
    if (IN(PH_L1_LN1)) { phase_ln1_route(a, (float*)lds + wid * 4096, 1, PRE, HFA, HB, gw, ngw, lane); SEAM(PH_L1_LN1); }
    if (IN(PH_L1_MOE1)) { phase_moe(a, lds, 1, 1, HB, bid, nb); SEAM(PH_L1_MOE1); }
    if (IN(PH_L1_MOE2)) { phase_moe(a, lds, 1, 2, HB, bid, nb); SEAM(PH_L1_MOE2); }
    if (IN(PH_L1_LN2)) { phase_ln2(a, 1, HFA, a.out, nullptr, gw, ngw, lane); }
#undef IN
#undef SEAM
}

extern "C" void kernel_launch(void* const* d_in, const int* in_sizes, int n_in, void* d_out, int out_size, void* d_ws, size_t ws_size, hipStream_t stream) {
    static int grid = 0;
    if (grid == 0) {
        if (n_in != 19 || out_size != T * DM || ws_size < WS_END) { fprintf(stderr, "kernel_launch: unexpected shapes (n_in %d out %d ws %zu)\n", n_in, out_size, ws_size); grid = -1; return; }
        int dev = 0, cus = 0;
        if (hipGetDevice(&dev) != hipSuccess || hipDeviceGetAttribute(&cus, hipDeviceAttributeMultiprocessorCount, dev) != hipSuccess || cus <= 0) cus = 256;
        (void)hipFuncSetAttribute((const void*)fwd, hipFuncAttributeMaxDynamicSharedMemorySize, LDS_BYTES);
        int per_cu = 0;
        if (hipOccupancyMaxActiveBlocksPerMultiprocessor(&per_cu, (const void*)fwd, NTHREADS, LDS_BYTES) != hipSuccess || per_cu < 1) fprintf(stderr, "kernel_launch: occupancy query says %d\n", per_cu);
        (void)hipGetLastError();
        grid = cus;
    }
    if (grid < 0) return;
    (void)in_sizes;
    (void)hipMemsetAsync((char*)d_ws + WS_CTL, 0, CTL_BYTES, stream);
    Args a{};
    for (int i = 0; i < 19; ++i) a.in[i] = (const float*)d_in[i];
    a.out = (float*)d_out; a.ws = (unsigned char*)d_ws;
#if ONE_LAUNCH
    a.ph_lo = 0; a.ph_hi = NPH;
    hipLaunchKernelGGL(fwd, dim3(grid), dim3(NTHREADS), LDS_BYTES, stream, a);
#if PROBE_PH >= 0
    (void)hipMemsetAsync((char*)d_ws + WS_CTL + CW_Q * 4, 0, 256, stream);
    (void)hipMemsetAsync((char*)d_ws + WS_CTL + CW_BAR * 4, 0, XCD_BAR_WORDS * 4, stream);
    a.ph_lo = PROBE_PH; a.ph_hi = PROBE_PH + 1;
    hipLaunchKernelGGL(fwd, dim3(grid), dim3(NTHREADS), LDS_BYTES, stream, a);
#endif
#else
    for (int p = 0; p < NPH; ++p) { a.ph_lo = p; a.ph_hi = p + 1; hipLaunchKernelGGL(fwd, dim3(grid), dim3(NTHREADS), LDS_BYTES, stream, a); }
#endif
}
```

```cpp
#include <hip/hip_runtime.h>
#include <stdint.h>
#include <stdio.h>

#ifndef PROBE_REP
#define PROBE_REP -1
#endif
#define REPS(k) ((PROBE_REP) == (k) ? 2 : 1)
#ifndef PROBE_PH
#define PROBE_PH -1
#endif
#ifndef ONE_LAUNCH
#define ONE_LAUNCH 1
#endif

#define DEVI __device__ __forceinline__
#define LAS __attribute__((address_space(3)))
typedef unsigned short bf16;
typedef short bf16x8 __attribute__((ext_vector_type(8)));
typedef float f32x4 __attribute__((ext_vector_type(4)));
typedef unsigned u32x4 __attribute__((ext_vector_type(4)));

constexpr int S = 4096, NBATCH = 2, T = NBATCH * S, DM = 2048;
constexpr int LDP = 4352;
constexpr int EVEN_IN = 3912, ODD_IN = 4352;
constexpr float LN_EPS = 1e-5f, RMS_EPS = 1e-6f;
constexpr float ALPHA = 1.4142135623730951f;
constexpr int NEXP = 32, FF = 512;
constexpr int E_CQ = 0, E_CKV = 512, E_KR = 768, E_FQ = 832, E_FK = 1856, E_FV = 2880, E_FL = 3904;
constexpr int O_SQ = 0, O_SK = 1024, O_SV = 1152, O_MQ = 1280, O_MK = 2304, O_MV = 3328;

constexpr size_t MiB = 1u << 20;
constexpr size_t WS_CTL = 0, CTL_BYTES = 1 * MiB;
constexpr int CW_CNT = 1024;
constexpr int CW_BAR = 4096;
constexpr int CW_NRM = 1200;
constexpr int CW_Q = 1100;
constexpr size_t WS_LIST = 2 * MiB;
constexpr size_t WS_EW = 4 * MiB;
constexpr size_t WS_BC = 4 * MiB + 256 * 1024;
constexpr size_t WS_FL = 5 * MiB;
constexpr size_t WS_LF = 5 * MiB + 512 * 1024;
constexpr size_t WS_CUM = 6 * MiB;
constexpr size_t WS_KM = 512 * 1024;
constexpr size_t WS_KPE = 7 * MiB;
constexpr size_t WS_XB = 16 * MiB;
constexpr size_t WS_HB = 48 * MiB;
constexpr size_t WS_HFA = 80 * MiB;
constexpr size_t WS_HFB = 144 * MiB;
constexpr size_t WS_PRE = 208 * MiB;
constexpr size_t WS_P = 272 * MiB;
constexpr size_t WS_CQN = 340 * MiB;
constexpr size_t WS_CKVN = 348 * MiB;
constexpr size_t WS_QM = 352 * MiB;
constexpr size_t WS_KVM = 376 * MiB;
constexpr size_t WS_AO = 408 * MiB;
constexpr size_t WS_HDN = 440 * MiB;
constexpr size_t WS_Y = 464 * MiB;
constexpr size_t WS_WIN0 = 600 * MiB;
constexpr size_t WS_WQU = 616 * MiB;
constexpr size_t WS_WKVU = 618 * MiB;
constexpr size_t WS_WOUT0 = 620 * MiB;
constexpr size_t WS_WIN1 = 628 * MiB;
constexpr size_t WS_WOUT1 = 646 * MiB;
constexpr size_t WS_WGU = 656 * MiB;
constexpr size_t WS_WDN = 912 * MiB;
constexpr size_t WS_WRH = 1040 * MiB;
constexpr size_t WS_WRL = 1040 * MiB + 256 * 1024;
constexpr size_t WS_END = 1041 * MiB;

constexpr int LDS_BYTES = 163840;
constexpr int LDS_SH = 131072 + 1024, LDS_PRE = 135168, LDS_CNTL = 152576;
constexpr int NTHREADS = 512, NWAVES = 8;

DEVI unsigned f2bf(float f) { unsigned u = __float_as_uint(f); return (u + 0x7fffu + ((u >> 16) & 1u)) >> 16; }
DEVI float bf2f(unsigned b) { return __uint_as_float(b << 16); }
DEVI float bflo(unsigned w) { return __uint_as_float(w << 16); }
DEVI float bfhi(unsigned w) { return __uint_as_float(w & 0xffff0000u); }
DEVI unsigned pk2(float lo, float hi) { return f2bf(lo) | (f2bf(hi) << 16); }
DEVI float wave_sum(float v) {
#pragma unroll
    for (int o = 1; o < 64; o <<= 1) v += __shfl_xor(v, o);
    return v;
}
DEVI float wave_max(float v) {
#pragma unroll
    for (int o = 1; o < 64; o <<= 1) v = fmaxf(v, __shfl_xor(v, o));
    return v;
}
DEVI void rope_cs(int t, int i, float& c, float& s) {
    const float inv_freq = exp2f(-(float)i * (13.287712379549449f / 32.0f));
    double rev = (double)t * (double)inv_freq * 0.15915494309189535;
    rev -= floor(rev);
    const float a = (float)(rev * 6.283185307179586);
    c = __cosf(a); s = __sinf(a);
}

#define XB_TMO      128
#define XB_XCNT(j)  (256  + 64 * (j))
#define XB_XSUB(j)  (1280 + 64 * (j))
#define XB_XGEN(j)  (2304 + 64 * (j))
#define XB_TOP      3328
#define XB_TOPGEN   3392
#define XCD_BAR_WORDS 3456
#define XB_SPIN_CAP (1u << 18)
DEVI unsigned xb_ld(unsigned* p)              { return __hip_atomic_load(p, __ATOMIC_RELAXED, __HIP_MEMORY_SCOPE_AGENT); }
DEVI unsigned xb_add(unsigned* p, unsigned v) { return __hip_atomic_fetch_add(p, v, __ATOMIC_RELAXED, __HIP_MEMORY_SCOPE_AGENT); }
DEVI unsigned xb_xcc_id() { return (unsigned)__builtin_amdgcn_s_getreg((3 << 11) | 20) & 0xFu; }
#define XB_SPIN(cond, bar) do { unsigned _sp = 0; while (cond) { __builtin_amdgcn_s_sleep(1); \
    if ((++_sp & 255u) == 0u) { if (xb_ld(&(bar)[XB_TMO])) break; if (_sp > XB_SPIN_CAP) { atomicAdd(&(bar)[XB_TMO], 1u); break; } } } } while (0)
struct XcdBarrier { unsigned* bar; unsigned x; volatile LAS unsigned* st; };
DEVI XcdBarrier xcd_barrier_post(unsigned* bar, volatile LAS unsigned* st) {
    XcdBarrier b; b.bar = bar; b.x = xb_xcc_id(); b.st = st;
    if (threadIdx.x == 0) (void)xb_add(&bar[XB_XCNT(b.x)], 1u);
    return b;
}
DEVI void xcd_barrier_complete(unsigned* bar, unsigned x, unsigned& nloc, unsigned& nx) {
    const unsigned G = gridDim.x * gridDim.y * gridDim.z;
    unsigned sum, cnt, mine, sp = 0u;
    for (;;) {
        sum = 0u; cnt = 0u; mine = 0u;
#pragma unroll
        for (unsigned j = 0; j < 16; ++j) { const unsigned c = xb_ld(&bar[XB_XCNT(j)]); sum += c; cnt += (c > 0u) ? 1u : 0u; mine = (j == x) ? c : mine; }
        if (sum == G) break;
        __builtin_amdgcn_s_sleep(1);
        if ((++sp & 255u) == 0u) { if (xb_ld(&bar[XB_TMO])) break; if (sp > XB_SPIN_CAP) { atomicAdd(&bar[XB_TMO], 1u); break; } }
    }
    nloc = mine > 0u ? mine : 1u; nx = cnt > 0u ? cnt : 1u;
}
DEVI void xcd_barrier(const XcdBarrier& b) {
    asm volatile("s_waitcnt vmcnt(0)" ::: "memory");
    __syncthreads();
    if (threadIdx.x == 0) {
        unsigned* bar = b.bar;
        __builtin_amdgcn_s_waitcnt(0);
        unsigned nloc = b.st[0], nx = b.st[1];
        if (nloc == 0u) { xcd_barrier_complete(bar, b.x, nloc, nx); b.st[0] = nloc; b.st[1] = nx; }
        const unsigned old = xb_add(&bar[XB_XSUB(b.x)], 1u);
        const unsigned gen = old / nloc;
        if (old + 1u == (gen + 1u) * nloc) {
            __builtin_amdgcn_fence(__ATOMIC_RELEASE, "agent");
            asm volatile("s_waitcnt vmcnt(0)" ::: "memory");
            const unsigned og = xb_add(&bar[XB_TOP], 1u);
            const unsigned tg = og / nx;
            if (og + 1u == (tg + 1u) * nx) xb_add(&bar[XB_TOPGEN], 1u);
            else XB_SPIN(xb_ld(&bar[XB_TOPGEN]) == tg, bar);
            __builtin_amdgcn_fence(__ATOMIC_ACQUIRE, "agent");
            xb_add(&bar[XB_XGEN(b.x)], 1u);
            asm volatile("s_waitcnt vmcnt(0)" ::: "memory");
        } else {
            XB_SPIN(xb_ld(&bar[XB_XGEN(b.x)]) == gen, bar);
            __builtin_amdgcn_fence(__ATOMIC_ACQUIRE, "agent");
            asm volatile("s_waitcnt vmcnt(0)" ::: "memory");
        }
    }
    __syncthreads();
}

template <class RowMap, class ColMap, class Epi>
DEVI void gemm_tile(char* lds, int K, const bf16* __restrict__ A, int lda, const float* __restrict__ W, int ldw,
                    RowMap rowmap, ColMap colmap, Epi epi) {
    bf16* sA = (bf16*)lds;
    bf16* sB = sA + 128 * 40;
    const int tid = threadIdx.x, lane = tid & 63, wid = tid >> 6, wm = wid >> 1, wn = wid & 1;
    const int ar = tid >> 2, ac = (tid & 3) * 8;
    const int src_row = rowmap(ar);
    const bf16* aptr = A + (size_t)(src_row < 0 ? 0 : src_row) * lda + ac;
    const int bk = tid >> 4, bn = (tid & 15) * 8;
    const int pcol = colmap(bn);
    const float* wptr = W + (size_t)bk * ldw + (pcol < 0 ? 0 : pcol);
    f32x4 acc[2][4];
#pragma unroll
    for (int a = 0; a < 2; ++a)
#pragma unroll
        for (int b = 0; b < 4; ++b) acc[a][b] = (f32x4){0.f, 0.f, 0.f, 0.f};
    u32x4 ra; f32x4 rb0, rb1;
    ra = (u32x4){0u, 0u, 0u, 0u}; rb0 = (f32x4){0.f, 0.f, 0.f, 0.f}; rb1 = rb0;
    if (src_row >= 0) ra = *(const u32x4*)(aptr);
    if (pcol >= 0) { rb0 = *(const f32x4*)(wptr); rb1 = *(const f32x4*)(wptr + 4); }
    for (int k0 = 0; k0 < K; k0 += 32) {
        *(u32x4*)(sA + ar * 40 + ac) = ra;
#pragma unroll
        for (int j = 0; j < 4; ++j) { sB[(bn + j) * 40 + bk] = (bf16)f2bf(rb0[j]); sB[(bn + 4 + j) * 40 + bk] = (bf16)f2bf(rb1[j]); }
        __syncthreads();
        if (k0 + 32 < K) {
            if (src_row >= 0) ra = *(const u32x4*)(aptr + k0 + 32);
            if (pcol >= 0) { rb0 = *(const f32x4*)(wptr + (size_t)(k0 + 32) * ldw); rb1 = *(const f32x4*)(wptr + (size_t)(k0 + 32) * ldw + 4); }
        }
        bf16x8 af[2], bfr[4];
#pragma unroll
        for (int mf = 0; mf < 2; ++mf) af[mf] = *(const bf16x8*)(sA + (wm * 32 + mf * 16 + (lane & 15)) * 40 + (lane >> 4) * 8);
#pragma unroll
        for (int nf = 0; nf < 4; ++nf) bfr[nf] = *(const bf16x8*)(sB + (wn * 64 + nf * 16 + (lane & 15)) * 40 + (lane >> 4) * 8);
#pragma unroll
        for (int mf = 0; mf < 2; ++mf)
#pragma unroll
            for (int nf = 0; nf < 4; ++nf) acc[mf][nf] = __builtin_amdgcn_mfma_f32_16x16x32_bf16(af[mf], bfr[nf], acc[mf][nf], 0, 0, 0);
        __syncthreads();
    }
    epi(acc, wm, wn, lane);
}
template <class F> DEVI void for_each_acc(const f32x4 (&acc)[2][4], int wm, int wn, int lane, F f) {
#pragma unroll
    for (int mf = 0; mf < 2; ++mf)
#pragma unroll
        for (int nf = 0; nf < 4; ++nf)
#pragma unroll
            for (int j = 0; j < 4; ++j) f(wm * 32 + mf * 16 + (lane >> 4) * 4 + j, wn * 64 + nf * 16 + (lane & 15), acc[mf][nf][j]);
}

template <class Store>
DEVI void gemm_dense(char* lds, int M, int N, int K, const bf16* A, int lda, const float* W, int ldw, Store store, int item0, int nitems_total, int bid, int nb) {
    const int ntn = (N + 127) / 128, ntm = M / 128, nt = ntm * ntn;
    (void)nitems_total;
    for (int it = bid; it < item0 + nt; it += nb) {
        if (it < item0) continue;
        const int t = it - item0, tm = t / ntn, tn = t % ntn;
        gemm_tile(lds, K, A, lda, W, ldw,
                  [&](int r) { return tm * 128 + r; },
                  [&](int c) { const int pc = tn * 128 + c; return pc < N ? pc : -1; },
                  [&](const f32x4 (&acc)[2][4], int wm, int wn, int lane) {
                      for_each_acc(acc, wm, wn, lane, [&](int r, int c, float v) { const int n = tn * 128 + c; if (n < N) store(tm * 128 + r, n, v); });
                  });
    }
}


namespace g8 {
constexpr int BM = 256, BK = 64, HALF = 128, HTB = HALF * BK * 2, STAGE_BYTES = 8 * HTB, NXCD = 8, WGM = 8;
DEVI int lds_byte(int r, int c) { const int st = (r >> 4) * 2 + (c >> 5), rr = r & 15, cc = c & 31, ob = rr * 64 + cc * 2; return st * 1024 + (ob ^ (((ob >> 9) & 1) << 5)); }
DEVI void stage_rc(int b, int& R, int& C) { const int st = b / 1024, sb = b % 1024, swz = sb ^ (((sb >> 9) & 1) << 5); R = (st >> 1) * 16 + swz / 64; C = (st & 1) * 32 + (swz % 64) / 2; }
struct U { int pm, pn; const char* A; const char* Bt; int x0, x1, x2, x3; };
struct DenseOrder {
    int nM, nN, nwg, G, c, lda, K; const char* A; const char* Bt;
    DEVI void init(const bf16* A_, int lda_, const bf16* Bt_, int M, int N, int K_, int G_, int c_) { nM = M / BM; nN = N / BM; nwg = nM * nN; G = G_; c = c_; lda = lda_; K = K_; A = (const char*)A_; Bt = (const char*)Bt_; }
    DEVI bool next(int i, U& u) const {
        const long L = (long)i * G + c; if (L >= nwg) return false;
        int wgid = (int)L; { const int q = nwg / NXCD, r = nwg % NXCD, xcd = wgid % NXCD, off = wgid / NXCD; wgid = (xcd < r ? xcd * (q + 1) : r * (q + 1) + (xcd - r) * q) + off; }
        const int nig = WGM * nN, gid = wgid / nig, fm = gid * WGM, gsz = (nM - fm) < WGM ? (nM - fm) : WGM;
        u.pm = fm + ((wgid % nig) % gsz); u.pn = (wgid % nig) / gsz; u.A = A; u.Bt = Bt + (size_t)u.pn * BM * K * 2; return true;
    }
    DEVI unsigned a_off(const U& u, int h, int R, int C) const { return (unsigned)((u.pm * BM + h * HALF + R) * lda + C) * 2u; }
};
template <class Sched, class Epi>
DEVI void gemm8(LAS unsigned char* lds, const int K, const Sched& S, const Epi& E) {
    const int tid = threadIdx.x, wid = __builtin_amdgcn_readfirstlane(tid >> 6), lane = tid & 63, wr = wid >> 2, wc = wid & 3, fr = lane & 15, fq = lane >> 4;
    const int nt = K / BK;
    int Rr[2], Cc[2]; unsigned vb[2];
#pragma unroll
    for (int i = 0; i < 2; ++i) { stage_rc(tid * 16 + i * 8192, Rr[i], Cc[i]); vb[i] = (unsigned)(Rr[i] * K + Cc[i]) * 2u; }
    const size_t kstep = (size_t)(BK * 2), hstepB = (size_t)HALF * K * 2;
    const unsigned ldsw = (unsigned)wid * 1024u;
    const int aoff = lds_byte(wr * 64 + fr, fq * 8), boff = lds_byte(wc * 32 + fr, fq * 8);
#define G8_SA(b, h) (((b) * 2 + (h)) * HTB)
#define G8_SB(b, h) ((4 + (b) * 2 + (h)) * HTB)
#define G8_STAGE(bufoff, gbase, v0, v1) do { \
        __builtin_amdgcn_global_load_lds((const unsigned*)((const char*)(gbase) + (v0)), (LAS unsigned*)(lds + (bufoff) + ldsw), 16, 0, 0); \
        __builtin_amdgcn_global_load_lds((const unsigned*)((const char*)(gbase) + (v1)), (LAS unsigned*)(lds + (bufoff) + ldsw + 8192), 16, 0, 0); } while (0)
#define G8_LDA(dst, b, h) do { _Pragma("unroll") for (int m = 0; m < 4; ++m) _Pragma("unroll") for (int k = 0; k < 2; ++k) dst[m][k] = *(const LAS bf16x8*)(lds + G8_SA(b, h) + aoff + m * 2048 + k * 1024); } while (0)
#define G8_LDB(dst, b, h) do { _Pragma("unroll") for (int n = 0; n < 2; ++n) _Pragma("unroll") for (int k = 0; k < 2; ++k) dst[n][k] = *(const LAS bf16x8*)(lds + G8_SB(b, h) + boff + n * 2048 + k * 1024); } while (0)
#define G8_MMA(ai, bj, At, Bt) do { __builtin_amdgcn_s_setprio(1); _Pragma("unroll") for (int m = 0; m < 4; ++m) _Pragma("unroll") for (int n = 0; n < 2; ++n) _Pragma("unroll") for (int k = 0; k < 2; ++k) \
        acc[ai][bj][m][n] = __builtin_amdgcn_mfma_f32_16x16x32_bf16(Bt[n][k], At[m][k], acc[ai][bj][m][n], 0, 0, 0); __builtin_amdgcn_s_setprio(0); } while (0)
#define G8_WAIT_V(n) asm volatile("s_waitcnt vmcnt(" #n ")" ::: "memory")
#define G8_WAIT_L(n) asm volatile("s_waitcnt lgkmcnt(" #n ")" ::: "memory")
#define G8_BAR __builtin_amdgcn_s_barrier()
#define G8_SCHED __builtin_amdgcn_sched_barrier(0)
    U cur, nxt; int ui = 0;
    if (!S.next(0, cur)) return;
    f32x4 acc[2][2][4][2];
#pragma unroll
    for (int a = 0; a < 2; ++a)
#pragma unroll
        for (int b = 0; b < 2; ++b)
#pragma unroll
            for (int m = 0; m < 4; ++m)
#pragma unroll
                for (int n = 0; n < 2; ++n) acc[a][b][m][n] = (f32x4){0.f, 0.f, 0.f, 0.f};
    bf16x8 At[4][2], B0[2][2], B1[2][2];
    unsigned ac00 = S.a_off(cur, 0, Rr[0], Cc[0]), ac01 = S.a_off(cur, 0, Rr[1], Cc[1]), ac10 = S.a_off(cur, 1, Rr[0], Cc[0]), ac11 = S.a_off(cur, 1, Rr[1], Cc[1]);
    const char* cA = cur.A; const char* cB = cur.Bt;
    G8_STAGE(G8_SB(0, 0), cB, vb[0], vb[1]); G8_STAGE(G8_SA(0, 0), cA, ac00, ac01); G8_STAGE(G8_SB(0, 1), cB + hstepB, vb[0], vb[1]); G8_STAGE(G8_SA(0, 1), cA, ac10, ac11);
    if (wr == 1) G8_BAR;
    G8_WAIT_V(4); G8_BAR;
    G8_STAGE(G8_SB(1, 0), cB + kstep, vb[0], vb[1]); G8_STAGE(G8_SA(1, 0), cA + kstep, ac00, ac01); G8_STAGE(G8_SB(1, 1), cB + hstepB + kstep, vb[0], vb[1]);
    G8_WAIT_V(6); G8_BAR;
    for (;;) {
        const bool has_next = S.next(ui + 1, nxt);
        const char* nA = has_next ? nxt.A : cA; const char* nB = has_next ? nxt.Bt : cB;
        unsigned an00 = ac00, an01 = ac01, an10 = ac10, an11 = ac11;
        if (has_next) { an00 = S.a_off(nxt, 0, Rr[0], Cc[0]); an01 = S.a_off(nxt, 0, Rr[1], Cc[1]); an10 = S.a_off(nxt, 1, Rr[0], Cc[0]); an11 = S.a_off(nxt, 1, Rr[1], Cc[1]); }
        for (int t = 0; t < nt; t += 2) {
            const bool last = (t == nt - 2);
            const char* a1 = cA + (size_t)(t + 1) * kstep;
            const char* a2 = last ? nA : cA + (size_t)(t + 2) * kstep; const char* b2 = last ? nB : cB + (size_t)(t + 2) * kstep;
            const char* a3 = a2 + kstep; const char* b3 = b2 + kstep;
            const unsigned s00 = last ? an00 : ac00, s01 = last ? an01 : ac01, s10 = last ? an10 : ac10, s11 = last ? an11 : ac11;
            G8_LDB(B0, 0, 0); G8_SCHED; G8_LDA(At, 0, 0); G8_STAGE(G8_SA(1, 1), a1, ac10, ac11);
            G8_WAIT_L(8); G8_BAR; G8_WAIT_L(0); G8_MMA(0, 0, At, B0); G8_BAR; G8_SCHED;
            G8_LDB(B1, 0, 1); G8_STAGE(G8_SB(0, 0), b2, vb[0], vb[1]);
            G8_BAR; G8_WAIT_L(0); G8_MMA(0, 1, At, B1); G8_BAR;
            G8_LDA(At, 0, 1); G8_STAGE(G8_SA(0, 0), a2, s00, s01);
            G8_BAR; G8_WAIT_L(0); G8_MMA(1, 0, At, B0); G8_BAR; G8_SCHED;
            G8_STAGE(G8_SB(0, 1), b2 + hstepB, vb[0], vb[1]);
            G8_WAIT_V(6); G8_BAR; G8_MMA(1, 1, At, B1); G8_BAR;
            G8_LDB(B0, 1, 0); G8_SCHED; G8_LDA(At, 1, 0); G8_STAGE(G8_SA(0, 1), a2, s10, s11);
            G8_WAIT_L(8); G8_BAR; G8_WAIT_L(0); G8_MMA(0, 0, At, B0); G8_BAR; G8_SCHED;
            G8_LDB(B1, 1, 1); G8_STAGE(G8_SB(1, 0), b3, vb[0], vb[1]);
            G8_BAR; G8_WAIT_L(0); G8_MMA(0, 1, At, B1); G8_BAR;
            G8_LDA(At, 1, 1); G8_STAGE(G8_SA(1, 0), a3, s00, s01);
            G8_BAR; G8_WAIT_L(0); G8_MMA(1, 0, At, B0); G8_BAR; G8_SCHED;
            G8_STAGE(G8_SB(1, 1), b3 + hstepB, vb[0], vb[1]);
            G8_WAIT_V(6); G8_BAR; G8_MMA(1, 1, At, B1); G8_BAR;
        }
        E(acc, cur, wr, wc, fr, fq);
        if (!has_next) break;
#pragma unroll
        for (int a = 0; a < 2; ++a)
#pragma unroll
            for (int b = 0; b < 2; ++b)
#pragma unroll
                for (int m = 0; m < 4; ++m)
#pragma unroll
                    for (int n = 0; n < 2; ++n) acc[a][b][m][n] = (f32x4){0.f, 0.f, 0.f, 0.f};
        cur = nxt; cA = nA; cB = nB; ac00 = an00; ac01 = an01; ac10 = an10; ac11 = an11; ++ui;
    }
    G8_WAIT_V(0);
    if (wr == 0) G8_BAR;
    G8_BAR;
#undef G8_SA
#undef G8_SB
#undef G8_STAGE
#undef G8_LDA
#undef G8_LDB
#undef G8_MMA
#undef G8_WAIT_V
#undef G8_WAIT_L
#undef G8_BAR
#undef G8_SCHED
}
struct EpiBf16 {
    bf16* O; int ld, ncols; float* FL; int fl0; float* KMs; int km0;
    DEVI void operator()(const f32x4 (&acc)[2][2][4][2], const U& u, int wr, int wc, int fr, int fq) const {
        const int row0 = u.pm * BM + wr * 64 + fr, col0 = u.pn * BM + wc * 32 + 4 * fq;
        if (KMs && u.pn * BM >= km0 && u.pn * BM < km0 + 1024) {
#pragma unroll
            for (int bj = 0; bj < 2; ++bj)
#pragma unroll
                for (int n = 0; n < 2; ++n) {
                    f32x4 sv = acc[0][bj][0][n];
#pragma unroll
                    for (int m = 1; m < 4; ++m) sv += acc[0][bj][m][n];
#pragma unroll
                    for (int m = 0; m < 4; ++m) sv += acc[1][bj][m][n];
#pragma unroll
                    for (int q = 0; q < 4; ++q) { float x = sv[q]; x += __shfl_xor(x, 1); x += __shfl_xor(x, 2); x += __shfl_xor(x, 4); x += __shfl_xor(x, 8); sv[q] = x; }
                    if (fr == 0) { const int cc = col0 + bj * HALF + n * 16 - km0; float* dst = KMs + ((size_t)((u.pm >> 4) * 8 + (cc >> 7)) * 16 + (u.pm & 15)) * 128 + (cc & 127);
#pragma unroll
                        for (int q = 0; q < 4; ++q) atomicAdd(dst + q, sv[q]); }
                }
        }
#pragma unroll
        for (int ai = 0; ai < 2; ++ai)
#pragma unroll
            for (int m = 0; m < 4; ++m) { const int row = row0 + ai * HALF + m * 16;
#pragma unroll
                for (int bj = 0; bj < 2; ++bj)
#pragma unroll
                    for (int n = 0; n < 2; ++n) { const int col = col0 + bj * HALF + n * 16; const f32x4 v = acc[ai][bj][m][n];
                        if (col < ncols) { uint2 w; w.x = pk2(v[0], v[1]); w.y = pk2(v[2], v[3]); *(uint2*)(O + (size_t)row * ld + col) = w;
                            if (FL && col >= fl0) *(f32x4*)(FL + (size_t)row * 8 + (col - fl0)) = v; } } }
    }
};
struct EpiRes {
    float* C; const float* res; int ld; float alpha;
    DEVI void operator()(const f32x4 (&acc)[2][2][4][2], const U& u, int wr, int wc, int fr, int fq) const {
        const int row0 = u.pm * BM + wr * 64 + fr, col0 = u.pn * BM + wc * 32 + 4 * fq;
#pragma unroll
        for (int ai = 0; ai < 2; ++ai)
#pragma unroll
            for (int m = 0; m < 4; ++m) { const size_t ro = (size_t)(row0 + ai * HALF + m * 16) * ld + col0;
#pragma unroll
                for (int bj = 0; bj < 2; ++bj)
#pragma unroll
                    for (int n = 0; n < 2; ++n) { const size_t o = ro + bj * HALF + n * 16; *(f32x4*)(C + o) = *(const f32x4*)(res + o) * alpha + acc[ai][bj][m][n]; } }
    }
};

DEVI int moe_entry(const LAS unsigned short* pre, const int* list, int e, int i) {
    const LAS unsigned short* p = pre + e * 256; int lo = 0;
#pragma unroll
    for (int step = 128; step >= 1; step >>= 1) { if ((int)p[lo + step] <= i) lo += step; }
    return list[e * T + lo * 32 + (i - (int)p[lo])];
}
struct MoeOrder {
    const LAS int* sh; const LAS unsigned short* pre; const int* list; const char* A; const char* W; int lda, K, ntn, G, c, stage; size_t wstride;
    DEVI bool next(int i, U& u) const {
        const int L = i * G + c; if (L >= sh[33 + 32]) return false;
        int e = 0; while (sh[33 + e + 1] <= L) ++e;
        const int r = L - sh[33 + e]; u.pm = r / ntn; u.pn = r % ntn; u.x0 = e; u.x1 = sh[e + 1] - sh[e]; u.x2 = sh[e];
        u.A = A; u.Bt = W + (size_t)e * wstride + (size_t)u.pn * BM * K * 2; return true;
    }
    DEVI unsigned a_off(const U& u, int h, int R, int C) const {
        int i = u.pm * BM + h * HALF + R; if (i > u.x1 - 1) i = u.x1 - 1;
        const int row = stage == 1 ? (moe_entry(pre, list, u.x0, i) >> 1) : (u.x2 + i);
        return (unsigned)(row * lda + C) * 2u;
    }
};
struct EpiMoe1 {
    bf16* hdn;
    DEVI void operator()(const f32x4 (&acc)[2][2][4][2], const U& u, int wr, int wc, int fr, int fq) const {
        const int i0 = u.pm * BM + wr * 64 + fr, j0 = u.pn * HALF + wc * 32 + 4 * fq;
#pragma unroll
        for (int ai = 0; ai < 2; ++ai)
#pragma unroll
            for (int m = 0; m < 4; ++m) { const int i = i0 + ai * HALF + m * 16;
                if (i < u.x1) {
#pragma unroll
                    for (int n = 0; n < 2; ++n) { const f32x4 gv = acc[ai][0][m][n], uv = acc[ai][1][m][n]; float hv[4];
#pragma unroll
                        for (int q = 0; q < 4; ++q) hv[q] = gv[q] / (1.f + __expf(-gv[q])) * uv[q];
                        uint2 w; w.x = pk2(hv[0], hv[1]); w.y = pk2(hv[2], hv[3]);
                        *(uint2*)(hdn + (size_t)(u.x2 + i) * FF + j0 + n * 16) = w; } } }
    }
};
struct EpiMoe2 {
    bf16* Y; const int* list; const float* ew; const LAS unsigned short* pre;
    DEVI void operator()(const f32x4 (&acc)[2][2][4][2], const U& u, int wr, int wc, int fr, int fq) const {
        const int i0 = u.pm * BM + wr * 64 + fr, col0 = u.pn * BM + wc * 32 + 4 * fq;
#pragma unroll
        for (int ai = 0; ai < 2; ++ai)
#pragma unroll
            for (int m = 0; m < 4; ++m) { const int i = i0 + ai * HALF + m * 16;
                if (i < u.x1) { const int ent = moe_entry(pre, list, u.x0, i); const float wt = ew[ent]; bf16* yr = Y + (size_t)ent * DM + col0;
#pragma unroll
                    for (int bj = 0; bj < 2; ++bj)
#pragma unroll
                        for (int n = 0; n < 2; ++n) { const f32x4 v = acc[ai][bj][m][n] * wt; uint2 w; w.x = pk2(v[0], v[1]); w.y = pk2(v[2], v[3]); *(uint2*)(yr + bj * HALF + n * 16) = w; } } }
    }
};
}

DEVI void transpose_item64(const float* W, int K, int Nsrc, int src_c0, bf16* WT, int dst_r0, int k0, LAS float* scr, int lane) {
    const int cq = 4 * (lane & 15), kq = lane >> 4;
    const bool ok = src_c0 >= 0 && (src_c0 + cq + 3) < Nsrc;
    const float* wp = W + (size_t)(k0 + kq) * Nsrc + (src_c0 < 0 ? 0 : src_c0) + cq;
    f32x4 v[16];
#pragma unroll
    for (int i = 0; i < 16; ++i) v[i] = ok ? *(const f32x4*)(wp + (size_t)(4 * i) * Nsrc) : (f32x4){0.f, 0.f, 0.f, 0.f};
#pragma unroll
    for (int i = 0; i < 16; ++i) { const int k = 4 * i + kq; *(LAS f32x4*)(scr + k * 68 + (cq ^ (((k >> 3) & 7) << 2))) = v[i]; }
    asm volatile("s_waitcnt lgkmcnt(0)" ::: "memory");
    const int c = lane & 7;
#pragma unroll
    for (int j = 0; j < 8; ++j) { const int n = (lane >> 3) + 8 * j; const LAS float* sp = scr + (8 * c) * 68 + (n ^ (c << 2));
        u32x4 o; o[0] = pk2(sp[0 * 68], sp[1 * 68]); o[1] = pk2(sp[2 * 68], sp[3 * 68]); o[2] = pk2(sp[4 * 68], sp[5 * 68]); o[3] = pk2(sp[6 * 68], sp[7 * 68]);
        *(u32x4*)(WT + (size_t)(dst_r0 + n) * K + k0 + 8 * c) = o; }
    asm volatile("s_waitcnt lgkmcnt(0)" ::: "memory");
}
template <class Map>
DEVI void cvt_matrix(const float* W, int K, int Nsrc, int Ndst, bf16* WT, Map smap, LAS float* scr, int gw, int ngw, int lane, int& base) {
    const int nblk = Ndst / 64, n = (K / 64) * nblk;
    int first = (gw - base % ngw + ngw) % ngw;
    for (int it = first; it < n; it += ngw) { const int kb = it / nblk, nb_ = it % nblk; transpose_item64(W, K, Nsrc, smap(nb_ * 64), WT, nb_ * 64, kb * 64, scr, lane); }
    base += n;
}

template <int DK1, int DK2, int DV, class Bias>
DEVI void attn_range(const float* qs, const bf16* K1, int ldk1, const bf16* K2, int ldk2, const bf16* V, int ldv,
                     int j0, int j1, float scale, Bias bias, float& m, float& l, float (&o)[2], int lane) {
    for (int jb = j0; jb < j1; jb += 64) {
        const int j = jb + lane; const bool valid = j < j1;
        float s = -__builtin_inff();
        if (valid) {
            float acc = 0.f;
            const bf16* kr = K1 + (size_t)j * ldk1;
#pragma unroll 4
            for (int d = 0; d < DK1; d += 8) {
                const u32x4 kv = *(const u32x4*)(kr + d); const f32x4 q0 = *(const f32x4*)(qs + d), q1 = *(const f32x4*)(qs + d + 4);
                acc += q0[0] * bflo(kv[0]) + q0[1] * bfhi(kv[0]) + q0[2] * bflo(kv[1]) + q0[3] * bfhi(kv[1])
                     + q1[0] * bflo(kv[2]) + q1[1] * bfhi(kv[2]) + q1[2] * bflo(kv[3]) + q1[3] * bfhi(kv[3]);
            }
            if (DK2 > 0) {
                const bf16* kr2 = K2 + (size_t)j * ldk2;
#pragma unroll 4
                for (int d = 0; d < DK2; d += 8) {
                    const u32x4 kv = *(const u32x4*)(kr2 + d); const f32x4 q0 = *(const f32x4*)(qs + DK1 + d), q1 = *(const f32x4*)(qs + DK1 + d + 4);
                    acc += q0[0] * bflo(kv[0]) + q0[1] * bfhi(kv[0]) + q0[2] * bflo(kv[1]) + q0[3] * bfhi(kv[1])
                         + q1[0] * bflo(kv[2]) + q1[1] * bfhi(kv[2]) + q1[2] * bflo(kv[3]) + q1[3] * bfhi(kv[3]);
                }
            }
            s = acc * scale + bias(j);
        }
        const float cm = wave_max(s);
        const float mn = fmaxf(m, cm);
        const float alpha = __expf(m - mn);
        const float p = __expf(s - mn);
        l = l * alpha + wave_sum(p);
        o[0] *= alpha; o[1] *= alpha;
        m = mn;
        const int cnt = (j1 - jb) < 64 ? (j1 - jb) : 64;
        for (int jj = 0; jj < cnt; ++jj) {
            const float pj = __shfl(p, jj);
            const bf16* vr = V + (size_t)(jb + jj) * ldv;
            if (DV == 128) { const unsigned vv = *(const unsigned*)(vr + lane * 2); o[0] += pj * bflo(vv); o[1] += pj * bfhi(vv); }
            else { o[0] += pj * bf2f(vr[lane]); }
        }
    }
}


typedef short s16x4 __attribute__((ext_vector_type(4)));
typedef float f32x16 __attribute__((ext_vector_type(16)));
constexpr int FA_V = 0, FA_K = 32768, FA_KR = 65536, FA_CUM = 81920, FA_WS = 82432, FA_Q = 131072 + 512, FA_KM = 84992, FA_END = 93184;
constexpr int SHM_K = 16384, SHM_V = 16384, SHM_KR = 8192;
#define KSWZ(row, colB) ((row) * 256 + ((colB) ^ (((row) & 7) << 4)))
DEVI int v_st(int k, int c) { const int kk = (k & ~0xC) | ((k & 4) << 1) | ((k & 8) >> 1); return ((kk >> 3) * 4 + (c >> 5)) * 512 + ((kk & 7) * 32 + (c & 31)) * 2; }
DEVI int v_rd_base(int lane) { return ((lane & 3) << 3) | (((lane >> 2) & 3) << 6) | (((lane >> 4) & 1) << 5) | (((lane >> 5) & 1) << 8); }
DEVI int crow(int r, int hi) { return (r & 3) + 8 * (r >> 2) + 4 * hi; }
DEVI unsigned cvtpk(float lo, float hi) { unsigned r; asm volatile("v_cvt_pk_bf16_f32 %0, %1, %2" : "=v"(r) : "v"(lo), "v"(hi)); return r; }
enum { FM_MLA = 0, FM_FOX = 1, FM_MOBA = 2 };

template <int MODE>
DEVI void flash_unit(char* lds, const bf16* Qp, int ldq, const bf16* Kp, int ldk, const bf16* Vp, int ldv, const bf16* KRp,
                     const float* cum, const float* km, float slope, float sbound, int q0, bf16* Op, int ldo) {
    const int tid = threadIdx.x, wid = __builtin_amdgcn_readfirstlane(tid >> 6), lane = tid & 63, r32 = lane & 31, hi = lane >> 5;
    const int kh = wid >> 2, rgp = wid & 3;
    char* V_lds = lds + FA_V; char* K_lds = lds + FA_K; char* KR_lds = lds + FA_KR;
    float* cumt = (float*)(lds + FA_CUM);
    float* wsf = (float*)(lds + FA_WS) + wid * 64; float* li_l = wsf; float* al_l = wsf + 32;
    const int qrow = q0 + rgp * 32 + r32;
    constexpr float LOG2E = 1.4426950408889634f;
    constexpr float SC = (MODE == FM_MLA ? 0.07216878364870322f : 0.08838834764831845f) * LOG2E;
    constexpr int NQ = MODE == FM_MLA ? 12 : 8;
    bf16x8 qr[NQ];
    const bf16* qp = Qp + (size_t)qrow * ldq;
#pragma unroll
    for (int d0 = 0; d0 < 8; ++d0) qr[d0] = *(const bf16x8*)(qp + d0 * 16 + hi * 8);
    if constexpr (MODE == FM_MLA) {
        const bf16x8 a0 = *(const bf16x8*)(qp + 128 + hi * 8), a1 = *(const bf16x8*)(qp + 144 + hi * 8);
        const bf16x8 b0 = *(const bf16x8*)(qp + 160 + hi * 8), b1 = *(const bf16x8*)(qp + 176 + hi * 8);
        bf16x8 ra0, ra1, rb0, rb1;
#pragma unroll
        for (int e = 0; e < 8; ++e) {
            float c, s_;
            rope_cs(qrow, hi * 8 + e, c, s_);
            { const float t1 = bf2f((unsigned short)a0[e]), t2 = bf2f((unsigned short)b0[e]); ra0[e] = (short)f2bf(t1 * c - t2 * s_); rb0[e] = (short)f2bf(t1 * s_ + t2 * c); }
            rope_cs(qrow, 16 + hi * 8 + e, c, s_);
            { const float t1 = bf2f((unsigned short)a1[e]), t2 = bf2f((unsigned short)b1[e]); ra1[e] = (short)f2bf(t1 * c - t2 * s_); rb1[e] = (short)f2bf(t1 * s_ + t2 * c); }
        }
        qr[8] = ra0; qr[9] = ra1; qr[10] = rb0; qr[11] = rb1;
    }
    const int j_hi = (q0 >> 6) + 2;
    unsigned sel = 0xffffffffu, umask = 0xffffffffu;
    if constexpr (MODE == FM_MOBA) {
        const int blk = q0 >> 8;
        float* kml = (float*)(lds + FA_KM);
        unsigned* um = (unsigned*)(lds + FA_Q) + 4;
        *(f32x4*)(kml + tid * 4) = *(const f32x4*)(km + tid * 4) * (1.f / 256.f);
        if (tid == 0) *um = 0u;
        __syncthreads();
        float g[15];
#pragma unroll
        for (int n = 0; n < 15; ++n) g[n] = 0.f;
        for (int dd = 0; dd < 64; dd += 8) {
            const bf16x8 qv = *(const bf16x8*)(qp + hi * 64 + dd);
            float qf[8];
#pragma unroll
            for (int e = 0; e < 8; ++e) qf[e] = bf2f((unsigned short)qv[e]);
#pragma unroll
            for (int n = 0; n < 15; ++n)
                if (n < blk) {
                    const f32x4 k0 = *(const f32x4*)(kml + n * 128 + hi * 64 + dd), k1 = *(const f32x4*)(kml + n * 128 + hi * 64 + dd + 4);
                    g[n] += qf[0] * k0[0] + qf[1] * k0[1] + qf[2] * k0[2] + qf[3] * k0[3] + qf[4] * k1[0] + qf[5] * k1[1] + qf[6] * k1[2] + qf[7] * k1[3];
                }
        }
#pragma unroll
        for (int n = 0; n < 15; ++n) g[n] += __shfl_xor(g[n], 32);
        sel = 1u << blk;
#pragma unroll
        for (int r = 0; r < 3; ++r) {
            float best = -__builtin_inff(); int bi = -1;
#pragma unroll
            for (int n = 0; n < 15; ++n) if (n < blk && !((sel >> n) & 1u) && g[n] > best) { best = g[n]; bi = n; }
            if (bi >= 0) sel |= 1u << bi;
        }
        unsigned wm_ = 0u;
#pragma unroll
        for (int n = 0; n < 16; ++n) if (__any((sel >> n) & 1u)) wm_ |= 1u << n;
        if (lane == 0) atomicOr(um, wm_);
        __syncthreads();
        umask = *um;
    }
    auto nxt = [&](int j) { do { ++j; } while (j < j_hi && !((umask >> (j >> 2)) & 1u)); return j; };
    int j_lo = 0;
    if constexpr (MODE == FM_FOX) {
        const float lim = cum[q0] + 2.f * sbound + 40.f;
        const float cj = (lane < j_hi) ? cum[64 * lane + 63] : -__builtin_inff();
        const unsigned long long keep = __ballot(cj <= lim);
        j_lo = keep ? (int)__builtin_ctzll(keep) : j_hi - 1;
        if (j_lo > j_hi - 2) j_lo = j_hi - 2;
        j_lo = __builtin_amdgcn_readfirstlane(j_lo);
    }
    int jc = nxt(j_lo - 1);
    const int sr = tid >> 4, sc = (tid & 15) * 8;
    const int kws = KSWZ(sr, sc * 2), vst0 = v_st(sr, sc), vst1 = v_st(32 + sr, sc);
    const int krk = tid >> 3, krc = tid & 7, krw = krk * 128 + ((krc ^ (krk & 7)) << 4);
    bf16x8 st_k0, st_k1, st_v0, st_v1, st_kr; float st_c = 0.f;
#define FA_GL(kb) do { const unsigned ko_ = (unsigned)(((kb) + sr) * ldk + sc) * 2u, vo_ = (unsigned)(((kb) + sr) * ldv + sc) * 2u; \
        st_k0 = *(const bf16x8*)((const char*)Kp + ko_); st_k1 = *(const bf16x8*)((const char*)Kp + ko_ + (unsigned)(64 * ldk)); \
        st_v0 = *(const bf16x8*)((const char*)Vp + vo_); st_v1 = *(const bf16x8*)((const char*)Vp + vo_ + (unsigned)(64 * ldv)); \
        if constexpr (MODE == FM_MLA) st_kr = *(const bf16x8*)((const char*)KRp + (unsigned)(((kb) + krk) * 64 + krc * 8) * 2u); \
        if constexpr (MODE == FM_FOX) { if (tid < 64) st_c = cum[(kb) + tid]; } } while (0)
#define FA_SW(bf) do { *(bf16x8*)(K_lds + (bf) * SHM_K + kws) = st_k0; *(bf16x8*)(K_lds + (bf) * SHM_K + kws + 32 * 256) = st_k1; \
        *(bf16x8*)(V_lds + (bf) * SHM_V + vst0) = st_v0; *(bf16x8*)(V_lds + (bf) * SHM_V + vst1) = st_v1; \
        if constexpr (MODE == FM_MLA) *(bf16x8*)(KR_lds + (bf) * SHM_KR + krw) = st_kr; \
        if constexpr (MODE == FM_FOX) { if (tid < 64) cumt[(bf) * 64 + tid] = st_c; } } while (0)
    FA_GL(jc * 64);
    asm volatile("s_waitcnt vmcnt(0)" ::: "memory");
    FA_SW(0);
    float m_reg = -1e30f, l_reg = 0.f;
    f32x16 o[4];
#pragma unroll
    for (int d = 0; d < 4; ++d)
#pragma unroll
        for (int r = 0; r < 16; ++r) o[d][r] = 0.f;
    float cqL = 0.f;
    if constexpr (MODE == FM_FOX) cqL = cum[qrow];
    const float slopeL = slope * LOG2E;
    const int vb0 = (int)(unsigned)(size_t)((LAS char*)V_lds) + v_rd_base(lane) + kh * 8192;
    int bf = 0;
    while (jc < j_hi) {
        const int kb = jc * 64;
        const int jn = nxt(jc);
        __syncthreads();
        if (jn < j_hi) FA_GL(jn * 64);
        f32x16 p0;
#pragma unroll
        for (int r = 0; r < 16; ++r) p0[r] = 0.f;
        {
            const char* kbase = K_lds + bf * SHM_K + kh * (32 * 256);
            const char* kbp[4];
#pragma unroll
            for (int dd = 0; dd < 4; ++dd) kbp[dd] = kbase + KSWZ(r32, (dd * 16 + hi * 8) * 2);
#pragma unroll
            for (int d0 = 0; d0 < 8; ++d0) {
                const bf16x8 b0 = *(const bf16x8*)(kbp[d0 & 3] + (d0 >> 2) * 128);
                p0 = __builtin_amdgcn_mfma_f32_32x32x16_bf16(b0, qr[d0], p0, 0, 0, 0);
            }
            if constexpr (MODE == FM_MLA) {
                const char* krb = KR_lds + bf * SHM_KR + (kh * 32 + r32) * 128;
#pragma unroll
                for (int d = 0; d < 4; ++d) {
                    const bf16x8 b0 = *(const bf16x8*)(krb + (((d * 2 + hi) ^ (r32 & 7)) << 4));
                    p0 = __builtin_amdgcn_mfma_f32_32x32x16_bf16(b0, qr[8 + d], p0, 0, 0, 0);
                }
            }
        }
        if (jn < j_hi) { asm volatile("s_waitcnt vmcnt(0)" ::: "memory"); FA_SW(bf ^ 1); }
        const int kbh = kb + kh * 32;
        if constexpr (MODE == FM_FOX) {
#pragma unroll
            for (int g4 = 0; g4 < 4; ++g4) {
                const f32x4 c0 = *(const f32x4*)(cumt + bf * 64 + kh * 32 + 8 * g4 + 4 * hi);
#pragma unroll
                for (int i = 0; i < 4; ++i) p0[4 * g4 + i] = p0[4 * g4 + i] * SC + (cqL - c0[i]) * LOG2E;
            }
        } else if constexpr (MODE == FM_MOBA) {
            const float dq = (float)(qrow - kbh - 4 * hi);
#pragma unroll
            for (int r = 0; r < 16; ++r) { const float c = (float)((r & 3) + 8 * (r >> 2)); p0[r] = p0[r] * SC - slopeL * (dq - c); }
        } else {
#pragma unroll
            for (int r = 0; r < 16; ++r) p0[r] *= SC;
        }
        const float NEG = -__builtin_inff();
        if (kbh + 31 > q0 + rgp * 32) {
            const int dqi = qrow - kbh - 4 * hi;
#pragma unroll
            for (int r = 0; r < 16; ++r) { const int c = (r & 3) + 8 * (r >> 2); if (c > dqi) p0[r] = NEG; }
        }
        if constexpr (MODE == FM_MOBA) {
            if (!((sel >> (kb >> 8)) & 1u)) {
#pragma unroll
                for (int r = 0; r < 16; ++r) p0[r] = NEG;
            }
        }
        float pmax = p0[0];
#pragma unroll
        for (int r = 1; r < 16; ++r) pmax = fmaxf(pmax, p0[r]);
        { auto rr = __builtin_amdgcn_permlane32_swap(__float_as_uint(pmax), __float_as_uint(pmax), false, false);
          pmax = fmaxf(__uint_as_float(rr[0]), __uint_as_float(rr[1])); }
        const float mn = fmaxf(m_reg, pmax);
        const float alpha = __builtin_amdgcn_exp2f(m_reg - mn);
        m_reg = mn;
        float ps = 0.f;
#pragma unroll
        for (int r = 0; r < 16; ++r) { p0[r] = __builtin_amdgcn_exp2f(p0[r] - mn); ps += p0[r]; }
        { auto rr = __builtin_amdgcn_permlane32_swap(__float_as_uint(ps), __float_as_uint(ps), false, false);
          ps = __uint_as_float(rr[0]) + __uint_as_float(rr[1]); }
        l_reg = l_reg * alpha + ps;
        bf16x8 pa0, pa1;
#define PK4(P, B_, OUT) do { unsigned a0_ = cvtpk(P[B_ + 0], P[B_ + 1]), a1_ = cvtpk(P[B_ + 2], P[B_ + 3]); \
        unsigned b0_ = cvtpk(P[B_ + 4], P[B_ + 5]), b1_ = cvtpk(P[B_ + 6], P[B_ + 7]); \
        auto r0_ = __builtin_amdgcn_permlane32_swap(a0_, b0_, false, false); auto r1_ = __builtin_amdgcn_permlane32_swap(a1_, b1_, false, false); \
        u32x4 w_ = {r0_[0], r1_[0], r0_[1], r1_[1]}; OUT = *reinterpret_cast<bf16x8*>(&w_); } while (0)
        PK4(p0, 0, pa0); PK4(p0, 8, pa1);
#undef PK4
        if (__any(alpha < 1.f)) {
            if (hi == 0) al_l[r32] = alpha;
            asm volatile("s_waitcnt lgkmcnt(0)" ::: "memory");
#pragma unroll
            for (int d = 0; d < 4; ++d)
#pragma unroll
                for (int r = 0; r < 16; ++r) o[d][r] *= al_l[crow(r, hi)];
        }
        {
            const int vb = vb0 + bf * SHM_V;
#define TRRD(dst, off) asm volatile("ds_read_b64_tr_b16 %0, %1 offset:%2" : "=&v"(dst) : "v"(vb), "i"(off) : "memory")
#define PV_D0(d0) do { s16x4 l0, l1, h0, h1; constexpr int b_ = (d0) * 512; \
        TRRD(l0, b_); TRRD(h0, b_ + 2048); TRRD(l1, b_ + 4096); TRRD(h1, b_ + 6144); \
        asm volatile("s_waitcnt lgkmcnt(0)" ::: "memory"); __builtin_amdgcn_sched_barrier(0); \
        o[d0] = __builtin_amdgcn_mfma_f32_32x32x16_bf16(pa0, (bf16x8){l0[0], l0[1], l0[2], l0[3], h0[0], h0[1], h0[2], h0[3]}, o[d0], 0, 0, 0); \
        o[d0] = __builtin_amdgcn_mfma_f32_32x32x16_bf16(pa1, (bf16x8){l1[0], l1[1], l1[2], l1[3], h1[0], h1[1], h1[2], h1[3]}, o[d0], 0, 0, 0); } while (0)
            PV_D0(0); PV_D0(1); PV_D0(2); PV_D0(3);
#undef PV_D0
#undef TRRD
        }
        bf ^= 1; jc = jn;
    }
#undef FA_GL
#undef FA_SW
    __syncthreads();
    float* xo = (float*)(lds + FA_V) + (size_t)rgp * 66 * 64 + lane;
    if (kh == 1) {
#pragma unroll
        for (int d = 0; d < 4; ++d)
#pragma unroll
            for (int r = 0; r < 16; ++r) xo[(d * 16 + r) * 64] = o[d][r];
        xo[64 * 64] = m_reg; xo[65 * 64] = l_reg;
    }
    __syncthreads();
    if (kh == 0) {
        const float mB = xo[64 * 64], lB = xo[65 * 64];
        const float mm = fmaxf(m_reg, mB);
        const float aA = __builtin_amdgcn_exp2f(m_reg - mm), aB = __builtin_amdgcn_exp2f(mB - mm);
        const float inv = 1.f / (l_reg * aA + lB * aB);
        if (hi == 0) { li_l[r32] = aA * inv; al_l[r32] = aB * inv; }
        asm volatile("s_waitcnt lgkmcnt(0)" ::: "memory");
        int tz = lane; asm volatile("" : "+v"(tz));
        const int hz = tz >> 5, rz = tz & 31;
        bf16* Ow = Op + (size_t)(q0 + rgp * 32) * ldo;
#pragma unroll
        for (int r = 0; r < 16; ++r) {
            const int orow = crow(r, hz);
            const float fa = li_l[orow], fb = al_l[orow];
            const unsigned obase = (unsigned)(orow * ldo + rz);
#pragma unroll
            for (int d0 = 0; d0 < 4; ++d0) {
                const float v = o[d0][r] * fa + xo[(d0 * 16 + r) * 64] * fb;
                const float vn = __shfl_xor(v, 1);
                if ((rz & 1) == 0) *(unsigned*)(Ow + obase + d0 * 32) = cvtpk(v, vn);
            }
        }
    }
    __syncthreads();
}

constexpr int SW_V = 0, SW_K = 49152, SW_WS = 98304;
DEVI void swa_unit(char* lds, const bf16* Pb  , int kvh, int q0, const float* sinks, bf16* Ob  ) {
    const int tid = threadIdx.x, wid = __builtin_amdgcn_readfirstlane(tid >> 6), lane = tid & 63, r32 = lane & 31, hi = lane >> 5;
    char* V_lds = lds + SW_V; char* K_lds = lds + SW_K;
    float* wsf = (float*)(lds + SW_WS) + wid * 64; float* li_l = wsf; float* al_l = wsf + 32;
    constexpr float LOG2E = 1.4426950408889634f, SC = 0.125f * LOG2E;
    const int qh = kvh * 8 + wid;
    const float slopeL = exp2f(-0.5f * (float)(qh + 1)) * LOG2E, sinkL = sinks[qh] * LOG2E;
    {
        const int key = tid >> 3, ch = tid & 7;
        const int kws = KSWZ(key, ch * 16), vws = v_st(key, ch * 8);
        bf16x8 sk[3], sv[3];
#pragma unroll
        for (int jt = 0; jt < 3; ++jt) {
            const int kb = q0 - 128 + jt * 64;
            if (kb >= 0) {
                const unsigned o_ = (unsigned)((kb + key) * LDP + ch * 8) * 2u;
                sk[jt] = *(const bf16x8*)((const char*)Pb + o_ + (unsigned)(O_SK + kvh * 64) * 2u);
                sv[jt] = *(const bf16x8*)((const char*)Pb + o_ + (unsigned)(O_SV + kvh * 64) * 2u);
            }
        }
#pragma unroll
        for (int jt = 0; jt < 3; ++jt) {
            const int kb = q0 - 128 + jt * 64;
            if (kb >= 0) { *(bf16x8*)(K_lds + jt * SHM_K + kws) = sk[jt]; *(bf16x8*)(V_lds + jt * SHM_V + vws) = sv[jt]; }
        }
    }
    __syncthreads();
    const int vb0 = (int)(unsigned)(size_t)((LAS char*)V_lds) + v_rd_base(lane);
    for (int rg = 0; rg < 2; ++rg) {
        const int qrow = q0 + rg * 32 + r32;
        bf16x8 qr[4];
        const bf16* qp = Pb + (size_t)qrow * LDP + O_SQ + qh * 64;
#pragma unroll
        for (int d0 = 0; d0 < 4; ++d0) qr[d0] = *(const bf16x8*)(qp + d0 * 16 + hi * 8);
        float m_reg = -1e30f, l_reg = 0.f;
        f32x16 o[2];
#pragma unroll
        for (int d = 0; d < 2; ++d)
#pragma unroll
            for (int r = 0; r < 16; ++r) o[d][r] = 0.f;
#pragma unroll 1
        for (int jt = 0; jt < 3; ++jt) {
            const int kb = q0 - 128 + jt * 64;
            if (kb < 0) continue;
            f32x16 p0, p1;
#pragma unroll
            for (int r = 0; r < 16; ++r) { p0[r] = 0.f; p1[r] = 0.f; }
            {
                const char* kbase = K_lds + jt * SHM_K;
#pragma unroll
                for (int d0 = 0; d0 < 4; ++d0) {
                    const char* ap = kbase + KSWZ(r32, (d0 * 16 + hi * 8) * 2);
                    const bf16x8 b0 = *(const bf16x8*)(ap), b1 = *(const bf16x8*)(ap + 32 * 256);
                    p0 = __builtin_amdgcn_mfma_f32_32x32x16_bf16(b0, qr[d0], p0, 0, 0, 0);
                    p1 = __builtin_amdgcn_mfma_f32_32x32x16_bf16(b1, qr[d0], p1, 0, 0, 0);
                }
            }
            const float NEG = -__builtin_inff();
            const int dqi = qrow - kb - 4 * hi;
#pragma unroll
            for (int r = 0; r < 16; ++r) {
                const int c = (r & 3) + 8 * (r >> 2);
                const int d0_ = dqi - c, d1_ = dqi - c - 32;
                p0[r] = ((unsigned)d0_ < 128u) ? p0[r] * SC - slopeL * (float)d0_ : NEG;
                p1[r] = ((unsigned)d1_ < 128u) ? p1[r] * SC - slopeL * (float)d1_ : NEG;
            }
            float pmax = p0[0];
#pragma unroll
            for (int r = 1; r < 16; ++r) pmax = fmaxf(pmax, p0[r]);
#pragma unroll
            for (int r = 0; r < 16; ++r) pmax = fmaxf(pmax, p1[r]);
            { auto rr = __builtin_amdgcn_permlane32_swap(__float_as_uint(pmax), __float_as_uint(pmax), false, false);
              pmax = fmaxf(__uint_as_float(rr[0]), __uint_as_float(rr[1])); }
            const float mn = fmaxf(m_reg, pmax);
            const float alpha = __builtin_amdgcn_exp2f(m_reg - mn);
            m_reg = mn;
            float ps = 0.f;
#pragma unroll
            for (int r = 0; r < 16; ++r) { p0[r] = __builtin_amdgcn_exp2f(p0[r] - mn); p1[r] = __builtin_amdgcn_exp2f(p1[r] - mn); ps += p0[r] + p1[r]; }
            { auto rr = __builtin_amdgcn_permlane32_swap(__float_as_uint(ps), __float_as_uint(ps), false, false);
              ps = __uint_as_float(rr[0]) + __uint_as_float(rr[1]); }
            l_reg = l_reg * alpha + ps;
            bf16x8 pa0, pa1, pa2, pa3;
#define PK4(P, B_, OUT) do { unsigned a0_ = cvtpk(P[B_ + 0], P[B_ + 1]), a1_ = cvtpk(P[B_ + 2], P[B_ + 3]); \
        unsigned b0_ = cvtpk(P[B_ + 4], P[B_ + 5]), b1_ = cvtpk(P[B_ + 6], P[B_ + 7]); \
        auto r0_ = __builtin_amdgcn_permlane32_swap(a0_, b0_, false, false); auto r1_ = __builtin_amdgcn_permlane32_swap(a1_, b1_, false, false); \
        u32x4 w_ = {r0_[0], r1_[0], r0_[1], r1_[1]}; OUT = *reinterpret_cast<bf16x8*>(&w_); } while (0)
            PK4(p0, 0, pa0); PK4(p0, 8, pa1); PK4(p1, 0, pa2); PK4(p1, 8, pa3);
#undef PK4
            if (__any(alpha < 1.f)) {
                if (hi == 0) al_l[r32] = alpha;
                asm volatile("s_waitcnt lgkmcnt(0)" ::: "memory");
#pragma unroll
                for (int d = 0; d < 2; ++d)
#pragma unroll
                    for (int r = 0; r < 16; ++r) o[d][r] *= al_l[crow(r, hi)];
            }
            {
                const int vb = vb0 + jt * SHM_V;
#define TRRD(dst, off) asm volatile("ds_read_b64_tr_b16 %0, %1 offset:%2" : "=&v"(dst) : "v"(vb), "i"(off) : "memory")
#define PV_D0(d0) do { s16x4 l0, l1, l2, l3, h0, h1, h2, h3; constexpr int b_ = (d0) * 512; \
        TRRD(l0, b_); TRRD(h0, b_ + 2048); TRRD(l1, b_ + 4096); TRRD(h1, b_ + 6144); TRRD(l2, b_ + 8192); TRRD(h2, b_ + 10240); TRRD(l3, b_ + 12288); TRRD(h3, b_ + 14336); \
        asm volatile("s_waitcnt lgkmcnt(0)" ::: "memory"); __builtin_amdgcn_sched_barrier(0); \
        o[d0] = __builtin_amdgcn_mfma_f32_32x32x16_bf16(pa0, (bf16x8){l0[0], l0[1], l0[2], l0[3], h0[0], h0[1], h0[2], h0[3]}, o[d0], 0, 0, 0); \
        o[d0] = __builtin_amdgcn_mfma_f32_32x32x16_bf16(pa1, (bf16x8){l1[0], l1[1], l1[2], l1[3], h1[0], h1[1], h1[2], h1[3]}, o[d0], 0, 0, 0); \
        o[d0] = __builtin_amdgcn_mfma_f32_32x32x16_bf16(pa2, (bf16x8){l2[0], l2[1], l2[2], l2[3], h2[0], h2[1], h2[2], h2[3]}, o[d0], 0, 0, 0); \
        o[d0] = __builtin_amdgcn_mfma_f32_32x32x16_bf16(pa3, (bf16x8){l3[0], l3[1], l3[2], l3[3], h3[0], h3[1], h3[2], h3[3]}, o[d0], 0, 0, 0); } while (0)
                PV_D0(0); PV_D0(1);
#undef PV_D0
#undef TRRD
            }
        }
        const float mf = fmaxf(m_reg, sinkL), al = __builtin_amdgcn_exp2f(m_reg - mf);
        const float lf = l_reg * al + __builtin_amdgcn_exp2f(sinkL - mf);
        if (hi == 0) li_l[r32] = al / lf;
        asm volatile("s_waitcnt lgkmcnt(0)" ::: "memory");
        int tz = lane; asm volatile("" : "+v"(tz));
        const int hz = tz >> 5, rz = tz & 31;
        bf16* Ow = Ob + (size_t)(q0 + rg * 32) * 2048 + qh * 64;
#pragma unroll
        for (int r = 0; r < 16; ++r) {
            const int orow = crow(r, hz);
            const float rl = li_l[orow];
            const unsigned obase = (unsigned)(orow * 2048 + rz);
#pragma unroll
            for (int d0 = 0; d0 < 2; ++d0) {
                const float v = o[d0][r] * rl;
                const float vn = __shfl_xor(v, 1);
                if ((rz & 1) == 0) *(unsigned*)(Ow + obase + d0 * 32) = cvtpk(v, vn);
            }
        }
        asm volatile("s_waitcnt lgkmcnt(0)" ::: "memory");
    }
    __syncthreads();
}

struct Args { const float* in[19]; float* out; unsigned char* ws; int ph_lo, ph_hi; };
enum { I_X = 0, I_WR, I_RB, I_EWIN, I_EQN, I_EWQ, I_EKVN, I_EWKV, I_EFB, I_EWOUT, I_OWIN, I_OSINK, I_OWOUT, I_LMG, I_LMB, I_LFG, I_LFB, I_WGU, I_WDN };
enum { PH_CVT = 0, PH_L0_IN, PH_L0_PREP, PH_L0_UP, PH_L0_ATT, PH_L0_OUT, PH_L0_LN1, PH_L0_MOE1, PH_L0_MOE2, PH_L0_LN2,
       PH_L1_IN, PH_L1_KM, PH_L1_ATT, PH_L1_OUT, PH_L1_LN1, PH_L1_MOE1, PH_L1_MOE2, PH_L1_LN2, NPH };

DEVI void ln_row(const float* hrow, float a, const bf16* y0, const bf16* y1, const float* g, const float* bta, int lane, f32x4 (&v)[8]) {
    float s = 0.f;
#pragma unroll
    for (int j = 0; j < 8; ++j) {
        f32x4 x = *(const f32x4*)(hrow + 4 * lane + 256 * j) * a;
        if (y0) { const uint2 w = *(const uint2*)(y0 + 4 * lane + 256 * j); x += (f32x4){bflo(w.x), bfhi(w.x), bflo(w.y), bfhi(w.y)}; }
        if (y1) { const uint2 w = *(const uint2*)(y1 + 4 * lane + 256 * j); x += (f32x4){bflo(w.x), bfhi(w.x), bflo(w.y), bfhi(w.y)}; }
        v[j] = x; s += (x[0] + x[1]) + (x[2] + x[3]);
    }
    const float mean = wave_sum(s) * (1.f / DM);
    float s2 = 0.f;
#pragma unroll
    for (int j = 0; j < 8; ++j) { v[j] = v[j] - mean; s2 += (v[j][0] * v[j][0] + v[j][1] * v[j][1]) + (v[j][2] * v[j][2] + v[j][3] * v[j][3]); }
    const float rstd = 1.f / sqrtf(wave_sum(s2) * (1.f / DM) + LN_EPS);
#pragma unroll
    for (int j = 0; j < 8; ++j) v[j] = v[j] * rstd * *(const f32x4*)(g + 4 * lane + 256 * j) + *(const f32x4*)(bta + 4 * lane + 256 * j);
}

DEVI void route_select(LAS int* cntl, int* list, float* ew, const float* rb, int blk, int t, float lg, int lane, int off) {
    const float affl = 1.f / (1.f + __expf(-lg));
    const float sell = affl + rb[lane & 31];
    int best = 0; float bests = -__builtin_inff();
#pragma unroll
    for (int gI = 0; gI < 8; ++gI) {
        float m1 = -__builtin_inff(), m2 = -__builtin_inff();
#pragma unroll
        for (int q = 0; q < 4; ++q) { const float x = __shfl(sell, off + gI * 4 + q); if (x > m1) { m2 = m1; m1 = x; } else if (x > m2) m2 = x; }
        const float sc = m1 + m2;
        if (sc > bests) { bests = sc; best = gI; }
    }
    int e1 = 0, e2 = 0; float s1 = -__builtin_inff(), s2 = -__builtin_inff(), a1 = 0.f, a2 = 0.f;
#pragma unroll
    for (int q = 0; q < 4; ++q) {
        const float af = __shfl(affl, off + best * 4 + q), x = __shfl(sell, off + best * 4 + q);
        if (x > s1) { s2 = s1; e2 = e1; a2 = a1; s1 = x; e1 = best * 4 + q; a1 = af; } else if (x > s2) { s2 = x; e2 = best * 4 + q; a2 = af; }
    }
    if (lane == off) {
        const float inv = 1.f / (a1 + a2);
        ew[t * 2 + 0] = a1 * inv; ew[t * 2 + 1] = a2 * inv;
        const int p1 = __hip_atomic_fetch_add(cntl + e1, 1, __ATOMIC_RELAXED, __HIP_MEMORY_SCOPE_WORKGROUP); list[e1 * T + blk * 32 + p1] = t * 2 + 0;
        const int p2 = __hip_atomic_fetch_add(cntl + e2, 1, __ATOMIC_RELAXED, __HIP_MEMORY_SCOPE_WORKGROUP); list[e2 * T + blk * 32 + p2] = t * 2 + 1;
    }
}
DEVI void ln_row2(const float* r0, const float* r1, const float* g, const float* bta, int lane, f32x4 (&v0)[8], f32x4 (&v1)[8]) {
    float s0 = 0.f, s1 = 0.f;
#pragma unroll
    for (int j = 0; j < 8; ++j) { v0[j] = *(const f32x4*)(r0 + 4 * lane + 256 * j); v1[j] = *(const f32x4*)(r1 + 4 * lane + 256 * j); }
#pragma unroll
    for (int j = 0; j < 8; ++j) { s0 += (v0[j][0] + v0[j][1]) + (v0[j][2] + v0[j][3]); s1 += (v1[j][0] + v1[j][1]) + (v1[j][2] + v1[j][3]); }
#pragma unroll
    for (int o = 1; o < 64; o <<= 1) { s0 += __shfl_xor(s0, o); s1 += __shfl_xor(s1, o); }
    const float m0 = s0 * (1.f / DM), m1 = s1 * (1.f / DM);
    float q0 = 0.f, q1 = 0.f;
#pragma unroll
    for (int j = 0; j < 8; ++j) { v0[j] = v0[j] - m0; v1[j] = v1[j] - m1;
        q0 += (v0[j][0] * v0[j][0] + v0[j][1] * v0[j][1]) + (v0[j][2] * v0[j][2] + v0[j][3] * v0[j][3]);
        q1 += (v1[j][0] * v1[j][0] + v1[j][1] * v1[j][1]) + (v1[j][2] * v1[j][2] + v1[j][3] * v1[j][3]); }
#pragma unroll
    for (int o = 1; o < 64; o <<= 1) { q0 += __shfl_xor(q0, o); q1 += __shfl_xor(q1, o); }
    const float rs0 = 1.f / sqrtf(q0 * (1.f / DM) + LN_EPS), rs1 = 1.f / sqrtf(q1 * (1.f / DM) + LN_EPS);
#pragma unroll
    for (int j = 0; j < 8; ++j) { const f32x4 gg = *(const f32x4*)(g + 4 * lane + 256 * j), bb = *(const f32x4*)(bta + 4 * lane + 256 * j);
        v0[j] = v0[j] * rs0 * gg + bb; v1[j] = v1[j] * rs1 * gg + bb; }
}
DEVI void phase_ln1_route(const Args& a, char* lds, int layer, const float* pre, float* hf, bf16* hb, int bid, int nb, int wid, int lane) {
    int* list = (int*)(a.ws + WS_LIST) + layer * NEXP * T;
    int* bc = (int*)(a.ws + WS_BC) + layer * NEXP * 256;
    float* ew = (float*)(a.ws + WS_EW);
    const float* g = a.in[I_LMG] + layer * DM; const float* bta = a.in[I_LMB] + layer * DM;
    const float* rb = a.in[I_RB];
    LAS int* cntl = (LAS int*)((LAS char*)lds + LDS_CNTL);
    if (nb != 256) return;
    if (threadIdx.x < NEXP) cntl[threadIdx.x] = 0;
    __syncthreads();
    const bf16* wrh = (const bf16*)(a.ws + WS_WRH); const bf16* wrl = (const bf16*)(a.ws + WS_WRL);
    constexpr int RS = 2056;
    bf16* xh = (bf16*)lds; bf16* xl = xh + 16 * RS;
    float* part = (float*)lds;
    const int tid = threadIdx.x;
    for (int base = bid * 16; base < T; base += nb * 16) {
        {
            const int t0 = base + 2 * wid, t1 = t0 + 1;
            f32x4 v0[8], v1[8];
            ln_row2(pre + (size_t)t0 * DM, pre + (size_t)t1 * DM, g, bta, lane, v0, v1);
#pragma unroll
            for (int k = 0; k < 2; ++k) {
                const int t = k == 0 ? t0 : t1; bf16* rh = xh + (2 * wid + k) * RS; bf16* rl = xl + (2 * wid + k) * RS;
#pragma unroll
                for (int j = 0; j < 8; ++j) {
                    const f32x4 x = k == 0 ? v0[j] : v1[j];
                    *(f32x4*)(hf + (size_t)t * DM + 4 * lane + 256 * j) = x;
                    const unsigned h01 = pk2(x[0], x[1]), h23 = pk2(x[2], x[3]);
                    uint2 w; w.x = h01; w.y = h23;
                    *(uint2*)(hb + (size_t)t * DM + 4 * lane + 256 * j) = w;
                    *(uint2*)(rh + 4 * lane + 256 * j) = w;
                    uint2 wl; wl.x = pk2(x[0] - bflo(h01), x[1] - bfhi(h01)); wl.y = pk2(x[2] - bflo(h23), x[3] - bfhi(h23));
                    *(uint2*)(rl + 4 * lane + 256 * j) = wl;
                }
            }
        }
        __syncthreads();
        f32x4 acc0 = {0.f, 0.f, 0.f, 0.f}, acc1 = {0.f, 0.f, 0.f, 0.f};
        {
            const int tok = lane & 15, kg = lane >> 4;
            const bf16* ah_p = xh + tok * RS + 256 * wid + 8 * kg; const bf16* al_p = xl + tok * RS + 256 * wid + 8 * kg;
            const size_t bo = (size_t)(lane & 15) * DM + 256 * wid + 8 * kg;
#pragma unroll
            for (int sI = 0; sI < 8; ++sI) {
                const bf16x8 ah = *(const bf16x8*)(ah_p + 32 * sI), al = *(const bf16x8*)(al_p + 32 * sI);
                const bf16x8 bh0 = *(const bf16x8*)(wrh + bo + 32 * sI), bh1 = *(const bf16x8*)(wrh + bo + 16 * DM + 32 * sI);
                const bf16x8 bl0 = *(const bf16x8*)(wrl + bo + 32 * sI), bl1 = *(const bf16x8*)(wrl + bo + 16 * DM + 32 * sI);
                acc0 = __builtin_amdgcn_mfma_f32_16x16x32_bf16(ah, bh0, acc0, 0, 0, 0); acc1 = __builtin_amdgcn_mfma_f32_16x16x32_bf16(ah, bh1, acc1, 0, 0, 0);
                acc0 = __builtin_amdgcn_mfma_f32_16x16x32_bf16(al, bh0, acc0, 0, 0, 0); acc1 = __builtin_amdgcn_mfma_f32_16x16x32_bf16(al, bh1, acc1, 0, 0, 0);
                acc0 = __builtin_amdgcn_mfma_f32_16x16x32_bf16(ah, bl0, acc0, 0, 0, 0); acc1 = __builtin_amdgcn_mfma_f32_16x16x32_bf16(ah, bl1, acc1, 0, 0, 0);
            }
        }
        __syncthreads();
#pragma unroll
        for (int j = 0; j < 4; ++j) {
            part[(wid * 16 + 4 * (lane >> 4) + j) * 32 + (lane & 15)] = acc0[j];
            part[(wid * 16 + 4 * (lane >> 4) + j) * 32 + 16 + (lane & 15)] = acc1[j];
        }
        __syncthreads();
        float lg = 0.f;
#pragma unroll
        for (int w = 0; w < 8; ++w) lg += part[(w * 16 + (tid >> 5)) * 32 + (tid & 31)];
        route_select(cntl, list, ew, rb, bid, base + (tid >> 5), lg, lane, lane & 32);
        __syncthreads();
    }
    if (tid < NEXP) bc[tid * 256 + bid] = cntl[tid];
}

DEVI void phase_moe(const Args& a, char* lds, int layer, int stage, const bf16* hb, int bid, int nb) {
    const int* list = (const int*)(a.ws + WS_LIST) + layer * NEXP * T;
    const float* ew = (const float*)(a.ws + WS_EW);
    bf16* hdn = (bf16*)(a.ws + WS_HDN);
    bf16* Y = (bf16*)(a.ws + WS_Y);
    int* sh = (int*)(lds + LDS_SH);
    LAS unsigned short* pre = (LAS unsigned short*)((LAS char*)lds + LDS_PRE);
    LAS int* tot = (LAS int*)((LAS char*)lds + LDS_CNTL);
    const int* bc = (const int*)(a.ws + WS_BC) + layer * NEXP * 256;
    const int ntn = stage == 1 ? 4 : 8;
    {
        const int w_ = threadIdx.x >> 6, l_ = threadIdx.x & 63;
#pragma unroll
        for (int q = 0; q < 4; ++q) {
            const int e = 4 * w_ + q;
            const int c0 = bc[e * 256 + 4 * l_], c1 = bc[e * 256 + 4 * l_ + 1], c2 = bc[e * 256 + 4 * l_ + 2], c3 = bc[e * 256 + 4 * l_ + 3];
            const int loc = c0 + c1 + c2 + c3; int inc = loc;
#pragma unroll
            for (int o = 1; o < 64; o <<= 1) { const int v = __shfl_up(inc, o); if (l_ >= o) inc += v; }
            const int ex = inc - loc;
            pre[e * 256 + 4 * l_] = (unsigned short)ex; pre[e * 256 + 4 * l_ + 1] = (unsigned short)(ex + c0);
            pre[e * 256 + 4 * l_ + 2] = (unsigned short)(ex + c0 + c1); pre[e * 256 + 4 * l_ + 3] = (unsigned short)(ex + c0 + c1 + c2);
            if (l_ == 63) tot[e] = inc;
        }
    }
    __syncthreads();
    if (threadIdx.x == 0) {
        int so = 0, to = 0;
        for (int e = 0; e < NEXP; ++e) { const int c = tot[e]; sh[e] = so; sh[33 + e] = to; so += c; to += ((c + 255) / 256) * ntn; }
        sh[32] = so; sh[33 + 32] = to;
    }
    __syncthreads();
    g8::MoeOrder S_;
    S_.sh = (const LAS int*)sh; S_.pre = pre; S_.list = list; S_.G = nb; S_.c = bid; S_.stage = stage; S_.ntn = ntn;
    if (stage == 1) {
        S_.A = (const char*)hb; S_.lda = DM; S_.K = DM; S_.W = (const char*)(a.ws + WS_WGU) + (size_t)layer * NEXP * 1024 * DM * 2; S_.wstride = (size_t)1024 * DM * 2;
        g8::EpiMoe1 E_{hdn};
        g8::gemm8((LAS unsigned char*)lds, DM, S_, E_);
    } else {
        S_.A = (const char*)hdn; S_.lda = FF; S_.K = FF; S_.W = (const char*)(a.ws + WS_WDN) + (size_t)layer * NEXP * DM * FF * 2; S_.wstride = (size_t)DM * FF * 2;
        g8::EpiMoe2 E_{Y, list, ew, pre};
        g8::gemm8((LAS unsigned char*)lds, FF, S_, E_);
    }
    __syncthreads();
}

DEVI void phase_ln2(const Args& a, int layer, const float* hf, float* of, bf16* ob, int gw, int ngw, int lane) {
    const bf16* Y = (const bf16*)(a.ws + WS_Y);
    const float* g = a.in[I_LFG] + layer * DM; const float* bta = a.in[I_LFB] + layer * DM;
    for (int t = gw; t < T; t += ngw) {
        f32x4 v[8];
        ln_row(hf + (size_t)t * DM, ALPHA, Y + (size_t)(2 * t) * DM, Y + (size_t)(2 * t + 1) * DM, g, bta, lane, v);
#pragma unroll
        for (int j = 0; j < 8; ++j) {
            *(f32x4*)(of + (size_t)t * DM + 4 * lane + 256 * j) = v[j];
            if (ob) { uint2 w; w.x = pk2(v[j][0], v[j][1]); w.y = pk2(v[j][2], v[j][3]); *(uint2*)(ob + (size_t)t * DM + 4 * lane + 256 * j) = w; }
        }
    }
}

__global__ void __launch_bounds__(NTHREADS, 2) fwd(Args a) {
    extern __shared__ __attribute__((aligned(16))) char lds[];
    const int tid = threadIdx.x, lane = tid & 63, wid = tid >> 6;
    const int bid = blockIdx.x, nb = gridDim.x;
    const int gw = bid * NWAVES + wid, ngw = nb * NWAVES;
    unsigned char* ws = a.ws;
    unsigned* ctl = (unsigned*)(ws + WS_CTL);
    float* FL = (float*)(ws + WS_FL); float* LF = (float*)(ws + WS_LF); float* CUM = (float*)(ws + WS_CUM); float* KM = (float*)(ws + WS_KM);
    bf16* KPE = (bf16*)(ws + WS_KPE); bf16* XB = (bf16*)(ws + WS_XB); bf16* HB = (bf16*)(ws + WS_HB);
    float* HFA = (float*)(ws + WS_HFA); float* HFB = (float*)(ws + WS_HFB); float* PRE = (float*)(ws + WS_PRE);
    bf16* P = (bf16*)(ws + WS_P); bf16* CQN = (bf16*)(ws + WS_CQN); bf16* CKVN = (bf16*)(ws + WS_CKVN);
    bf16* QM = (bf16*)(ws + WS_QM); bf16* KVM = (bf16*)(ws + WS_KVM); bf16* AO = (bf16*)(ws + WS_AO);

    volatile LAS unsigned* xbw = (volatile LAS unsigned*)((LAS char*)lds + LDS_BYTES - 16);
    if (tid < 4) xbw[tid] = 0u;
    __syncthreads();
    XcdBarrier bar; bar.bar = ctl + CW_BAR; bar.x = 0; bar.st = xbw;
#if ONE_LAUNCH
    bar = xcd_barrier_post(ctl + CW_BAR, xbw);
#define SEAM(k) do { if ((k) + 1 < a.ph_hi) xcd_barrier(bar); } while (0)
#else
#define SEAM(k) do { } while (0)
#endif
#define IN(k) (a.ph_lo <= (k) && (k) < a.ph_hi)

    if (IN(PH_CVT)) { for (int rep_ = 0; rep_ < REPS(PH_CVT); ++rep_) {
        const float* x = a.in[I_X];
        for (size_t i = (size_t)bid * NTHREADS + tid; i < (size_t)T * DM / 8; i += (size_t)nb * NTHREADS) {
            const f32x4 v0 = *(const f32x4*)(x + i * 8), v1 = *(const f32x4*)(x + i * 8 + 4);
            u32x4 w; w[0] = pk2(v0[0], v0[1]); w[1] = pk2(v0[2], v0[3]); w[2] = pk2(v1[0], v1[1]); w[3] = pk2(v1[2], v1[3]);
            *(u32x4*)(XB + i * 8) = w;
        }
        {
            const float* wr = a.in[I_WR]; bf16* wrh = (bf16*)(ws + WS_WRH); bf16* wrl = (bf16*)(ws + WS_WRL);
            for (int idx = bid * NTHREADS + tid; idx < NEXP * DM; idx += nb * NTHREADS) {
                const int e = idx >> 11, i = idx & 2047; const float w = wr[i * NEXP + e];
                const unsigned h = f2bf(w); wrh[idx] = (bf16)h; wrl[idx] = (bf16)f2bf(w - bf2f(h));
            }
        }
        {
            LAS float* scr = (LAS float*)((LAS char*)lds + wid * 17408);
            int base = 0;
            auto ident = [](int n0) { return n0; };
            cvt_matrix(a.in[I_EWIN], DM, EVEN_IN, 4096, (bf16*)(ws + WS_WIN0), [](int n0) { return n0 < EVEN_IN ? n0 : -1; }, scr, gw, ngw, lane, base);
            cvt_matrix(a.in[I_EWQ], 512, 1536, 1536, (bf16*)(ws + WS_WQU), ident, scr, gw, ngw, lane, base);
            cvt_matrix(a.in[I_EWKV], 256, 2048, 2048, (bf16*)(ws + WS_WKVU), ident, scr, gw, ngw, lane, base);
            cvt_matrix(a.in[I_EWOUT], DM, DM, DM, (bf16*)(ws + WS_WOUT0), ident, scr, gw, ngw, lane, base);
            cvt_matrix(a.in[I_OWIN], DM, ODD_IN, ODD_IN, (bf16*)(ws + WS_WIN1), ident, scr, gw, ngw, lane, base);
            cvt_matrix(a.in[I_OWOUT], DM, DM, DM, (bf16*)(ws + WS_WOUT1), ident, scr, gw, ngw, lane, base);
            for (int le = 0; le < 2 * NEXP; ++le)
                cvt_matrix(a.in[I_WGU] + (size_t)le * DM * 1024, DM, 1024, 1024, (bf16*)(ws + WS_WGU) + (size_t)le * 1024 * DM,
                           [](int n0) { return ((n0 >> 7) & 1) * 512 + (n0 >> 8) * 128 + (n0 & 127); }, scr, gw, ngw, lane, base);
            for (int le = 0; le < 2 * NEXP; ++le)
                cvt_matrix(a.in[I_WDN] + (size_t)le * FF * DM, FF, DM, DM, (bf16*)(ws + WS_WDN) + (size_t)le * DM * FF, ident, scr, gw, ngw, lane, base);
        }
        }
        SEAM(PH_CVT);
    }
    if (IN(PH_L0_IN)) { for (int rep_ = 0; rep_ < REPS(PH_L0_IN); ++rep_) {
        { g8::DenseOrder S_; S_.init(XB, DM, (const bf16*)(ws + WS_WIN0), T, 4096, DM, nb, bid); g8::EpiBf16 E_{P, LDP, EVEN_IN, FL, E_FL, nullptr, 0}; g8::gemm8((LAS unsigned char*)lds, DM, S_, E_); }
        }
        SEAM(PH_L0_IN);
    }
    if (IN(PH_L0_PREP)) { for (int rep_ = 0; rep_ < REPS(PH_L0_PREP); ++rep_) {
        const float* qn = a.in[I_EQN]; const float* kvn = a.in[I_EKVN]; const float* fb = a.in[I_EFB];
        float nq0 = 0.f, nk0 = 0.f, nq1 = 0.f, nk1 = 0.f;
        for (int t = gw; t < T; t += ngw) {
            const bf16* pr = P + (size_t)t * LDP;
            {
                const u32x4 w = *(const u32x4*)(pr + E_CQ + lane * 8);
                float x[8] = {bflo(w[0]), bfhi(w[0]), bflo(w[1]), bfhi(w[1]), bflo(w[2]), bfhi(w[2]), bflo(w[3]), bfhi(w[3])};
                float ss = 0.f;
#pragma unroll
                for (int i = 0; i < 8; ++i) ss += x[i] * x[i];
                const float r = 1.f / sqrtf(wave_sum(ss) * (1.f / 512.f) + RMS_EPS);
                u32x4 o;
#pragma unroll
                for (int i = 0; i < 4; ++i) o[i] = pk2(x[2 * i] * r * qn[lane * 8 + 2 * i], x[2 * i + 1] * r * qn[lane * 8 + 2 * i + 1]);
                *(u32x4*)(CQN + (size_t)t * 512 + lane * 8) = o;
            }
            {
                const uint2 w = *(const uint2*)(pr + E_CKV + lane * 4);
                float x[4] = {bflo(w.x), bfhi(w.x), bflo(w.y), bfhi(w.y)};
                float ss = x[0] * x[0] + x[1] * x[1] + x[2] * x[2] + x[3] * x[3];
                const float r = 1.f / sqrtf(wave_sum(ss) * (1.f / 256.f) + RMS_EPS);
                uint2 o; o.x = pk2(x[0] * r * kvn[lane * 4], x[1] * r * kvn[lane * 4 + 1]); o.y = pk2(x[2] * r * kvn[lane * 4 + 2], x[3] * r * kvn[lane * 4 + 3]);
                *(uint2*)(CKVN + (size_t)t * 256 + lane * 4) = o;
            }
            if (lane < 32) {
                const float t1 = bf2f(pr[E_KR + lane]), t2 = bf2f(pr[E_KR + 32 + lane]);
                float c, s; rope_cs(t % S, lane, c, s);
                KPE[(size_t)t * 64 + lane] = (bf16)f2bf(t1 * c - t2 * s);
                KPE[(size_t)t * 64 + 32 + lane] = (bf16)f2bf(t1 * s + t2 * c);
            }
            if (lane < 8) {
                const float x = FL[t * 8 + lane] + fb[lane];
                LF[t * 8 + lane] = fminf(x, 0.f) - log1pf(__expf(-fabsf(x)));
            }
            {
                float sq = 0.f, sk = 0.f;
#pragma unroll
                for (int hh = 0; hh < 2; ++hh) {
                    const u32x4 wq = *(const u32x4*)(pr + E_FQ + lane * 16 + hh * 8), wk = *(const u32x4*)(pr + E_FK + lane * 16 + hh * 8);
#pragma unroll
                    for (int i = 0; i < 4; ++i) { sq += bflo(wq[i]) * bflo(wq[i]) + bfhi(wq[i]) * bfhi(wq[i]); sk += bflo(wk[i]) * bflo(wk[i]) + bfhi(wk[i]) * bfhi(wk[i]); }
                }
                sq += __shfl_xor(sq, 1); sq += __shfl_xor(sq, 2); sq += __shfl_xor(sq, 4);
                sk += __shfl_xor(sk, 1); sk += __shfl_xor(sk, 2); sk += __shfl_xor(sk, 4);
                if (t < S) { nq0 = fmaxf(nq0, sq); nk0 = fmaxf(nk0, sk); } else { nq1 = fmaxf(nq1, sq); nk1 = fmaxf(nk1, sk); }
            }
        }
        if ((lane & 7) == 0) {
            const int h = lane >> 3;
            atomicMax(&ctl[CW_NRM + 0 * 16 + h], __float_as_uint(nq0)); atomicMax(&ctl[CW_NRM + 0 * 16 + 8 + h], __float_as_uint(nk0));
            atomicMax(&ctl[CW_NRM + 1 * 16 + h], __float_as_uint(nq1)); atomicMax(&ctl[CW_NRM + 1 * 16 + 8 + h], __float_as_uint(nk1));
        }
        }
        SEAM(PH_L0_PREP);
    }
    if (IN(PH_L0_UP)) { for (int rep_ = 0; rep_ < REPS(PH_L0_UP); ++rep_) {
        if (bid >= nb - 16) {
            const int sq = bid - (nb - 16), b = sq >> 3, h = sq & 7;
            double* sd = (double*)(lds + 4096);
            double v8[8], run = 0.0;
#pragma unroll
            for (int i = 0; i < 8; ++i) { run += (double)LF[(size_t)(b * S + tid * 8 + i) * 8 + h]; v8[i] = run; }
            double inc = run;
#pragma unroll
            for (int o = 1; o < 64; o <<= 1) { const double nbv = __shfl_up(inc, o); if (lane >= o) inc += nbv; }
            if (lane == 63) sd[wid] = inc;
            __syncthreads();
            double off = inc - run;
            for (int w = 0; w < wid; ++w) off += sd[w];
#pragma unroll
            for (int i = 0; i < 8; ++i) CUM[(size_t)sq * S + tid * 8 + i] = (float)(off + v8[i]);
            __syncthreads();
        }
        const int n1 = (T / 128) * (1536 / 128);
        { g8::DenseOrder S_; S_.init(CQN, 512, (const bf16*)(ws + WS_WQU), T, 1536, 512, nb, bid); g8::EpiBf16 E_{QM, 1536, 1536, nullptr, 0, nullptr, 0}; g8::gemm8((LAS unsigned char*)lds, 512, S_, E_); }
        { g8::DenseOrder S_; S_.init(CKVN, 256, (const bf16*)(ws + WS_WKVU), T, 2048, 256, nb, bid); g8::EpiBf16 E_{KVM, 2048, 2048, nullptr, 0, nullptr, 0}; g8::gemm8((LAS unsigned char*)lds, 256, S_, E_); }
        }
        SEAM(PH_L0_UP);
    }
    if (IN(PH_L0_ATT)) { for (int rep_ = 0; rep_ < REPS(PH_L0_ATT); ++rep_) {
        volatile unsigned* qslot = (volatile unsigned*)(lds + FA_Q);
        for (;;) {
            if (tid == 0) *qslot = atomicAdd(&ctl[CW_Q + 0 + 8 * rep_], 1u);
            __syncthreads();
            const int item = __builtin_amdgcn_readfirstlane((int)*qslot);
            __syncthreads();
            if (item >= 512) break;
            const int qb = 31 - (item >> 4), bh = item & 15, b = bh >> 3, h = bh & 7;
            flash_unit<FM_MLA>(lds, QM + (size_t)b * S * 1536 + h * 192, 1536, KVM + (size_t)b * S * 2048 + h * 256, 2048, KVM + (size_t)b * S * 2048 + h * 256 + 128, 2048,
                               KPE + (size_t)b * S * 64, nullptr, nullptr, 0.f, 0.f, qb * 128, AO + (size_t)b * S * 2048 + h * 128, 2048);
        }
        for (;;) {
            if (tid == 0) *qslot = atomicAdd(&ctl[CW_Q + 1 + 8 * rep_], 1u);
            __syncthreads();
            const int item = __builtin_amdgcn_readfirstlane((int)*qslot);
            __syncthreads();
            if (item >= 512) break;
            const int qb = 31 - (item >> 4), bh = item & 15, b = bh >> 3, h = bh & 7;
            const float sb_ = 0.08838834764831845f * sqrtf(__uint_as_float(ctl[CW_NRM + b * 16 + h]) * __uint_as_float(ctl[CW_NRM + b * 16 + 8 + h])) * 1.01f + 0.01f;
            flash_unit<FM_FOX>(lds, P + (size_t)b * S * LDP + E_FQ + h * 128, LDP, P + (size_t)b * S * LDP + E_FK + h * 128, LDP, P + (size_t)b * S * LDP + E_FV + h * 128, LDP,
                               nullptr, CUM + (size_t)bh * S, nullptr, 0.f, sb_, qb * 128, AO + (size_t)b * S * 2048 + 1024 + h * 128, 2048);
        }
        }
        SEAM(PH_L0_ATT);
    }
    if (IN(PH_L0_OUT)) { for (int rep_ = 0; rep_ < REPS(PH_L0_OUT); ++rep_) {
        const float* x = a.in[I_X];
        { g8::DenseOrder S_; S_.init(AO, DM, (const bf16*)(ws + WS_WOUT0), T, DM, DM, nb, bid); g8::EpiRes E_{PRE, x, DM, ALPHA}; g8::gemm8((LAS unsigned char*)lds, DM, S_, E_); }
        }
        SEAM(PH_L0_OUT);
    }
    if (IN(PH_L0_LN1)) { phase_ln1_route(a, lds, 0, PRE, HFA, HB, bid, nb, wid, lane); SEAM(PH_L0_LN1); }
    if (IN(PH_L0_MOE1)) { for (int rep_ = 0; rep_ < REPS(PH_L0_MOE1); ++rep_) phase_moe(a, lds, 0, 1, HB, bid, nb); SEAM(PH_L0_MOE1); }
    if (IN(PH_L0_MOE2)) { for (int rep_ = 0; rep_ < REPS(PH_L0_MOE2); ++rep_) phase_moe(a, lds, 0, 2, HB, bid, nb); SEAM(PH_L0_MOE2); }
    if (IN(PH_L0_LN2)) { for (int rep_ = 0; rep_ < REPS(PH_L0_LN2); ++rep_) phase_ln2(a, 0, HFA, HFB, XB, gw, ngw, lane); SEAM(PH_L0_LN2); }

    if (IN(PH_L1_IN)) {
        { g8::DenseOrder S_; S_.init(XB, DM, (const bf16*)(ws + WS_WIN1), T, ODD_IN, DM, nb, bid); g8::EpiBf16 E_{P, LDP, ODD_IN, nullptr, 0, KM, O_MK}; g8::gemm8((LAS unsigned char*)lds, DM, S_, E_); }
        SEAM(PH_L1_IN);
    }
    if (IN(PH_L1_ATT)) { for (int rep_ = 0; rep_ < REPS(PH_L1_ATT); ++rep_) {
        volatile unsigned* qslot = (volatile unsigned*)(lds + FA_Q);
        const float* sinks = a.in[I_OSINK];
        for (;;) {
            if (tid == 0) *qslot = atomicAdd(&ctl[CW_Q + 2 + 8 * rep_], 1u);
            __syncthreads();
            const int item = __builtin_amdgcn_readfirstlane((int)*qslot);
            __syncthreads();
            if (item >= 512) break;
            const int qb = 31 - (item >> 4), bh = item & 15, b = bh >> 3, h = bh & 7;
            flash_unit<FM_MOBA>(lds, P + (size_t)b * S * LDP + O_MQ + h * 128, LDP, P + (size_t)b * S * LDP + O_MK + h * 128, LDP, P + (size_t)b * S * LDP + O_MV + h * 128, LDP,
                                nullptr, nullptr, KM + (size_t)bh * 16 * 128, exp2f(-(float)(h + 1)), 0.f, qb * 128, AO + (size_t)b * S * 2048 + 1024 + h * 128, 2048);
        }
        for (;;) {
            if (tid == 0) *qslot = atomicAdd(&ctl[CW_Q + 3 + 8 * rep_], 1u);
            __syncthreads();
            const int item = __builtin_amdgcn_readfirstlane((int)*qslot);
            __syncthreads();
            if (item >= 256) break;
            const int qb = item & 63, bk = item >> 6, b = bk >> 1, kvh = bk & 1;
            swa_unit(lds, P + (size_t)b * S * LDP, kvh, qb * 64, sinks, AO + (size_t)b * S * 2048);
        }
        }
        SEAM(PH_L1_ATT);
    }
    if (IN(PH_L1_OUT)) {
        { g8::DenseOrder S_; S_.init(AO, DM, (const bf16*)(ws + WS_WOUT1), T, DM, DM, nb, bid); g8::EpiRes E_{PRE, HFB, DM, ALPHA}; g8::gemm8((LAS unsigned char*)lds, DM, S_, E_); }
        SEAM(PH_L1_OUT);
    }
    if (IN(PH_L1_LN1)) { phase_ln1_route(a, lds, 1, PRE, HFA, HB, bid, nb, wid, lane); SEAM(PH_L1_LN1); }
    if (IN(PH_L1_MOE1)) { phase_moe(a, lds, 1, 1, HB, bid, nb); SEAM(PH_L1_MOE1); }
    if (IN(PH_L1_MOE2)) { phase_moe(a, lds, 1, 2, HB, bid, nb); SEAM(PH_L1_MOE2); }
    if (IN(PH_L1_LN2)) { phase_ln2(a, 1, HFA, a.out, nullptr, gw, ngw, lane); }
#undef IN
#undef SEAM
}

extern "C" void kernel_launch(void* const* d_in, const int* in_sizes, int n_in, void* d_out, int out_size, void* d_ws, size_t ws_size, hipStream_t stream) {
    static int grid = 0;
    if (grid == 0) {
        if (n_in != 19 || out_size != T * DM || ws_size < WS_END) { fprintf(stderr, "kernel_launch: unexpected shapes (n_in %d out %d ws %zu)\n", n_in, out_size, ws_size); grid = -1; return; }
        int dev = 0, cus = 0;
        if (hipGetDevice(&dev) != hipSuccess || hipDeviceGetAttribute(&cus, hipDeviceAttributeMultiprocessorCount, dev) != hipSuccess || cus <= 0) cus = 256;
        (void)hipFuncSetAttribute((const void*)fwd, hipFuncAttributeMaxDynamicSharedMemorySize, LDS_BYTES);
        int per_cu = 0;
        if (hipOccupancyMaxActiveBlocksPerMultiprocessor(&per_cu, (const void*)fwd, NTHREADS, LDS_BYTES) != hipSuccess || per_cu < 1) fprintf(stderr, "kernel_launch: occupancy query says %d\n", per_cu);
        (void)hipGetLastError();
        grid = cus;
    }
    if (grid < 0) return;
    (void)in_sizes;
    (void)hipMemsetAsync((char*)d_ws + WS_CTL, 0, CTL_BYTES, stream);
    Args a{};
    for (int i = 0; i < 19; ++i) a.in[i] = (const float*)d_in[i];
    a.out = (float*)d_out; a.ws = (unsigned char*)d_ws;
#if ONE_LAUNCH
    a.ph_lo = 0; a.ph_hi = NPH;
    hipLaunchKernelGGL(fwd, dim3(grid), dim3(NTHREADS), LDS_BYTES, stream, a);
#if PROBE_PH >= 0
    (void)hipMemsetAsync((char*)d_ws + WS_CTL + CW_Q * 4, 0, 256, stream);
    (void)hipMemsetAsync((char*)d_ws + WS_CTL + CW_BAR * 4, 0, XCD_BAR_WORDS * 4, stream);
    a.ph_lo = PROBE_PH; a.ph_hi = PROBE_PH + 1;
    hipLaunchKernelGGL(fwd, dim3(grid), dim3(NTHREADS), LDS_BYTES, stream, a);
#endif
#else
    for (int p = 0; p < NPH; ++p) { a.ph_lo = p; a.ph_hi = p + 1; hipLaunchKernelGGL(fwd, dim3(grid), dim3(NTHREADS), LDS_BYTES, stream, a); }
#endif
}
```
